# Optimizing an MI355X kernel written in HIP

```python
import math
import jax, jax.numpy as jnp
from jax import lax
import numpy as np

D_MODEL = 1024
BATCH = 32
SEQ = 2048
DEPTH = 2

GRID_W = 64
HEAD_DIM = 64
N_Q_HEADS = 8
N_KV_HEADS = 2
GROUP = N_Q_HEADS // N_KV_HEADS
ATTN_WIDTH = N_Q_HEADS * HEAD_DIM
KV_WIDTH = N_KV_HEADS * HEAD_DIM
CONV_CH = D_MODEL - ATTN_WIDTH
MIX_WIDTH = ATTN_WIDTH + CONV_CH
IN_WIDTH = ATTN_WIDTH + 2 * KV_WIDTH + 2 * CONV_CH
Q_BLOCK = 128
ROPE_THETA = 10000.0
ROPE_HALF = HEAD_DIM // 2
ROPE_FREQS = ROPE_HALF // 2
CONV_WIDTH = 31
CONV_PAD = CONV_WIDTH // 2
N_EXPERTS = 32
TOP_K = 4
D_EXPERT = 1024
SWIGLU_LIMIT = 7.0
SWIGLU_ALPHA = 1.702
MOE_BLOCK = 512
EPS = 1e-6

kernel_name = "hymba_style_attn_conformer_moe_encoder"


def rmsnorm(x, g):
    xf = x.astype(jnp.float32)
    y = xf * lax.rsqrt(jnp.mean(xf * xf, axis=-1, keepdims=True) + EPS)
    return (y * g.astype(jnp.float32)).astype(x.dtype)


def layernorm(x, g, b):
    xf = x.astype(jnp.float32)
    mu = jnp.mean(xf, axis=-1, keepdims=True)
    var = jnp.mean(jnp.square(xf - mu), axis=-1, keepdims=True)
    y = (xf - mu) * lax.rsqrt(var + EPS)
    return (y * g.astype(jnp.float32) + b.astype(jnp.float32)).astype(x.dtype)


def axial_rope_tables(seq_len):
    rows = seq_len // GRID_W
    freqs = ROPE_THETA ** (-jnp.arange(ROPE_FREQS, dtype=jnp.float32) / ROPE_FREQS)
    row_ang = jnp.arange(rows, dtype=jnp.float32)[:, None] * freqs
    col_ang = jnp.arange(GRID_W, dtype=jnp.float32)[:, None] * freqs
    row_full = jnp.broadcast_to(row_ang[:, None, :], (rows, GRID_W, ROPE_FREQS)).reshape(seq_len, ROPE_FREQS)
    col_full = jnp.broadcast_to(col_ang[None, :, :], (rows, GRID_W, ROPE_FREQS)).reshape(seq_len, ROPE_FREQS)
    return jnp.cos(row_full), jnp.sin(row_full), jnp.cos(col_full), jnp.sin(col_full)


def _rotate(x, cos, sin):
    x1, x2 = x[..., :ROPE_FREQS], x[..., ROPE_FREQS:]
    return jnp.concatenate([x1 * cos - x2 * sin, x2 * cos + x1 * sin], axis=-1)


def apply_axial_rope(x, tables):
    cr, sr, cc, sc = [t.astype(x.dtype)[None, :, None, :] for t in tables]
    return jnp.concatenate([_rotate(x[..., :ROPE_HALF], cr, sr),
                            _rotate(x[..., ROPE_HALF:], cc, sc)], axis=-1)


def blocked_gqa(q, k, v):
    B, S, _, Dh = q.shape
    nblk = S // Q_BLOCK
    scale = Dh ** -0.5
    qb = q.reshape(B, nblk, Q_BLOCK, N_KV_HEADS, GROUP, Dh).transpose(1, 0, 2, 3, 4, 5)

    def one_block(qblk):
        s = jnp.einsum('bqkgd,bskd->bkgqs', qblk, k).astype(jnp.float32) * scale
        p = jax.nn.softmax(s, axis=-1).astype(v.dtype)
        return jnp.einsum('bkgqs,bskd->bqkgd', p, v)

    o = lax.map(one_block, qb)
    return o.transpose(1, 0, 2, 3, 4, 5).reshape(B, S, N_Q_HEADS * Dh)


def conformer_conv(a, gate, w_dw, b_dw, g_cn, b_cn):
    u = a * jax.nn.sigmoid(gate)
    u = lax.conv_general_dilated(u, w_dw[:, None, :].astype(u.dtype), window_strides=(1,),
                                 padding=[(CONV_PAD, CONV_PAD)],
                                 dimension_numbers=('NWC', 'WIO', 'NWC'),
                                 feature_group_count=CONV_CH) + b_dw
    return jax.nn.silu(layernorm(u, g_cn, b_cn))


def moe_ffn(h, w_router, b_router, w1, b1, w2, b2):
    B, S, D = h.shape
    N = B * S
    NK = N * TOP_K
    hf = h.reshape(N, D)
    logits = (hf @ w_router).astype(jnp.float32) + b_router.astype(jnp.float32)
    top_vals, top_idx = lax.top_k(logits, TOP_K)
    gates = jax.nn.softmax(top_vals, axis=-1)
    flat_e = top_idx.reshape(NK)
    flat_t = jnp.repeat(jnp.arange(N, dtype=jnp.int32), TOP_K)
    flat_g = gates.reshape(NK)
    order = jnp.argsort(flat_e)
    se, st, sg = flat_e[order], flat_t[order], flat_g[order]
    counts = jnp.bincount(flat_e, length=N_EXPERTS)
    starts = jnp.cumsum(counts) - counts
    padded = (counts + MOE_BLOCK - 1) // MOE_BLOCK * MOE_BLOCK
    pstarts = jnp.cumsum(padded) - padded
    pends = pstarts + padded
    dest = pstarts[se] + (jnp.arange(NK, dtype=jnp.int32) - starts[se])
    P = (NK + MOE_BLOCK - 1) // MOE_BLOCK * MOE_BLOCK + N_EXPERTS * MOE_BLOCK
    n_blocks = P // MOE_BLOCK
    pad_t = jnp.zeros((P,), jnp.int32).at[dest].set(st)
    pad_g = jnp.zeros((P,), jnp.float32).at[dest].set(sg)
    block_start = jnp.arange(n_blocks, dtype=jnp.int32) * MOE_BLOCK
    block_e = jnp.minimum(jnp.searchsorted(pends, block_start, side='right'), N_EXPERTS - 1)

    def step(acc, blk):
        tok, g, e = blk
        xb = hf[tok]
        hu = xb @ w1[e] + b1[e]
        x_glu = jnp.minimum(hu[:, :D_EXPERT], SWIGLU_LIMIT)
        x_lin = jnp.clip(hu[:, D_EXPERT:], -SWIGLU_LIMIT, SWIGLU_LIMIT)
        act = (x_lin + 1.0) * (x_glu * jax.nn.sigmoid(SWIGLU_ALPHA * x_glu))
        y = act @ w2[e] + b2[e]
        return acc.at[tok].add(y * g[:, None].astype(y.dtype)), None

    out, _ = lax.scan(step, jnp.zeros_like(hf),
                      (pad_t.reshape(n_blocks, MOE_BLOCK), pad_g.reshape(n_blocks, MOE_BLOCK), block_e))
    return out.reshape(B, S, D)


def setup_inputs(seed: int = 0) -> dict:
    key = jax.random.key(seed)
    ks = jax.random.split(key, 26)
    L, D = DEPTH, D_MODEL

    def nrm(k, shape, scale):
        return jax.random.normal(k, shape, jnp.float32) * scale

    return {
        "x": nrm(ks[0], (BATCH, SEQ, D), 1.0),
        "c": nrm(ks[1], (BATCH, D), 1.0),
        "w_mod": nrm(ks[2], (L, D, 6 * D), 0.5 * D ** -0.5),
        "b_mod": nrm(ks[3], (L, 6 * D), 0.01),
        "g_mix": 1.0 + nrm(ks[4], (L, D), 0.02),
        "w_in": nrm(ks[5], (L, D, IN_WIDTH), D ** -0.5),
        "g_q": 1.0 + nrm(ks[6], (L, HEAD_DIM), 0.02),
        "g_k": 1.0 + nrm(ks[7], (L, HEAD_DIM), 0.02),
        "w_dw": nrm(ks[8], (L, CONV_WIDTH, CONV_CH), CONV_WIDTH ** -0.5),
        "b_dw": nrm(ks[9], (L, CONV_CH), 0.01),
        "g_cn": 1.0 + nrm(ks[10], (L, CONV_CH), 0.02),
        "b_cn": nrm(ks[11], (L, CONV_CH), 0.01),
        "w_out": nrm(ks[12], (L, MIX_WIDTH, D), MIX_WIDTH ** -0.5),
        "g_ffn": 1.0 + nrm(ks[13], (L, D), 0.02),
        "w_router": nrm(ks[14], (L, D, N_EXPERTS), D ** -0.5),
        "b_router": nrm(ks[15], (L, N_EXPERTS), 0.01),
        "w1": nrm(ks[16], (L, N_EXPERTS, D, 2 * D_EXPERT), D ** -0.5),
        "b1": nrm(ks[17], (L, N_EXPERTS, 2 * D_EXPERT), 0.01),
        "w2": nrm(ks[18], (L, N_EXPERTS, D_EXPERT, D), D_EXPERT ** -0.5),
        "b2": nrm(ks[19], (L, N_EXPERTS, D), 0.01),
        "g_final": 1.0 + nrm(ks[20], (D,), 0.02),
    }


def reference(x, c, w_mod, b_mod, g_mix, w_in, g_q, g_k, w_dw, b_dw, g_cn, b_cn,
              w_out, g_ffn, w_router, b_router, w1, b1, w2, b2, g_final):
    B, S, D = x.shape
    rope = axial_rope_tables(S)
    c_act = jax.nn.silu(c)
    split_at = [ATTN_WIDTH, ATTN_WIDTH + KV_WIDTH, ATTN_WIDTH + 2 * KV_WIDTH,
                ATTN_WIDTH + 2 * KV_WIDTH + CONV_CH]
    for l in range(DEPTH):
        mod = c_act @ w_mod[l] + b_mod[l]
        sh1, sc1, gt1, sh2, sc2, gt2 = [m[:, None, :] for m in jnp.split(mod, 6, axis=-1)]

        h = rmsnorm(x, g_mix[l]) * (1.0 + sc1) + sh1
        proj = h @ w_in[l]
        q, k, v, ca, cg = jnp.split(proj, split_at, axis=-1)
        q = apply_axial_rope(rmsnorm(q.reshape(B, S, N_Q_HEADS, HEAD_DIM), g_q[l]), rope)
        k = apply_axial_rope(rmsnorm(k.reshape(B, S, N_KV_HEADS, HEAD_DIM), g_k[l]), rope)
        v = v.reshape(B, S, N_KV_HEADS, HEAD_DIM)
        attn = blocked_gqa(q, k, v)
        conv = conformer_conv(ca, cg, w_dw[l], b_dw[l], g_cn[l], b_cn[l])
        mix = jnp.concatenate([attn, conv], axis=-1) @ w_out[l]
        x = x + gt1 * mix

        h = rmsnorm(x, g_ffn[l]) * (1.0 + sc2) + sh2
        x = x + gt2 * moe_ffn(h, w_router[l], b_router[l], w1[l], b1[l], w2[l], b2[l])
    return rmsnorm(x, g_final)
```

```cpp
#include <hip/hip_runtime.h>
#include <hip/hip_bf16.h>
#include <cstdio>
#include <cstdint>
#include <cmath>
#ifndef MK_PER_PHASE
#define MK_PER_PHASE 0
#endif
namespace pg8 {
#define PG8_LAS __attribute__((address_space(3)))
typedef unsigned short bf16_t;
typedef short bf16x8 __attribute__((ext_vector_type(8)));
typedef float f32x4 __attribute__((ext_vector_type(4)));
typedef unsigned u32x4 __attribute__((ext_vector_type(4)));
constexpr int BM = 256, BK = 64, HALF = 128, HTB = HALF * BK * 2  , STAGE_BYTES = 8 * HTB, NXCD = 8, WGM = 8;

__host__ __device__ __forceinline__ int lds_byte(int r, int c) { const int st = (r >> 4) * 2 + (c >> 5), rr = r & 15, cc = c & 31, ob = rr * 64 + cc * 2; return st * 1024 + (ob ^ (((ob >> 9) & 1) << 5)); }
__host__ __device__ __forceinline__ void stage_rc(int b, int& R, int& C) { const int st = b / 1024, sb = b % 1024, swz = sb ^ (((sb >> 9) & 1) << 5); R = (st >> 1) * 16 + swz / 64; C = (st & 1) * 32 + (swz % 64) / 2; }
__host__ __device__ __forceinline__ int perm32(int rho) { const int n = rho >> 4, i = rho & 15; return 8 * (i >> 2) + 4 * n + (i & 3); }


#define PG8_GAS __attribute__((address_space(1)))
typedef int v8i_t __attribute__((ext_vector_type(8)));
typedef int v4i_t __attribute__((ext_vector_type(4)));
#ifndef PG8_F8_SCALE
#define PG8_F8_SCALE 0
#endif
__device__ __forceinline__ void pg8_glds(const void* sbase, unsigned voff, unsigned ldsdst) { unsigned keep;
    asm volatile("s_mov_b32 %0, m0\n\ts_mov_b32 m0, %3\n\ts_nop 0\n\tglobal_load_lds_dwordx4 %1, %2\n\ts_mov_b32 m0, %0" : "=&s"(keep) : "v"(voff), "s"(sbase), "s"(ldsdst) : "memory"); }
template <class T> __device__ __forceinline__ T* pg8_uniform(T* p) { const unsigned long long v = (unsigned long long)p;
    return (T*)(((unsigned long long)(unsigned)__builtin_amdgcn_readfirstlane((int)(v >> 32)) << 32) | (unsigned)__builtin_amdgcn_readfirstlane((int)(unsigned)v)); }
__device__ __forceinline__ v8i_t pg8_cat(bf16x8 lo, bf16x8 hi) { const v4i_t a = __builtin_bit_cast(v4i_t, lo), b = __builtin_bit_cast(v4i_t, hi); return __builtin_shufflevector(a, b, 0, 1, 2, 3, 4, 5, 6, 7); }

struct Unit { int pm, pn, e; };
struct Gemm { const bf16_t* A; const bf16_t* Bt; int M, N, K; size_t estride; };

struct StaticOrder {
    static constexpr bool GATHER = false; const int* perm; PG8_LAS int* ptab;
    int nM, nN, nwg, G, c;
    __host__ __device__ void init(int M, int N, int G_, int c_) { nM = M / BM; nN = N / BM; nwg = nM * nN; G = G_; c = c_; }
    __host__ __device__ bool next(int i, Unit& u) const {
        const long L = (long)i * G + c; if (L >= nwg) return false;
        int wgid = (int)L; { const int q = nwg / NXCD, r = nwg % NXCD, xcd = wgid % NXCD, off = wgid / NXCD; wgid = (xcd < r ? xcd * (q + 1) : r * (q + 1) + (xcd - r) * q) + off; }
        const int nig = WGM * nN, gid = wgid / nig, fm = gid * WGM, gsz = (nM - fm) < WGM ? (nM - fm) : WGM;
        u.pm = fm + ((wgid % nig) % gsz); u.pn = (wgid % nig) / gsz; u.e = 0; return true;
    }
    __device__ __forceinline__ void a_ready(const Unit&) const {}
    __device__ __forceinline__ void done(const Unit&) const {}
};
struct RowOrder {
    static constexpr bool GATHER = false; const int* perm; PG8_LAS int* ptab;
    int nM, nN, G, vcu;
    __device__ __forceinline__ bool next(int i, Unit& u) const { const int lap = i / nN, pm = lap * G + vcu; if (pm >= nM) return false; u.pm = pm; u.pn = i - lap * nN; u.e = 0; return true; }
    __device__ __forceinline__ void a_ready(const Unit&) const {}
    __device__ __forceinline__ void done(const Unit&) const {}
};
template <int LOGN, bool GATHER_ = false> struct MoeRowOrder {
    static constexpr bool GATHER = GATHER_;
    const PG8_LAS unsigned char* tile_e; int T, G, vcu; const int* perm; PG8_LAS int* ptab;
    __device__ __forceinline__ bool next(int i, Unit& u) const {
        const int fl = T / G, nfull = fl << LOGN;
        int t, pn;
        if (i < nfull) { t = (i >> LOGN) * G + vcu; pn = i & ((1 << LOGN) - 1); }
        else { const int v = (i - nfull) * G + vcu; t = fl * G + (v >> LOGN); pn = v & ((1 << LOGN) - 1); if (t >= T) return false; }
        u.pm = t; u.pn = pn; u.e = __builtin_amdgcn_readfirstlane((int)tile_e[t]); return true;
    }
    __device__ __forceinline__ void a_ready(const Unit&) const {}
    __device__ __forceinline__ void done(const Unit&) const {}
};
template <bool NN8, bool GATHER_ = false, bool REV = false> struct MoeOrder {
    static constexpr bool GATHER = GATHER_;
    const PG8_LAS unsigned char* tile_e; int T, G, vcu; const int* perm; PG8_LAS int* ptab;
    __device__ __forceinline__ bool next(int i, Unit& u) const {
        const int v = i * G + vcu, grp = v >> 5, j = v & 31;
        const int t = NN8 ? (4 * grp + (j & 3)) : (8 * grp + (j & 7));
        if (t >= T) return false;
        u.pm = REV ? (T - 1 - t) : t; u.pn = NN8 ? (j >> 2) : (j >> 3); u.e = __builtin_amdgcn_readfirstlane((int)tile_e[u.pm]); return true;
    }
    __device__ __forceinline__ void a_ready(const Unit&) const {}
    __device__ __forceinline__ void done(const Unit&) const {}
};

__device__ __forceinline__ unsigned cvt_pk_bf16(float lo, float hi) { unsigned r; asm volatile("v_cvt_pk_bf16_f32 %0, %1, %2" : "=v"(r) : "v"(lo), "v"(hi)); return r; }

constexpr float F8_SA = 8.f, F8_SW = 1024.f, F8_SACT = 8.f;
constexpr float F8_SMIX = 16.f;
constexpr float F8_DQ_OUT = 1.0f / (F8_SMIX * F8_SW);
constexpr float F8_DQ_IN = 1.0f / (F8_SA * F8_SW);
struct EpiInProj {
    static constexpr bool PERM = true, AFTER_DRAIN = false, STAGED = false;
    bf16_t* Q; bf16_t* KN; bf16_t* V; bf16_t* U; const float* g_q; const float* g_k; const float* rope;
    __device__ __forceinline__ void operator()(const f32x4 (&acc)[2][2][4][2], const Unit& u, int wr, int wc, int fr, int fq) const {
        const int row0 = u.pm * BM + wr * 64 + fr;
        if (u.pn >= 3) {
            bf16_t* op = U + (size_t)row0 * 512 + (u.pn - 3) * HALF + wc * 32 + 8 * fq;
#pragma unroll
            for (int ai = 0; ai < 2; ++ai)
#pragma unroll
                for (int m = 0; m < 4; ++m) { float o[8];
#pragma unroll
                    for (int n = 0; n < 2; ++n)
#pragma unroll
                        for (int j = 0; j < 4; ++j) o[4 * n + j] = (acc[ai][0][m][n][j] * F8_DQ_IN) * __builtin_amdgcn_rcpf(1.0f + __builtin_amdgcn_exp2f((-1.4426950408889634f * F8_DQ_IN) * acc[ai][1][m][n][j]));
                    u32x4 w; w.x = cvt_pk_bf16(o[0], o[1]); w.y = cvt_pk_bf16(o[2], o[3]); w.z = cvt_pk_bf16(o[4], o[5]); w.w = cvt_pk_bf16(o[6], o[7]);
                    *(PG8_GAS u32x4*)(op + (size_t)(ai * HALF + m * 16) * 512) = w; }
            return;
        }
        if (u.pn == 2 && wc >= 2) {
            bf16_t* op = V + (size_t)row0 * 128 + (wc - 2) * 64 + 8 * fq;
#pragma unroll
            for (int ai = 0; ai < 2; ++ai)
#pragma unroll
                for (int m = 0; m < 4; ++m)
#pragma unroll
                    for (int bj = 0; bj < 2; ++bj) { const f32x4 v0 = acc[ai][bj][m][0] * F8_DQ_IN, v1 = acc[ai][bj][m][1] * F8_DQ_IN;
                        u32x4 w; w.x = cvt_pk_bf16(v0[0], v0[1]); w.y = cvt_pk_bf16(v0[2], v0[3]); w.z = cvt_pk_bf16(v1[0], v1[1]); w.w = cvt_pk_bf16(v1[2], v1[3]);
                        *(PG8_GAS u32x4*)(op + (size_t)(ai * HALF + m * 16) * 128 + bj * 32) = w; }
            return;
        }
        const bool isq = u.pn < 2; const int lane = fr + 16 * fq;
        const float* gp = (isq ? g_q : g_k) + 32 * (fq >> 1) + 8 * (fq & 1);
        f32x4 g1[2], g2[2];
#pragma unroll
        for (int n = 0; n < 2; ++n) { g1[n] = *(const PG8_GAS f32x4*)(gp + 4 * n); g2[n] = *(const PG8_GAS f32x4*)(gp + 16 + 4 * n); }
        const float qs = isq ? 0.125f * 1.4426950408889634f : 1.0f;
        bf16_t* op = isq ? (Q + (size_t)row0 * 512 + (4 * u.pn + wc) * 64 + 8 * fq) : (KN + (size_t)row0 * 128 + wc * 64 + 8 * fq);
        const int ostride = isq ? 512 : 128;
#pragma unroll
        for (int ai = 0; ai < 2; ++ai)
#pragma unroll
            for (int m = 0; m < 4; ++m) { const int rr = ai * HALF + m * 16;
                const f32x4 a0 = acc[ai][0][m][0] * F8_DQ_IN, a1 = acc[ai][0][m][1] * F8_DQ_IN, b0 = acc[ai][1][m][0] * F8_DQ_IN, b1 = acc[ai][1][m][1] * F8_DQ_IN;
                float ss = (a0[0] * a0[0] + a0[1] * a0[1]) + (a0[2] * a0[2] + a0[3] * a0[3]) + (a1[0] * a1[0] + a1[1] * a1[1]) + (a1[2] * a1[2] + a1[3] * a1[3])
                         + (b0[0] * b0[0] + b0[1] * b0[1]) + (b0[2] * b0[2] + b0[3] * b0[3]) + (b1[0] * b1[0] + b1[1] * b1[1]) + (b1[2] * b1[2] + b1[3] * b1[3]);
                ss += __builtin_bit_cast(float, __builtin_amdgcn_ds_bpermute((lane ^ 16) << 2, __builtin_bit_cast(int, ss)));
                ss += __builtin_bit_cast(float, __builtin_amdgcn_ds_bpermute((lane ^ 32) << 2, __builtin_bit_cast(int, ss)));
                const float rinv = qs / __builtin_sqrtf(ss * (1.0f / 64.0f) + 1e-6f);
                const float* rp = rope + (size_t)((row0 + rr) & 2047) * 64 + 8 * fq;
                const f32x4 c0 = *(const PG8_GAS f32x4*)(rp), c1 = *(const PG8_GAS f32x4*)(rp + 4), s0 = *(const PG8_GAS f32x4*)(rp + 32), s1 = *(const PG8_GAS f32x4*)(rp + 36);
                const f32x4 y10 = a0 * rinv * g1[0], y11 = a1 * rinv * g1[1], y20 = b0 * rinv * g2[0], y21 = b1 * rinv * g2[1];
                const f32x4 o10 = y10 * c0 - y20 * s0, o11 = y11 * c1 - y21 * s1, o20 = y20 * c0 + y10 * s0, o21 = y21 * c1 + y11 * s1;
                u32x4 w; w.x = cvt_pk_bf16(o10[0], o10[1]); w.y = cvt_pk_bf16(o10[2], o10[3]); w.z = cvt_pk_bf16(o11[0], o11[1]); w.w = cvt_pk_bf16(o11[2], o11[3]);
                *(PG8_GAS u32x4*)(op + (size_t)rr * ostride) = w;
                w.x = cvt_pk_bf16(o20[0], o20[1]); w.y = cvt_pk_bf16(o20[2], o20[3]); w.z = cvt_pk_bf16(o21[0], o21[1]); w.w = cvt_pk_bf16(o21[2], o21[3]);
                *(PG8_GAS u32x4*)(op + (size_t)rr * ostride + 32) = w; }
    }
};
__host__ __device__ __forceinline__ int inproj_row(int n) {
    if (n < 640) { const int head = n >> 6, d = n & 63, a = d >> 5, p = (d >> 4) & 1, f = d & 15; const int tile = head < 8 ? (head >> 2) : 2, wc = head & 3; return tile * 256 + 128 * p + 32 * wc + 16 * a + f; }
    if (n < 768) { const int c = n - 640, vh = c >> 6, d = c & 63; return 2 * 256 + 128 * (d >> 5) + 32 * (2 + vh) + (d & 31); }
    if (n < 1280) { const int c = n - 768; return (3 + (c >> 7)) * 256 + (c & 127); }
    { const int c = n - 1280; return (3 + (c >> 7)) * 256 + 128 + (c & 127); }
}
template <bool XIN_F32> struct EpiResGate {
    static constexpr bool PERM = true, AFTER_DRAIN = false, STAGED = false;
    const void* xin; bf16_t* xout; const float* gate;
    __device__ __forceinline__ void operator()(const f32x4 (&acc)[2][2][4][2], const Unit& u, int wr, int wc, int fr, int fq) const {
        const int row0 = u.pm * BM + wr * 64 + fr, col0 = u.pn * BM + wc * 32 + 8 * fq;
        const float* gp = gate + (size_t)((u.pm * BM) >> 11) * 6144 + col0;
        f32x4 gv[2][2];
#pragma unroll
        for (int bj = 0; bj < 2; ++bj)
#pragma unroll
            for (int n = 0; n < 2; ++n) gv[bj][n] = *(const PG8_GAS f32x4*)(gp + bj * HALF + 4 * n) * F8_DQ_OUT;
#pragma unroll
        for (int ai = 0; ai < 2; ++ai)
#pragma unroll
            for (int m = 0; m < 4; ++m) { const size_t ro = (size_t)(row0 + ai * HALF + m * 16) * 1024 + col0;
#pragma unroll
                for (int bj = 0; bj < 2; ++bj) { f32x4 x0, x1;
                    if constexpr (XIN_F32) { x0 = *(const PG8_GAS f32x4*)((const float*)xin + ro + bj * HALF); x1 = *(const PG8_GAS f32x4*)((const float*)xin + ro + bj * HALF + 4); }
                    else { const u32x4 xw = *(const PG8_GAS u32x4*)((const bf16_t*)xin + ro + bj * HALF);
                        x0 = (f32x4){__builtin_bit_cast(float, xw.x << 16), __builtin_bit_cast(float, xw.x & 0xffff0000u), __builtin_bit_cast(float, xw.y << 16), __builtin_bit_cast(float, xw.y & 0xffff0000u)};
                        x1 = (f32x4){__builtin_bit_cast(float, xw.z << 16), __builtin_bit_cast(float, xw.z & 0xffff0000u), __builtin_bit_cast(float, xw.w << 16), __builtin_bit_cast(float, xw.w & 0xffff0000u)}; }
                    const f32x4 v0 = x0 + gv[bj][0] * acc[ai][bj][m][0], v1 = x1 + gv[bj][1] * acc[ai][bj][m][1];
                    u32x4 w; w.x = cvt_pk_bf16(v0[0], v0[1]); w.y = cvt_pk_bf16(v0[2], v0[3]); w.z = cvt_pk_bf16(v1[0], v1[1]); w.w = cvt_pk_bf16(v1[2], v1[3]);
                    *(PG8_GAS u32x4*)(xout + ro + bj * HALF) = w; } }
    }
};
__device__ __forceinline__ unsigned pk4_fp8(float a, float b, float c, float d) {
    a = __builtin_amdgcn_fmed3f(a, -448.f, 448.f); b = __builtin_amdgcn_fmed3f(b, -448.f, 448.f); c = __builtin_amdgcn_fmed3f(c, -448.f, 448.f); d = __builtin_amdgcn_fmed3f(d, -448.f, 448.f);
    int w = 0; w = __builtin_amdgcn_cvt_pk_fp8_f32(a, b, w, false); w = __builtin_amdgcn_cvt_pk_fp8_f32(c, d, w, true); return (unsigned)w; }
struct EpiSwiglu {
    static constexpr bool PERM = true, AFTER_DRAIN = false, STAGED = true;
    __device__ __forceinline__ const float* stage_addr(const Unit& u, int tid) const { const int t8 = tid & 255; return b1 + (size_t)u.e * 2048 + (t8 < 128 ? u.pn * HALF + t8 : 1024 + u.pn * HALF + t8 - 128); }
    __device__ __forceinline__ float stage(const Unit& u, int tid) const { return tid < 256 ? ((const PG8_GAS float*)b1)[(size_t)u.e * 2048 + (tid < 128 ? u.pn * HALF + tid : 1024 + u.pn * HALF + tid - 128)] : 0.f; }
    unsigned char* O; const float* b1;
    typedef float f32x2 __attribute__((ext_vector_type(2)));
    __device__ __forceinline__ void operator()(const f32x4 (&acc)[2][2][4][2], const Unit& u, int wr, int wc, int fr, int fq, const PG8_LAS float* st) const {
        const int row0 = u.pm * BM + wr * 64 + fr; const int colh = u.pn * HALF + wc * 32 + 8 * fq;
        const PG8_LAS float* bp = st + wc * 32 + 8 * fq; constexpr float dq = 1.0f / (F8_SA * F8_SW);
        constexpr float NC = -1.702f * 1.4426950408889634f;
        f32x4 bg[2], bl[2];
#pragma unroll
        for (int n = 0; n < 2; ++n) { bg[n] = *(const PG8_LAS f32x4*)(bp + 4 * n); bl[n] = *(const PG8_LAS f32x4*)(bp + 128 + 4 * n) * F8_SACT + F8_SACT; }
        typedef unsigned u32x2 __attribute__((ext_vector_type(2)));
#pragma unroll
        for (int ai = 0; ai < 2; ++ai)
#pragma unroll
            for (int m = 0; m < 4; ++m) { f32x2 a[4];
#pragma unroll
                for (int n = 0; n < 2; ++n)
#pragma unroll
                    for (int h = 0; h < 2; ++h) { const f32x2 ag = (f32x2){acc[ai][0][m][n][2 * h], acc[ai][0][m][n][2 * h + 1]}, al = (f32x2){acc[ai][1][m][n][2 * h], acc[ai][1][m][n][2 * h + 1]};
                        const f32x2 bgv = (f32x2){bg[n][2 * h], bg[n][2 * h + 1]}, blv = (f32x2){bl[n][2 * h], bl[n][2 * h + 1]};
                        f32x2 g = ag * dq + bgv; g.x = __builtin_fminf(g.x, 7.0f); g.y = __builtin_fminf(g.y, 7.0f);
                        f32x2 l = al * (dq * F8_SACT) + blv; l.x = __builtin_amdgcn_fmed3f(l.x, -6.0f * F8_SACT, 8.0f * F8_SACT); l.y = __builtin_amdgcn_fmed3f(l.y, -6.0f * F8_SACT, 8.0f * F8_SACT);
                        f32x2 t = g * NC; t.x = __builtin_amdgcn_exp2f(t.x); t.y = __builtin_amdgcn_exp2f(t.y); t = t + 1.0f; t.x = __builtin_amdgcn_rcpf(t.x); t.y = __builtin_amdgcn_rcpf(t.y);
                        a[2 * n + h] = (g * t) * l; }
                u32x2 w; int w0 = 0, w1 = 0;
                w0 = __builtin_amdgcn_cvt_pk_fp8_f32(a[0].x, a[0].y, w0, false); w0 = __builtin_amdgcn_cvt_pk_fp8_f32(a[1].x, a[1].y, w0, true);
                w1 = __builtin_amdgcn_cvt_pk_fp8_f32(a[2].x, a[2].y, w1, false); w1 = __builtin_amdgcn_cvt_pk_fp8_f32(a[3].x, a[3].y, w1, true);
                w.x = (unsigned)w0; w.y = (unsigned)w1;
                *(PG8_GAS u32x2*)(O + (size_t)(row0 + ai * HALF + m * 16) * 1024 + colh) = w; }
    }
};
constexpr float F8_SY = 64.f;
struct EpiY {
    static constexpr bool PERM = true, AFTER_DRAIN = false, STAGED = true;
    unsigned char* O; const float* b2; const float* rowgate;
    __device__ __forceinline__ const float* stage_addr(const Unit& u, int tid) const { return tid < 256 ? rowgate + u.pm * BM + tid : b2 + (size_t)u.e * 1024 + u.pn * BM + tid - 256; }
    __device__ __forceinline__ float stage(const Unit& u, int tid) const { return tid < 256 ? ((const PG8_GAS float*)rowgate)[u.pm * BM + tid] : ((const PG8_GAS float*)b2)[(size_t)u.e * 1024 + u.pn * BM + tid - 256]; }
    __device__ __forceinline__ void operator()(const f32x4 (&acc)[2][2][4][2], const Unit& u, int wr, int wc, int fr, int fq, const PG8_LAS float* st) const {
        const int rl0 = wr * 64 + fr; const int col0 = u.pn * BM + wc * 32 + 8 * fq;
        const PG8_LAS float* bp = st + 256 + wc * 32 + 8 * fq; constexpr float dq = 1.0f / (F8_SACT * F8_SW);
        f32x4 bv[2][2];
#pragma unroll
        for (int bj = 0; bj < 2; ++bj)
#pragma unroll
            for (int n = 0; n < 2; ++n) bv[bj][n] = *(const PG8_LAS f32x4*)(bp + bj * HALF + 4 * n);
        typedef unsigned u32x2 __attribute__((ext_vector_type(2)));
#pragma unroll
        for (int ai = 0; ai < 2; ++ai)
#pragma unroll
            for (int m = 0; m < 4; ++m) { const int rl = rl0 + ai * HALF + m * 16; const float gt = st[rl] * F8_SY; unsigned char* rowp = O + (size_t)(u.pm * BM + rl) * 1024 + col0;
#pragma unroll
                for (int bj = 0; bj < 2; ++bj) { const f32x4 v0 = (acc[ai][bj][m][0] * dq + bv[bj][0]) * gt, v1 = (acc[ai][bj][m][1] * dq + bv[bj][1]) * gt;
                    u32x2 w; w.x = pk4_fp8(v0[0], v0[1], v0[2], v0[3]); w.y = pk4_fp8(v1[0], v1[1], v1[2], v1[3]);
                    *(PG8_GAS u32x2*)(rowp + bj * HALF) = w; } }
    }
};

template <class Epi, class Sched, bool ALIGN_EPI = false, bool SP2 = false, bool F8 = false>
__device__ __forceinline__ void gemm_phase(PG8_LAS unsigned char* lds, const Gemm g_in, const Sched& S, const Epi& E, const int tid_in) {
    Gemm g = g_in; g.A = pg8_uniform(g_in.A); g.Bt = pg8_uniform(g_in.Bt);
    int tid_ = tid_in; asm volatile("" : "+v"(tid_));
    const int tid = tid_, wid = __builtin_amdgcn_readfirstlane(tid >> 6), lane = tid & 63, wr = wid >> 2, wc = wid & 3, fr = lane & 15, fq = lane >> 4;
    const int K = g.K, nt = K / BK;
    unsigned voffA, voffB;
    { int R, C; stage_rc(tid * 16, R, C); const int Rb = Epi::PERM ? ((R & ~31) + perm32(R & 31)) : R; voffA = (unsigned)(R * K + C) * 2u; voffB = (unsigned)(Rb * K + C) * 2u; }
    constexpr bool GATHER = Sched::GATHER;
    unsigned tabR, tabC;
    { int R, C; stage_rc(tid * 16, R, C); tabR = (unsigned)R; tabC = (unsigned)C * 2u; }
    const unsigned rowb = (unsigned)K * 2u;
#define PG8_GA_RD(h, PAR) unsigned gr0_ = 0, gr1_ = 0; if constexpr (GATHER) { gr0_ = (unsigned)S.ptab[(PAR) * 256 + (h) * 128 + (int)tabR]; gr1_ = (unsigned)S.ptab[(PAR) * 256 + (h) * 128 + 64 + (int)tabR]; }
#define PG8_GA_IS(bufoff, kofs) do { unsigned vo0_ = gr0_ * rowb + tabC, vo1_ = gr1_ * rowb + tabC; asm volatile("" : "+v"(vo0_), "+v"(vo1_)); \
        __builtin_amdgcn_global_load_lds((const unsigned*)((const char*)g.A + (kofs) + vo0_), (PG8_LAS unsigned*)(lds + (bufoff) + ldsw), 16, 0, 0); \
        __builtin_amdgcn_global_load_lds((const unsigned*)((const char*)g.A + (kofs) + vo1_), (PG8_LAS unsigned*)(lds + (bufoff) + ldsw + 8192), 16, 0, 0); } while (0)
#define PG8_GA(bufoff, kofs, h, PAR) do { PG8_GA_RD(h, PAR); PG8_GA_IS(bufoff, kofs); } while (0)
#define PG8_STAGE_A2(bufoff, ptr, kofs) do { if constexpr (GATHER) { PG8_GA_IS(bufoff, kofs); } else { PG8_STAGE(bufoff, ptr, voffA); } } while (0)
#define PG8_STAGE_A(bufoff, ptr, kofs, h, PAR) do { if constexpr (GATHER) { PG8_GA(bufoff, kofs, h, PAR); } else { PG8_STAGE(bufoff, ptr, voffA); } } while (0)
    const size_t kstep = (size_t)(BK * 2);
    const size_t hstep = (size_t)HALF * K * 2;
    const size_t tstep = 2 * hstep;
    const unsigned ldsw = (unsigned)wid * 1024u;
    const int aoff = lds_byte(wr * 64 + fr, fq * 8), boff = lds_byte(wc * 32 + fr, fq * 8);
#define PG8_SA(b, h) (((b) * 2 + (h)) * HTB)
#define PG8_SB(b, h) ((4 + (b) * 2 + (h)) * HTB)
#define PG8_STAGE(bufoff, gbase, voff) do { _Pragma("unroll") for (int _i = 0; _i < 2; ++_i) { unsigned vo_ = (voff); asm volatile("" : "+v"(vo_));     \
        __builtin_amdgcn_global_load_lds((const unsigned*)((const char*)(gbase) + (size_t)_i * 64 * rowb + vo_), (PG8_LAS unsigned*)(lds + (bufoff) + ldsw + _i * 8192), 16, 0, 0); } } while (0)
#define PG8_LDA(dst, b, h) do { _Pragma("unroll") for (int m = 0; m < 4; ++m) _Pragma("unroll") for (int k = 0; k < 2; ++k) dst[m][k] = *(const PG8_LAS bf16x8*)(lds + PG8_SA(b, h) + aoff + m * 2048 + k * 1024); } while (0)
#define PG8_LDB(dst, b, h) do { _Pragma("unroll") for (int n = 0; n < 2; ++n) _Pragma("unroll") for (int k = 0; k < 2; ++k) dst[n][k] = *(const PG8_LAS bf16x8*)(lds + PG8_SB(b, h) + boff + n * 2048 + k * 1024); } while (0)
#define PG8_MMA(ai, bj, At, Bt) do { __builtin_amdgcn_s_setprio(1); if constexpr (F8) { _Pragma("unroll") for (int m = 0; m < 4; ++m) _Pragma("unroll") for (int n = 0; n < 2; ++n) \
        acc[ai][bj][m][n] = __builtin_amdgcn_mfma_scale_f32_16x16x128_f8f6f4(pg8_cat(Bt[n][0], Bt[n][1]), pg8_cat(At[m][0], At[m][1]), acc[ai][bj][m][n], 0, 0, 0, PG8_F8_SCALE, 0, PG8_F8_SCALE); } \
        else { _Pragma("unroll") for (int m = 0; m < 4; ++m) _Pragma("unroll") for (int n = 0; n < 2; ++n) _Pragma("unroll") for (int k = 0; k < 2; ++k) \
        acc[ai][bj][m][n] = __builtin_amdgcn_mfma_f32_16x16x32_bf16(Bt[n][k], At[m][k], acc[ai][bj][m][n], 0, 0, 0); } __builtin_amdgcn_s_setprio(0); } while (0)
#define PG8_WAIT_V(n) asm volatile("s_waitcnt vmcnt(" #n ")" ::: "memory")
#define PG8_WAIT_L(n) asm volatile("s_waitcnt lgkmcnt(" #n ")" ::: "memory")
#define PG8_BAR __builtin_amdgcn_s_barrier()
#define PG8_SCHED __builtin_amdgcn_sched_barrier(0)
    Unit cur, nxt; int ui = 0;
    if (!S.next(0, cur)) return;
    f32x4 acc[2][2][4][2];
#pragma unroll
    for (int a = 0; a < 2; ++a)
#pragma unroll
        for (int b = 0; b < 2; ++b)
#pragma unroll
            for (int m = 0; m < 4; ++m)
#pragma unroll
                for (int n = 0; n < 2; ++n) acc[a][b][m][n] = (f32x4){0.f, 0.f, 0.f, 0.f};
    bf16x8 At[4][2], B0[2][2], B1[2][2];
    const char* cA = (const char*)g.A + (size_t)cur.pm * tstep; const char* cB = (const char*)g.Bt + (size_t)cur.e * g.estride + (size_t)cur.pn * tstep;
    S.a_ready(cur);
    int par = 0;
    PG8_LAS float* const etab = (PG8_LAS float*)(lds + STAGE_BYTES + 4096 + 2048);
    if constexpr (Epi::STAGED) { etab[tid] = E.stage(cur, tid); if constexpr (!GATHER) { PG8_WAIT_L(0); PG8_BAR; } }
    if constexpr (GATHER) { if (tid < 256) { unsigned po_ = (unsigned)(cur.pm * 256 + tid) * 4u; asm volatile("" : "+v"(po_)); S.ptab[tid] = *(const __attribute__((address_space(1))) int*)((const char*)S.perm + po_); } PG8_WAIT_L(0); PG8_BAR; }
    if constexpr (SP2) {
        PG8_STAGE(PG8_SB(0, 0), cB, voffB); PG8_STAGE(PG8_SB(0, 1), cB + hstep, voffB); PG8_STAGE_A(PG8_SA(0, 0), cA, (size_t)0, 0, par); PG8_STAGE_A(PG8_SA(0, 1), cA + hstep, (size_t)0, 1, par);
        if (wr == 1) PG8_BAR;
        PG8_WAIT_V(2); PG8_BAR;
        PG8_STAGE(PG8_SB(1, 0), cB + kstep, voffB); PG8_STAGE_A(PG8_SA(1, 0), cA + kstep, kstep, 0, par); PG8_STAGE(PG8_SB(1, 1), cB + hstep + kstep, voffB);
        PG8_WAIT_V(6); PG8_BAR;
    } else {
        PG8_STAGE(PG8_SB(0, 0), cB, voffB); PG8_STAGE_A(PG8_SA(0, 0), cA, (size_t)0, 0, par); PG8_STAGE(PG8_SB(0, 1), cB + hstep, voffB); PG8_STAGE_A(PG8_SA(0, 1), cA + hstep, (size_t)0, 1, par);
        if (wr == 1) PG8_BAR;
        PG8_WAIT_V(4); PG8_BAR;
        PG8_STAGE(PG8_SB(1, 0), cB + kstep, voffB); PG8_STAGE_A(PG8_SA(1, 0), cA + kstep, kstep, 0, par); PG8_STAGE(PG8_SB(1, 1), cB + hstep + kstep, voffB);
        PG8_WAIT_V(6); PG8_BAR;
    }
    for (;;) {
        const bool has_next = S.next(ui + 1, nxt);
        const char* nA = has_next ? (const char*)g.A + (size_t)nxt.pm * tstep : cA; const char* nB = has_next ? (const char*)g.Bt + (size_t)nxt.e * g.estride + (size_t)nxt.pn * tstep : cB;
        int pv = 0; if constexpr (GATHER) { if (has_next) { unsigned po_ = (unsigned)(nxt.pm * 256 + (tid & 255)) * 4u; asm volatile("" : "+v"(po_)); const int* pa_ = (const int*)((const char*)S.perm + po_); asm volatile("global_load_dword %0, %1, off" : "+v"(pv) : "v"(pa_) : "memory"); } }
        const int npar = has_next ? (par ^ 1) : par;
        float ev = 0.f; if constexpr (Epi::STAGED) { if (has_next) { const float* ea_ = E.stage_addr(nxt, tid); asm volatile("global_load_dword %0, %1, off" : "+v"(ev) : "v"(ea_) : "memory"); } }
#pragma unroll 1
        for (int t = 0; t < nt; t += 2) {
            const bool last = (t == nt - 2);
            if constexpr (GATHER) { if (t == 2 && has_next) { int tl_ = tid; asm volatile("" : "+v"(tl_)); if (tl_ < 256) S.ptab[(par ^ 1) * 256 + tl_] = pv; } }
            if constexpr (Epi::STAGED) { if (t == 2 && has_next) { int tl_ = tid; asm volatile("" : "+v"(tl_)); etab[(par ^ 1) * 512 + tl_] = ev; } }
            const size_t k2 = last ? (size_t)0 : (size_t)(t + 2) * kstep; const int p2 = last ? npar : par;
            const char* a1 = cA + (size_t)(t + 1) * kstep;
            const char* a2 = last ? nA : cA + (size_t)(t + 2) * kstep; const char* b2 = last ? nB : cB + (size_t)(t + 2) * kstep;
            const char* a3 = a2 + kstep; const char* b3 = b2 + kstep;
            if (last && has_next) S.a_ready(nxt);
            if constexpr (SP2) {
            { PG8_GA_RD(1, par); PG8_LDB(B0, 0, 0); PG8_LDB(B1, 0, 1); PG8_SCHED; PG8_LDA(At, 0, 0); PG8_STAGE_A2(PG8_SA(1, 1), a1 + hstep, (size_t)(t + 1) * kstep); }
            PG8_WAIT_V(8); PG8_WAIT_L(0); PG8_BAR; PG8_MMA(0, 0, At, B0); PG8_MMA(0, 1, At, B1); PG8_BAR; PG8_SCHED;
            { PG8_GA_RD(0, p2); PG8_LDA(At, 0, 1); PG8_STAGE(PG8_SB(0, 0), b2, voffB); PG8_STAGE(PG8_SB(0, 1), b2 + hstep, voffB); PG8_STAGE_A2(PG8_SA(0, 0), a2, k2); }
            PG8_WAIT_V(8); PG8_WAIT_L(0); PG8_BAR; PG8_MMA(1, 0, At, B0); PG8_MMA(1, 1, At, B1); PG8_BAR; PG8_SCHED;
            { PG8_GA_RD(1, p2); PG8_LDB(B0, 1, 0); PG8_LDB(B1, 1, 1); PG8_SCHED; PG8_LDA(At, 1, 0); PG8_STAGE_A2(PG8_SA(0, 1), a2 + hstep, k2); }
            PG8_WAIT_V(8); PG8_WAIT_L(0); PG8_BAR; PG8_MMA(0, 0, At, B0); PG8_MMA(0, 1, At, B1); PG8_BAR; PG8_SCHED;
            { PG8_GA_RD(0, p2); PG8_LDA(At, 1, 1); PG8_STAGE(PG8_SB(1, 0), b3, voffB); PG8_STAGE(PG8_SB(1, 1), b3 + hstep, voffB); PG8_STAGE_A2(PG8_SA(1, 0), a3, k2 + kstep); }
            PG8_WAIT_V(8); PG8_WAIT_L(0); PG8_BAR; PG8_MMA(1, 0, At, B0); PG8_MMA(1, 1, At, B1); PG8_BAR; PG8_SCHED;
            } else {
            { PG8_GA_RD(1, par); PG8_LDB(B0, 0, 0); PG8_SCHED; PG8_LDA(At, 0, 0); PG8_STAGE_A2(PG8_SA(1, 1), a1 + hstep, (size_t)(t + 1) * kstep); }
            PG8_WAIT_L(8); PG8_BAR; PG8_WAIT_L(0); PG8_MMA(0, 0, At, B0); PG8_BAR; PG8_SCHED;
            PG8_LDB(B1, 0, 1); PG8_STAGE(PG8_SB(0, 0), b2, voffB);
            PG8_BAR; PG8_WAIT_L(0); PG8_MMA(0, 1, At, B1); PG8_BAR;
            { PG8_GA_RD(0, p2); PG8_LDA(At, 0, 1); PG8_STAGE_A2(PG8_SA(0, 0), a2, k2); }
            PG8_BAR; PG8_WAIT_L(0); PG8_MMA(1, 0, At, B0); PG8_BAR; PG8_SCHED;
            PG8_STAGE(PG8_SB(0, 1), b2 + hstep, voffB);
            PG8_WAIT_V(6); PG8_BAR; PG8_MMA(1, 1, At, B1); PG8_BAR;
            { PG8_GA_RD(1, p2); PG8_LDB(B0, 1, 0); PG8_SCHED; PG8_LDA(At, 1, 0); PG8_STAGE_A2(PG8_SA(0, 1), a2 + hstep, k2); }
            PG8_WAIT_L(8); PG8_BAR; PG8_WAIT_L(0); PG8_MMA(0, 0, At, B0); PG8_BAR; PG8_SCHED;
            PG8_LDB(B1, 1, 1); PG8_STAGE(PG8_SB(1, 0), b3, voffB);
            PG8_BAR; PG8_WAIT_L(0); PG8_MMA(0, 1, At, B1); PG8_BAR;
            { PG8_GA_RD(0, p2); PG8_LDA(At, 1, 1); PG8_STAGE_A2(PG8_SA(1, 0), a3, k2 + kstep); }
            PG8_BAR; PG8_WAIT_L(0); PG8_MMA(1, 0, At, B0); PG8_BAR; PG8_SCHED;
            PG8_STAGE(PG8_SB(1, 1), b3 + hstep, voffB);
            PG8_WAIT_V(6); PG8_BAR; PG8_MMA(1, 1, At, B1); PG8_BAR;
            }
        }
        if constexpr (ALIGN_EPI) { if (wr == 0) PG8_BAR; }
        if constexpr (!Epi::AFTER_DRAIN) { int tl_ = tid; asm volatile("" : "+v"(tl_)); const int ln_ = tl_ & 63;
            if constexpr (Epi::STAGED) E(acc, cur, wr, wc, ln_ & 15, ln_ >> 4, etab + par * 512); else E(acc, cur, wr, wc, ln_ & 15, ln_ >> 4);
#ifdef DBG_EPI2
            if constexpr (F8 && Sched::GATHER) { asm volatile("" : "+v"(tl_)); const int l2_ = tl_ & 63; E(acc, cur, wr, wc, l2_ & 15, l2_ >> 4, etab + par * 512); }
#endif
#ifdef DBG_EPI2Y
            if constexpr (F8 && !Sched::GATHER && !SP2) { asm volatile("" : "+v"(tl_)); const int l2_ = tl_ & 63; E(acc, cur, wr, wc, l2_ & 15, l2_ >> 4, etab + par * 512); }
#endif
            S.done(cur); }
        if (!has_next) break;
#pragma unroll
        for (int a = 0; a < 2; ++a)
#pragma unroll
            for (int b = 0; b < 2; ++b)
#pragma unroll
                for (int m = 0; m < 4; ++m)
#pragma unroll
                    for (int n = 0; n < 2; ++n) acc[a][b][m][n] = (f32x4){0.f, 0.f, 0.f, 0.f};
        cur = nxt; cA = nA; cB = nB; ++ui; par = npar;
        if constexpr (ALIGN_EPI) { if (wr == 1) PG8_BAR; }
    }
    PG8_WAIT_V(0);
    if constexpr (!ALIGN_EPI) { if (wr == 0) PG8_BAR; }
    PG8_BAR;
    if constexpr (Epi::AFTER_DRAIN) { E.fused(acc, cur, wr, wc, fr, fq, lds, wid, lane); S.done(cur); }
#undef PG8_SA
#undef PG8_SB
#undef PG8_STAGE
#undef PG8_GA
#undef PG8_GA_RD
#undef PG8_GA_IS
#undef PG8_STAGE_A2
#undef PG8_STAGE_A
#undef PG8_LDA
#undef PG8_LDB
#undef PG8_MMA
#undef PG8_WAIT_V
#undef PG8_WAIT_L
#undef PG8_BAR
#undef PG8_SCHED
}
}
namespace attn_body {
using bf16=__hip_bfloat16;
using bf16x8=__attribute__((ext_vector_type(8)))short;
using s16x4=__attribute__((ext_vector_type(4)))short;
using f32x16=__attribute__((ext_vector_type(16)))float;
using u32x4=__attribute__((ext_vector_type(4)))unsigned;
constexpr int BATCH=32,NHEAD=8,NGRP=4,SEQ=2048,D=64;
constexpr int PQ=512,PK=128,PV=128,PO=1024;
constexpr float ATTN_OSCALE=16.f;
constexpr int NW=8,QBLK=32,QB=QBLK*NW,KVBLK=64,NQB=SEQ/QB;
constexpr int ATTN_UNIT_ROWS=QB;
__device__ __forceinline__ int crow(int r,int hi){return (r&3)+8*(r>>2)+4*hi;}
#define SBAR() __builtin_amdgcn_sched_barrier(0)
__device__ __forceinline__ void cmask(f32x16&p0,f32x16&p1,int jb,int qrel,int hi){
  const float NEG=-INFINITY; int kb=64*jb+4*hi;
  #pragma unroll
  for(int r=0;r<16;++r){int kv=kb+(r&3)+8*(r>>2); if(kv>qrel)p0[r]=NEG; if(kv+32>qrel)p1[r]=NEG;}
}

constexpr int NSLOT=3, SLOTB=8192;
constexpr int LDS_K=0, LDS_V=NSLOT*SLOTB, LDS_WS=2*NSLOT*SLOTB, LDS_OST=LDS_WS+NW*64*4, LDS_BYTES=LDS_OST+NW*4096;
constexpr float C2=0.125f*1.4426950408889634f;
__device__ __forceinline__ void glds16(const void*gsrc,unsigned lds_dst){unsigned keep;
  asm volatile("s_mov_b32 %0, m0\n\ts_mov_b32 m0, %2\n\ts_nop 0\n\tglobal_load_lds_dwordx4 %1, off\n\ts_mov_b32 m0, %0":"=&s"(keep):"v"(gsrc),"s"(lds_dst):"memory");}
__device__ __forceinline__ float max3f(float a,float b,float c){float r;asm("v_max3_f32 %0, %1, %2, %3":"=v"(r):"v"(a),"v"(b),"v"(c));return r;}
__device__ __forceinline__ float max2f(float a,float b){float r;asm("v_max_f32_e32 %0, %1, %2":"=v"(r):"v"(a),"v"(b));return r;}
__device__ __forceinline__ float fadd_s(float a,float b){float r;asm("v_add_f32_e32 %0, %1, %2":"=v"(r):"v"(a),"v"(b));return r;}
__device__ __forceinline__ float fsub_s(float a,float b){float r;asm("v_sub_f32_e32 %0, %1, %2":"=v"(r):"v"(a),"v"(b));return r;}
typedef float f32x2_t __attribute__((ext_vector_type(2))); typedef __bf16 bf16x2_t __attribute__((ext_vector_type(2)));
__device__ __forceinline__ unsigned cvtpk_s(float lo,float hi){f32x2_t v={lo,hi};bf16x2_t b=__builtin_convertvector(v,bf16x2_t);return __builtin_bit_cast(unsigned,b);}
#define WAIT_BAR(N) asm volatile("s_waitcnt vmcnt(" #N ") lgkmcnt(0)\n\ts_barrier":::"memory")

__device__ __forceinline__ void qkt(f32x16&p0,f32x16&p1,const char*Kslot,const bf16x8*qr,const f32x16&negm,int r32,int hi){
  const char*kb=Kslot+hi*1024+r32*16;
  #pragma unroll
  for(int d0=0;d0<4;++d0){
    const bf16x8 b0=*reinterpret_cast<const bf16x8*>(kb+d0*2048);
    const bf16x8 b1=*reinterpret_cast<const bf16x8*>(kb+d0*2048+512);
    if(d0==0){p0=__builtin_amdgcn_mfma_f32_32x32x16_bf16(b0,qr[0],negm,0,0,0);p1=__builtin_amdgcn_mfma_f32_32x32x16_bf16(b1,qr[0],negm,0,0,0);}
    else{p0=__builtin_amdgcn_mfma_f32_32x32x16_bf16(b0,qr[d0],p0,0,0,0);p1=__builtin_amdgcn_mfma_f32_32x32x16_bf16(b1,qr[d0],p1,0,0,0);}}
}
typedef __attribute__((address_space(3))) const char* lds_cptr;
typedef short v4i16_t __attribute__((ext_vector_type(4)));
__device__ __forceinline__ void kload8(bf16x8*kf,lds_cptr kp){
  kf[0]=*(const __attribute__((address_space(3))) bf16x8*)(kp);      kf[1]=*(const __attribute__((address_space(3))) bf16x8*)(kp+512);
  kf[2]=*(const __attribute__((address_space(3))) bf16x8*)(kp+2048); kf[3]=*(const __attribute__((address_space(3))) bf16x8*)(kp+2560);
  kf[4]=*(const __attribute__((address_space(3))) bf16x8*)(kp+4096); kf[5]=*(const __attribute__((address_space(3))) bf16x8*)(kp+4608);
  kf[6]=*(const __attribute__((address_space(3))) bf16x8*)(kp+6144); kf[7]=*(const __attribute__((address_space(3))) bf16x8*)(kp+6656);
}
__device__ __forceinline__ void kload2(bf16x8*kf,lds_cptr kp,int j){ kf[2*j]=*(const __attribute__((address_space(3))) bf16x8*)(kp+j*2048); kf[2*j+1]=*(const __attribute__((address_space(3))) bf16x8*)(kp+j*2048+512); }
__device__ __forceinline__ s16x4 vtr(lds_cptr p){ return __builtin_bit_cast(s16x4,__builtin_amdgcn_ds_read_tr16_b64_v4i16((__attribute__((address_space(3))) v4i16_t*)p)); }
__device__ __forceinline__ float rowmax(const f32x16&p0,const f32x16&p1){
  float a=max3f(p0[0],p0[1],p1[0]),b=max3f(p0[2],p0[3],p1[1]);a=max3f(a,p1[2],p1[3]);
  #pragma unroll
  for(int r=4;r<16;r+=4){a=max3f(a,p0[r],p0[r+1]);b=max3f(b,p0[r+2],p0[r+3]);a=max3f(a,p1[r],p1[r+1]);b=max3f(b,p1[r+2],p1[r+3]);}
  const float m=max2f(a,b);
  auto rr=__builtin_amdgcn_permlane32_swap(__float_as_uint(m),__float_as_uint(m),false,false);
  return max2f(__uint_as_float(rr[0]),__uint_as_float(rr[1]));
}
__device__ __forceinline__ void pv(f32x16*o,int vb,bf16x8 pa0,bf16x8 pa1,bf16x8 pa2,bf16x8 pa3){
  #pragma unroll
  for(int d0=0;d0<2;++d0){s16x4 lo[4],hi[4];
    #pragma unroll
    for(int ks=0;ks<4;++ks){
      asm volatile("ds_read_b64_tr_b16 %0,%1 offset:%c2":"=&v"(lo[ks]):"v"(vb),"i"(d0*4096+ks*1024):"memory");
      asm volatile("ds_read_b64_tr_b16 %0,%1 offset:%c2":"=&v"(hi[ks]):"v"(vb),"i"(d0*4096+ks*1024+512):"memory");}
    asm volatile("s_waitcnt lgkmcnt(0)":::"memory");SBAR();
    #define PK(k) (bf16x8){lo[k][0],lo[k][1],lo[k][2],lo[k][3],hi[k][0],hi[k][1],hi[k][2],hi[k][3]}
    o[d0]=__builtin_amdgcn_mfma_f32_32x32x16_bf16(pa0,PK(0),o[d0],0,0,0);
    o[d0]=__builtin_amdgcn_mfma_f32_32x32x16_bf16(pa1,PK(1),o[d0],0,0,0);
    o[d0]=__builtin_amdgcn_mfma_f32_32x32x16_bf16(pa2,PK(2),o[d0],0,0,0);
    o[d0]=__builtin_amdgcn_mfma_f32_32x32x16_bf16(pa3,PK(3),o[d0],0,0,0);
    #undef PK
  }
}

#ifndef ATTN_STORE16
#define ATTN_STORE16(p,v) (*(u32x4*)(p)=(v))
#endif
template<int THRL,bool FIXED> __device__ __forceinline__ void attn_unit(int b,int h,int qb,const bf16*Q,const bf16*__restrict__ K,const bf16*__restrict__ V,bf16*O,char*shm,const int tid_in,const float mfix){
  int tid_=tid_in; asm volatile("":"+v"(tid_)); const int tid=tid_,lane=tid&63,r32=lane&31,hi=lane>>5; const int wid=__builtin_amdgcn_readfirstlane(tid>>6);
  const long rowbase=(long)b*SEQ; const int q0=qb*QB;
  const bf16*Qw=Q+(rowbase+q0+wid*QBLK)*PQ+h*D;
  const bf16*Kh=K+rowbase*PK+(h/NGRP)*D,*Vh=V+rowbase*PV+(h/NGRP)*D;
  const unsigned lds0=(unsigned)(uintptr_t)shm;
  float*wsf=(float*)(shm+LDS_WS)+wid*64;
  const bf16*ksrc=Kh+(long)lane*PK+wid*8;
  const bf16*vsrc=Vh+(long)(16*(wid&3)+(lane>>2))*PV+(wid>>2)*32+(lane&3)*8;
  const unsigned kdst=lds0+LDS_K+wid*1024, vdst=lds0+LDS_V+wid*1024;
  #define DMA_K(t,slot) glds16(ksrc+(long)(t)*KVBLK*PK,(unsigned)__builtin_amdgcn_readfirstlane(kdst+(slot)))
  #define DMA_V(t,slot) glds16(vsrc+(long)(t)*KVBLK*PV,(unsigned)__builtin_amdgcn_readfirstlane(vdst+(slot)))
  const int vb0=(int)(lds0+LDS_V)+((lane>>4)&1)*32+(lane&3)*8+(4*hi+((lane&15)>>2))*64;
  const char*Kbase=shm+LDS_K; bf16x8 kf[8];
  const lds_cptr shm3=(lds_cptr)shm; const lds_cptr kp0=shm3+LDS_K+hi*1024+r32*16; const lds_cptr vp0=shm3+LDS_V+((lane>>4)&1)*32+(lane&3)*8+(4*hi+((lane&15)>>2))*64;
  constexpr int NT=SEQ/KVBLK;
  DMA_K(0,0);DMA_V(0,0);DMA_K(1,SLOTB);
  bf16x8 qr[4];
  #pragma unroll
  for(int d0=0;d0<4;++d0)qr[d0]=*(const __attribute__((address_space(1))) bf16x8*)(&Qw[(long)r32*PQ+d0*16+hi*8]);
  float mhat=0.f,l_reg=0.f;f32x16 o[2];o[0]=f32x16{};o[1]=f32x16{};f32x16 negm=f32x16{}; if constexpr(!FIXED){ asm volatile("":"+v"(negm)); } (void)mfix;
  #define NEGMC (FIXED?f32x16{}:negm)
  #define CMASK(P0,P1,t) do{}while(0)
  bool resc=false; f32x16 ol=f32x16{}; const bf16x8 ONES={0x3F80,0x3F80,0x3F80,0x3F80,0x3F80,0x3F80,0x3F80,0x3F80};
  #define START(P0,P1) do{ if constexpr(!FIXED){ const float rm=rowmax(P0,P1); resc=false; \
    { const float dl=rm; mhat=fadd_s(mhat,dl); \
      _Pragma("unroll") for(int r=0;r<16;++r){P0[r]=fsub_s(P0[r],dl);P1[r]=fsub_s(P1[r],dl);} \
      _Pragma("unroll") for(int r=0;r<16;++r)negm[r]=-mhat; asm volatile("":"+v"(negm)); } } \
    _Pragma("unroll") for(int r=0;r<16;++r)P0[r]=__builtin_amdgcn_exp2f(P0[r]); }while(0)
  #define RESC() do{ if(resc){ asm volatile("s_waitcnt lgkmcnt(0)":::"memory"); \
      _Pragma("unroll") for(int d_=0;d_<2;++d_) _Pragma("unroll") for(int r=0;r<16;++r)o[d_][r]*=wsf[crow(r,hi)]; } }while(0)
  f32x16 pA0,pA1,pB0,pB1;
  int sl_prev=0,sl_cur=0,sl_next=SLOTB;
  #define ROT() do{sl_prev=sl_cur;sl_cur=sl_next;sl_next=(sl_next==(NSLOT-1)*SLOTB)?0:sl_next+SLOTB;}while(0)
  DMA_K(2,2*SLOTB);
  WAIT_BAR(3);
  qkt(pA0,pA1,Kbase,qr,NEGMC,r32,hi);asm volatile("s_nop 15\n\ts_nop 7":"+v"(pA0),"+v"(pA1));CMASK(pA0,pA1,0);
  START(pA0,pA1);
  _Pragma("unroll") for(int r=0;r<16;++r)pA1[r]=__builtin_amdgcn_exp2f(pA1[r]);
  WAIT_BAR(0);
  DMA_K(3,0);DMA_V(1,SLOTB);
  ROT();
  kload8(kf,kp0+sl_cur);
  WAIT_BAR(2);
  s16x4 vlo[8],vhi[8]; u32x4 pw0,pw1,pw2,pw3;
  #define PKW(P,B) cvtpk_s(P[B],P[B+1])
  #define PAF(k) __builtin_bit_cast(bf16x8,pw##k)
  #define VFR(i) (bf16x8){vlo[i][0],vlo[i][1],vlo[i][2],vlo[i][3],vhi[i][0],vhi[i][1],vhi[i][2],vhi[i][3]}
  #define PIN(x) asm volatile("":"+v"(x))
  #define MX3(a,b,c) __builtin_fmaxf(__builtin_fmaxf((a),(b)),(c))
  #define GAPA(MF,A0,A1,A2,A3,W0,W1,PW) do{ MF; if constexpr(!FIXED){ sacc+=A0; sacc+=A1; sacc+=A2; sacc+=A3; PIN(sacc); } W0; W1; PIN(PW); SBAR(); }while(0)
  #define OLM(k) do{ if constexpr(FIXED){ ol=__builtin_amdgcn_mfma_f32_32x32x16_bf16(PAF(k),ONES,ol,0,0,0); SBAR(); } }while(0)
  #define EX(v) __builtin_amdgcn_exp2f(v)
  #define GAPB(MF,X,B) do{ MF; X[B]=EX(X[B]); X[B+1]=EX(X[B+1]); X[B+2]=EX(X[B+2]); X[B+3]=EX(X[B+3]); PIN(X); SBAR(); }while(0)
  #define VRD(i) do{ vlo[i]=vtr(vp_+(((i)>>2)*4096+((i)&3)*1024)); vhi[i]=vtr(vp_+(((i)>>2)*4096+((i)&3)*1024+512)); }while(0)
  #define KRD(G,j) do{ if(G){ kload2(kf,kp0+sl_next,j); SBAR(); } }while(0)
  #define STEP(C0,C1,P0,P1,t,GK,GV,GL) do{ SBAR(); \
    const lds_cptr vp_=vp0+sl_prev; \
    VRD(0); SBAR(); float sacc=0.f; if constexpr(!FIXED)sacc=(P0[0]+P0[1]); \
    GAPA(C0=__builtin_amdgcn_mfma_f32_32x32x16_bf16(kf[0],qr[0],NEGMC,0,0,0), P0[2],P0[3],P0[4],P0[5],     pw0[0]=PKW(P0,0), pw0[1]=PKW(P0,2), pw0); \
    VRD(4); SBAR(); GAPA(C1=__builtin_amdgcn_mfma_f32_32x32x16_bf16(kf[1],qr[0],NEGMC,0,0,0), P0[6],P0[7],P0[8],P0[9],     pw0[2]=PKW(P0,4), pw0[3]=PKW(P0,6), pw0); \
    VRD(1); SBAR(); GAPA(C0=__builtin_amdgcn_mfma_f32_32x32x16_bf16(kf[2],qr[1],C0,0,0,0),   P0[10],P0[11],P0[12],P0[13], pw1[0]=PKW(P0,8), pw1[1]=PKW(P0,10), pw1); \
    VRD(5); SBAR(); GAPA(C1=__builtin_amdgcn_mfma_f32_32x32x16_bf16(kf[3],qr[1],C1,0,0,0),   P0[14],P0[15],P1[0],P1[1],   pw1[2]=PKW(P0,12),pw1[3]=PKW(P0,14), pw1); \
    VRD(2); SBAR(); GAPA(C0=__builtin_amdgcn_mfma_f32_32x32x16_bf16(kf[4],qr[2],C0,0,0,0),   P1[2],P1[3],P1[4],P1[5],     pw2[0]=PKW(P1,0), pw2[1]=PKW(P1,2), pw2); \
    VRD(6); SBAR(); GAPA(C1=__builtin_amdgcn_mfma_f32_32x32x16_bf16(kf[5],qr[2],C1,0,0,0),   P1[6],P1[7],P1[8],P1[9],     pw2[2]=PKW(P1,4), pw2[3]=PKW(P1,6), pw2); \
    VRD(3); SBAR(); GAPA(C0=__builtin_amdgcn_mfma_f32_32x32x16_bf16(kf[6],qr[3],C0,0,0,0),   P1[10],P1[11],P1[12],P1[13], pw3[0]=PKW(P1,8), pw3[1]=PKW(P1,10), pw3); \
    VRD(7); SBAR(); GAPA(C1=__builtin_amdgcn_mfma_f32_32x32x16_bf16(kf[7],qr[3],C1,0,0,0),   P1[14],P1[15],0.f,0.f,       pw3[2]=PKW(P1,12),pw3[3]=PKW(P1,14), pw3); \
    l_reg+=sacc; \
    if(GK){DMA_K((t)+3,sl_cur);} if(GV){DMA_V((t)+1,sl_next);} \
    CMASK(C0,C1,t); \
    if constexpr(!FIXED){ float a=MX3(C0[0],C0[1],C1[0]),b=MX3(C0[2],C0[3],C1[1]); a=MX3(a,C1[2],C1[3]); \
      _Pragma("unroll") for(int r=4;r<16;r+=4){a=MX3(a,C0[r],C0[r+1]);b=MX3(b,C0[r+2],C0[r+3]);a=MX3(a,C1[r],C1[r+1]);b=MX3(b,C1[r+2],C1[r+3]);} \
      float rm=__builtin_fmaxf(a,b); { auto rr=__builtin_amdgcn_permlane32_swap(__float_as_uint(rm),__float_as_uint(rm),false,false); rm=__builtin_fmaxf(__uint_as_float(rr[0]),__uint_as_float(rr[1])); } \
      resc=false; \
      if(__builtin_expect(__any(rm>(float)THRL),0)){ const float dl=__builtin_fmaxf(rm,0.f); mhat+=dl; \
        _Pragma("unroll") for(int r=0;r<16;++r){C0[r]-=dl;C1[r]-=dl;} \
        _Pragma("unroll") for(int r=0;r<16;++r)negm[r]=-mhat; asm volatile("":"+v"(negm)); \
        const float f=__builtin_amdgcn_exp2f(-dl); l_reg*=f; if(hi==0)wsf[r32]=f; resc=true; } } \
    SBAR(); \
    GAPB(o[0]=__builtin_amdgcn_mfma_f32_32x32x16_bf16(PAF(0),VFR(0),o[0],0,0,0), C0,0); \
    GAPB(o[1]=__builtin_amdgcn_mfma_f32_32x32x16_bf16(PAF(0),VFR(4),o[1],0,0,0), C0,4); OLM(0); \
    KRD(GL,0); GAPB(o[0]=__builtin_amdgcn_mfma_f32_32x32x16_bf16(PAF(1),VFR(1),o[0],0,0,0), C0,8); \
    KRD(GL,1); GAPB(o[1]=__builtin_amdgcn_mfma_f32_32x32x16_bf16(PAF(1),VFR(5),o[1],0,0,0), C0,12); OLM(1); \
    KRD(GL,2); GAPB(o[0]=__builtin_amdgcn_mfma_f32_32x32x16_bf16(PAF(2),VFR(2),o[0],0,0,0), C1,0); \
    KRD(GL,3); GAPB(o[1]=__builtin_amdgcn_mfma_f32_32x32x16_bf16(PAF(2),VFR(6),o[1],0,0,0), C1,4); OLM(2); \
    GAPB(o[0]=__builtin_amdgcn_mfma_f32_32x32x16_bf16(PAF(3),VFR(3),o[0],0,0,0), C1,8); \
    GAPB(o[1]=__builtin_amdgcn_mfma_f32_32x32x16_bf16(PAF(3),VFR(7),o[1],0,0,0), C1,12); OLM(3); \
    }while(0)
  int t=1;
  #undef CMASK
  #define CMASK(P0,P1,t) do{}while(0)
  for(;t+5<NT;t+=2){
    STEP(pB0,pB1,pA0,pA1,t,true,true,true);     WAIT_BAR(2); RESC(); ROT();
    STEP(pA0,pA1,pB0,pB1,t+1,true,true,true);   WAIT_BAR(2); RESC(); ROT();
  }
  #undef CMASK
  #define CMASK(P0,P1,t) do{}while(0)
  #define ENDW(tt) do{ if((tt)+3<NT){WAIT_BAR(2);} else if((tt)+2<NT){WAIT_BAR(1);} else {WAIT_BAR(0);} }while(0)
  for(;t+1<NT;t+=2){
    STEP(pB0,pB1,pA0,pA1,t,(t+3<NT),(t+1<NT),(t+1<NT));       ENDW(t);   RESC(); ROT();
    STEP(pA0,pA1,pB0,pB1,t+1,(t+4<NT),(t+2<NT),(t+2<NT));     ENDW(t+1); RESC(); ROT();
  }
  STEP(pB0,pB1,pA0,pA1,NT-1,false,false,false); RESC();
  { float sacc=pB0[0]+pB0[1]; _Pragma("unroll") for(int r=2;r<16;++r)sacc+=pB0[r]; _Pragma("unroll") for(int r=0;r<16;++r)sacc+=pB1[r]; l_reg+=sacc;
    pw0=(u32x4){PKW(pB0,0),PKW(pB0,2),PKW(pB0,4),PKW(pB0,6)};pw1=(u32x4){PKW(pB0,8),PKW(pB0,10),PKW(pB0,12),PKW(pB0,14)};pw2=(u32x4){PKW(pB1,0),PKW(pB1,2),PKW(pB1,4),PKW(pB1,6)};pw3=(u32x4){PKW(pB1,8),PKW(pB1,10),PKW(pB1,12),PKW(pB1,14)};
    SBAR(); pv(o,vb0+sl_cur,PAF(0),PAF(1),PAF(2),PAF(3)); OLM(0); OLM(1); OLM(2); OLM(3); }
  #undef PKW
  #undef PAF
  #undef VFR
  #undef PIN
  #undef MX3
  #undef GAPA
  #undef NEGMC
  #undef OLM
  #undef GAPB
  #undef EX
  #undef VRD
  #undef KRD
  #undef STEP
  #undef ENDW
  {auto rr=__builtin_amdgcn_permlane32_swap(__float_as_uint(l_reg),__float_as_uint(l_reg),false,false);l_reg=__uint_as_float(rr[0])+__uint_as_float(rr[1]);}
  if(hi==0)wsf[32+r32]=l_reg;asm volatile("s_waitcnt lgkmcnt(0)":::"memory");
  float rli[16];
  #pragma unroll
  for(int r=0;r<16;++r){ if constexpr(FIXED)rli[r]=__builtin_amdgcn_rcpf(ol[r]); else rli[r]=__builtin_amdgcn_rcpf(wsf[32+crow(r,hi)]); }
  unsigned char*Ow=(unsigned char*)O+(rowbase+q0+wid*QBLK)*PO+h*D;
  { unsigned char*stg=(unsigned char*)(shm+LDS_OST)+wid*2048;
    #pragma unroll
    for(int r=0;r<16;++r){const int orow=crow(r,hi);
      #pragma unroll
      for(int d0=0;d0<2;++d0){ float ov=o[d0][r]*rli[r]*ATTN_OSCALE; ov=__builtin_amdgcn_fmed3f(ov,-448.f,448.f); stg[orow*64+d0*32+r32]=(unsigned char)__builtin_amdgcn_cvt_pk_fp8_f32(ov,ov,0,false);}}
    asm volatile("s_waitcnt lgkmcnt(0)":::"memory");
    #pragma unroll
    for(int i=0;i<2;++i){const int row=i*16+(lane>>2),ch=lane&3; const u32x4 v=*(const u32x4*)(stg+row*64+ch*16); ATTN_STORE16(Ow+(long)row*PO+ch*16,v);} }
  asm volatile("s_waitcnt lgkmcnt(0)\n\ts_barrier":::"memory");
  #undef DMA_K
  #undef DMA_V
  #undef CMASK
  #undef START
  #undef RESC
  #undef ROT
}
constexpr int ATTN_LDS_BYTES=LDS_BYTES;
struct AttnTensors { const bf16* Q; const bf16* K; const bf16* V; bf16* O; };
struct AttnUnit { int bh; int qb; };
struct StaticOrder {
  int vcu,G;
  __device__ __forceinline__ explicit StaticOrder(int grid,int block):vcu((grid%8==0)?(block%8)*(grid/8)+block/8:block),G(grid){}
  __device__ __forceinline__ bool next(int i,AttnUnit&u)const{ const int L=i*G+vcu; if(L>=BATCH*NHEAD*(SEQ/QB))return false; const int pair=L/32,j=L%32; const int b=pair/2,kvh=pair%2; u.bh=b*NHEAD+kvh*NGRP+(j>>3); u.qb=j&7; return true; }
  __device__ __forceinline__ void a_ready(const AttnUnit&)const{}
  __device__ __forceinline__ void done(const AttnUnit&)const{}
};
template<class Sched,bool FIXED,int THRL=8> __device__ __forceinline__ void attn_phase(char*lds,const AttnTensors&T,const Sched&S,const int tid_in,const int i0,const int i1,const float mfix){
  AttnUnit u;
  for(int i=i0;i<i1&&S.next(i,u);++i){ S.a_ready(u); attn_unit<THRL,FIXED>(u.bh/NHEAD,u.bh%NHEAD,u.qb,T.Q,T.K,T.V,T.O,lds,tid_in,mfix); S.done(u); }
}
#undef SBAR
#undef WAIT_BAR
}
#define XB_TMO      128
#define XB_XCNT(j)  (256  + 64 * (j))
#define XB_XSUB(j)  (1280 + 64 * (j))
#define XB_XGEN(j)  (2304 + 64 * (j))
#define XB_TOP      3328
#define XB_TOPGEN   3392
#define XCD_BAR_WORDS 3456
#define XB_SPIN_CAP (1u << 18)
constexpr int NWAVES = 8;
#ifndef MK_PER_PHASE
#define MK_PER_PHASE 0
#endif
constexpr int DM = 1024, NB = 32, SEQ = 2048, NTOK = NB * SEQ, DEPTH = 2;
constexpr int INW = 1792, COL_K = 512, COL_V = 640, COL_CA = 768, COL_CG = 1280, CC = 512;
constexpr int NE = 32, TOPK = 4, NK = NTOK * TOPK;
constexpr int PMAX = NK + NE * 256, TMAX = PMAX / 256;
constexpr float EPS = 1e-6f;
constexpr int NPH = 21;

constexpr size_t MiB = 1u << 20;
constexpr size_t WS_CTL = 0, CTL_ZERO_BYTES = 1 * MiB;
constexpr size_t WS_MOD = 1 * MiB;
constexpr size_t WS_ROPE = 3 * MiB;
constexpr size_t WS_WIN = 4 * MiB;
constexpr size_t WS_WOUT = 11 * MiB;
constexpr size_t WS_TOPK = 15 * MiB;
constexpr size_t WS_SLOT = 17 * MiB;
constexpr size_t WS_PGATE = 18 * MiB;
constexpr size_t WS_PERM = 20 * MiB;
constexpr size_t WS_IDENT = 22 * MiB;
constexpr size_t WS_W1 = 24 * MiB;
constexpr size_t WS_W2 = 152 * MiB;
constexpr size_t WS_X = 216 * MiB;
constexpr size_t WS_H = 472 * MiB;
constexpr size_t WS_U = 600 * MiB;
constexpr size_t WS_UU = WS_U;
constexpr size_t WS_Q = WS_U + 64 * MiB;
constexpr size_t WS_KN = WS_U + 128 * MiB;
constexpr size_t WS_V = WS_U + 144 * MiB;
constexpr size_t WS_MIX = WS_U + 160 * MiB;
constexpr size_t WS_Y = WS_U;
constexpr size_t WS_ACT = 1128 * MiB;
constexpr size_t WS_END = 1392 * MiB;
static_assert(WS_MIX + (size_t)NTOK * 1024 * 2 <= WS_ACT && WS_Y + (size_t)PMAX * 1024 * 2 <= WS_ACT && WS_ACT + (size_t)PMAX * 1024 <= WS_END && WS_PERM + (size_t)PMAX * 4 <= WS_W1, "d_ws map");
constexpr int CW_BAR = 4096;
constexpr int CW_CNT = 131072;
constexpr int RING_OFF = 0, RING_BYTES = 131072;
constexpr int LDSX_OFF = RING_BYTES;
constexpr int LX_MISC = LDSX_OFF, LX_TAB = LDSX_OFF + 512, LX_TILE = LDSX_OFF + 2048, LX_STG = LDSX_OFF + 4096;
constexpr int LDS_BYTES = 147456;

#define GAS __attribute__((address_space(1)))
#define LAS __attribute__((address_space(3)))
typedef unsigned short bf16;
typedef unsigned v4u __attribute__((ext_vector_type(4)));
typedef unsigned v2u __attribute__((ext_vector_type(2)));
typedef float f32x4 __attribute__((ext_vector_type(4)));
typedef GAS unsigned gu32;
#define RLX_AGENT __ATOMIC_RELAXED, __HIP_MEMORY_SCOPE_AGENT
#define LDS_WAIT() asm volatile("s_waitcnt lgkmcnt(0)" ::: "memory")
#define VM_WAIT() asm volatile("s_waitcnt vmcnt(0)" ::: "memory")
__device__ __forceinline__ unsigned f2bf(float f) { unsigned u = __builtin_bit_cast(unsigned, f); return (u + 0x7fffu + ((u >> 16) & 1u)) >> 16; }
__device__ __forceinline__ unsigned pk2(float lo, float hi) { return f2bf(lo) | (f2bf(hi) << 16); }
__device__ __forceinline__ float bflo(unsigned w) { return __builtin_bit_cast(float, w << 16); }
__device__ __forceinline__ float bfhi(unsigned w) { return __builtin_bit_cast(float, w & 0xffff0000u); }
__device__ __forceinline__ float shx(float v, int mask, int lane) { return __builtin_bit_cast(float, __builtin_amdgcn_ds_bpermute((lane ^ mask) << 2, __builtin_bit_cast(int, v))); }
__device__ __forceinline__ int shxi(int v, int mask, int lane) { return __builtin_amdgcn_ds_bpermute((lane ^ mask) << 2, v); }
#define DPPF(old, src, ctrl, rmask) __builtin_bit_cast(float, __builtin_amdgcn_update_dpp(__builtin_bit_cast(int, (float)(old)), __builtin_bit_cast(int, (float)(src)), (ctrl), (rmask), 0xF, false))
__device__ __forceinline__ float wave_sum_s(float v) {
    v += DPPF(0.f, v, 0xB1, 0xF); v += DPPF(0.f, v, 0x4E, 0xF); v += DPPF(0.f, v, 0x141, 0xF); v += DPPF(0.f, v, 0x140, 0xF);
    v += DPPF(0.f, v, 0x142, 0xA); v += DPPF(0.f, v, 0x143, 0xC);
    return __builtin_bit_cast(float, __builtin_amdgcn_readlane(__builtin_bit_cast(int, v), 63));
}
__device__ __forceinline__ float wave_max_s(float v) {
    v = __builtin_fmaxf(v, DPPF(v, v, 0xB1, 0xF)); v = __builtin_fmaxf(v, DPPF(v, v, 0x4E, 0xF)); v = __builtin_fmaxf(v, DPPF(v, v, 0x141, 0xF)); v = __builtin_fmaxf(v, DPPF(v, v, 0x140, 0xF));
    v = __builtin_fmaxf(v, DPPF(v, v, 0x142, 0xA)); v = __builtin_fmaxf(v, DPPF(v, v, 0x143, 0xC));
    return __builtin_bit_cast(float, __builtin_amdgcn_readlane(__builtin_bit_cast(int, v), 63));
}
__device__ __forceinline__ float wave_sum(float v, int lane) { (void)lane; return wave_sum_s(v); }
__device__ __forceinline__ unsigned xb_ld(unsigned* p)              { return __hip_atomic_load(p, __ATOMIC_RELAXED, __HIP_MEMORY_SCOPE_AGENT); }
__device__ __forceinline__ unsigned xb_add(unsigned* p, unsigned v) { return __hip_atomic_fetch_add(p, v, __ATOMIC_RELAXED, __HIP_MEMORY_SCOPE_AGENT); }
__device__ __forceinline__ unsigned xb_xcc_id() { return (unsigned)__builtin_amdgcn_s_getreg((3 << 11) | 20) & 0xFu; }
#define XB_SPIN(cond, bar) do { unsigned _sp = 0; while (cond) { __builtin_amdgcn_s_sleep(1); \
    if ((++_sp & 255u) == 0u) { if (xb_ld(&(bar)[XB_TMO])) break; if (_sp > XB_SPIN_CAP) { atomicAdd(&(bar)[XB_TMO], 1u); break; } } } } while (0)

struct XcdBarrier {
    unsigned* bar; unsigned x;
    unsigned wave;
    volatile LAS unsigned* st;
};

__device__ __forceinline__ bool xb_thread0(unsigned wave) { unsigned z_ = 0u; asm volatile("" : "+v"(z_)); return wave == 0u && __builtin_amdgcn_mbcnt_hi(~0u, __builtin_amdgcn_mbcnt_lo(~0u, z_)) == 0u; }
__device__ __forceinline__ XcdBarrier xcd_barrier_post(unsigned* bar, volatile LAS unsigned* st, unsigned wave) {
    XcdBarrier b; b.bar = bar; b.x = xb_xcc_id(); b.st = st; b.wave = wave;
    if (xb_thread0(wave)) (void)xb_add(&bar[XB_XCNT(b.x)], 1u);
    return b;
}
__device__ __forceinline__ void xcd_barrier_complete(unsigned* bar, unsigned x, unsigned& nloc, unsigned& nx) {
    const unsigned G = gridDim.x * gridDim.y * gridDim.z;
    unsigned sum, cnt, mine, sp = 0u;
    for (;;) {
        sum = 0u; cnt = 0u; mine = 0u;
#pragma unroll
        for (unsigned j = 0; j < 16; ++j) { const unsigned c = xb_ld(&bar[XB_XCNT(j)]); sum += c; cnt += (c > 0u) ? 1u : 0u; mine = (j == x) ? c : mine; }
        if (sum == G) break;
        __builtin_amdgcn_s_sleep(1);
        if ((++sp & 255u) == 0u) { if (xb_ld(&bar[XB_TMO])) break; if (sp > XB_SPIN_CAP) { atomicAdd(&bar[XB_TMO], 1u); break; } }
    }
    nloc = mine > 0u ? mine : 1u; nx = cnt > 0u ? cnt : 1u;
}

__device__ __forceinline__ void xcd_barrier(const XcdBarrier& b) {
    asm volatile("s_waitcnt vmcnt(0)" ::: "memory");
    __syncthreads();
    if (xb_thread0(b.wave)) {
        unsigned* bar = b.bar;
        __builtin_amdgcn_s_waitcnt(0);
        unsigned nloc = b.st[0], nx = b.st[1];
        if (nloc == 0u) { xcd_barrier_complete(bar, b.x, nloc, nx); b.st[0] = nloc; b.st[1] = nx; }
        const unsigned old = xb_add(&bar[XB_XSUB(b.x)], 1u);
        const unsigned gen = old / nloc;
        if (old + 1u == (gen + 1u) * nloc) {
            __builtin_amdgcn_fence(__ATOMIC_RELEASE, "agent");
            asm volatile("s_waitcnt vmcnt(0)" ::: "memory");
            const unsigned og = xb_add(&bar[XB_TOP], 1u);
            const unsigned tg = og / nx;
            if (og + 1u == (tg + 1u) * nx) xb_add(&bar[XB_TOPGEN], 1u);
            else XB_SPIN(xb_ld(&bar[XB_TOPGEN]) == tg, bar);
            __builtin_amdgcn_fence(__ATOMIC_ACQUIRE, "agent");
            xb_add(&bar[XB_XGEN(b.x)], 1u);
            asm volatile("s_waitcnt vmcnt(0)" ::: "memory");
        } else {
            XB_SPIN(xb_ld(&bar[XB_XGEN(b.x)]) == gen, bar);
            __builtin_amdgcn_fence(__ATOMIC_ACQUIRE, "agent");
            asm volatile("s_waitcnt vmcnt(0)" ::: "memory");
        }
    }
    __syncthreads();
}
struct Ctx { LAS unsigned char* lds; unsigned char* ws; gu32* ctl; int tid, lane, wave, vcu, G; };

template <bool INPROJ = false> __device__ __forceinline__ void transpose_item(const float* W, int K, int N, bf16* WT, int kb, int n0, int drow0, LAS float* scr, int lane) {
    const int k0 = 64 * kb;
    float ld_[32];
#pragma unroll
    for (int i = 0; i < 32; ++i) ld_[i] = W[(size_t)(k0 + 2 * i + (lane >> 5)) * N + n0 + (lane & 31)];
#pragma unroll
    for (int i = 0; i < 32; ++i) scr[(2 * i + (lane >> 5)) * 33 + (lane & 31)] = ld_[i];
    LDS_WAIT(); asm volatile("" ::: "memory");
    const int c = lane & 7;
#pragma unroll
    for (int j = 0; j < 4; ++j) { const int n = (lane >> 3) + 8 * j; const LAS float* s = scr + (8 * c) * 33 + n;
        v4u o; o.x = pk2(s[0 * 33], s[1 * 33]); o.y = pk2(s[2 * 33], s[3 * 33]); o.z = pk2(s[4 * 33], s[5 * 33]); o.w = pk2(s[6 * 33], s[7 * 33]);
        *(GAS v4u*)(WT + (size_t)(INPROJ ? pg8::inproj_row(n0 + n) : drow0 + n) * K + k0 + 8 * c) = o; }
    LDS_WAIT(); asm volatile("" ::: "memory");
}

template <bool INPROJ = false> __device__ __forceinline__ void transpose_item_f8(const float* W, int K, int N, unsigned char* WT, int kb, int n0, int drow0, LAS float* scr, int lane, float scale) {
    const int k0 = 64 * kb;
    float ld_[32];
#pragma unroll
    for (int i = 0; i < 32; ++i) ld_[i] = W[(size_t)(k0 + 2 * i + (lane >> 5)) * N + n0 + (lane & 31)];
#pragma unroll
    for (int i = 0; i < 32; ++i) scr[(2 * i + (lane >> 5)) * 33 + (lane & 31)] = ld_[i];
    LDS_WAIT(); asm volatile("" ::: "memory");
    const int c = lane & 7;
#pragma unroll
    for (int j = 0; j < 4; ++j) { const int n = (lane >> 3) + 8 * j; const LAS float* s = scr + (8 * c) * 33 + n;
        v2u o; o.x = pg8::pk4_fp8(s[0 * 33] * scale, s[1 * 33] * scale, s[2 * 33] * scale, s[3 * 33] * scale); o.y = pg8::pk4_fp8(s[4 * 33] * scale, s[5 * 33] * scale, s[6 * 33] * scale, s[7 * 33] * scale);
        *(GAS v2u*)(WT + (size_t)(INPROJ ? pg8::inproj_row(n0 + n) : drow0 + n) * K + k0 + 8 * c) = o; }
    LDS_WAIT(); asm volatile("" ::: "memory");
}

constexpr int I_CV_W1 = 64 * 1024, I_CV_W2 = 64 * 512, I_CV_IN = 2 * 896, I_CV_OUT = 2 * 512, I_CV_W1L = 32 * 1024, I_CV_W2L = 32 * 512;
__device__ __forceinline__ void p_convert(const Ctx& F, const float* w_in, const float* w_out, const float* w1, const float* w2, const int mode, const int l, const int count, const int widx_in, const int nw, const int first = 0) {
    LAS float* scr = (LAS float*)(F.lds + RING_OFF + F.wave * 16384);
    const int lane = F.lane; const int widx = __builtin_amdgcn_readfirstlane(widx_in);
    constexpr int I_W1 = I_CV_W1, I_W2 = I_CV_W2, I_IN = I_CV_IN;
    struct Item { const float* W; unsigned char* WT; int N, k0, n0, drow0; bool inproj; };
    auto decode = [&](int v) -> Item { Item r; int q = mode == 0 ? I_W1 + I_W2 + v : (v < I_CV_W1L ? l * I_CV_W1L + v : I_W1 + l * I_CV_W2L + (v - I_CV_W1L));
        if (q < I_W1) { const int m = q >> 10, qq = q & 1023, n0 = (qq & 63) * 32, half = n0 >> 10, nn = n0 & 1023;
            r.W = w1 + (size_t)m * 1024 * 2048; r.WT = (unsigned char*)(F.ws + WS_W1) + (size_t)m * 2048 * 1024; r.N = 2048; r.k0 = 64 * (qq >> 6); r.n0 = n0; r.drow0 = (nn >> 7) * 256 + half * 128 + (nn & 127); r.inproj = false; return r; }
        q -= I_W1;
        if (q < I_W2) { const int m = q >> 9, qq = q & 511, n0 = (qq & 31) * 32;
            r.W = w2 + (size_t)m * 1024 * 1024; r.WT = (unsigned char*)(F.ws + WS_W2) + (size_t)m * 1024 * 1024; r.N = 1024; r.k0 = 64 * (qq >> 5); r.n0 = n0; r.drow0 = n0; r.inproj = false; return r; }
        q -= I_W2;
        if (q < I_IN) { const int m = q / 896, qq = q % 896, n0 = (qq % 56) * 32;
            r.W = w_in + (size_t)m * 1024 * INW; r.WT = (unsigned char*)(F.ws + WS_WIN) + (size_t)m * INW * 1024; r.N = INW; r.k0 = 64 * (qq / 56); r.n0 = n0; r.drow0 = n0; r.inproj = true; return r; }
        q -= I_IN;
        { const int m = q >> 9, qq = q & 511, n0 = (qq & 31) * 32;
            r.W = w_out + (size_t)m * 1024 * 1024; r.WT = (unsigned char*)(F.ws + WS_WOUT) + (size_t)m * 1024 * 1024; r.N = 1024; r.k0 = 64 * (qq >> 5); r.n0 = n0; r.drow0 = n0; r.inproj = false; return r; } };
    float lda[32], ldb[32];
#define P0_LOAD(LD, I) do { int ll_ = lane; asm volatile("" : "+v"(ll_));     \
        const GAS float* wp_ = (const GAS float*)((I).W + (size_t)((I).k0 + (ll_ >> 5)) * (I).N + (I).n0 + (ll_ & 31)); _Pragma("unroll") for (int i = 0; i < 32; ++i) LD[i] = wp_[(size_t)(2 * i) * (I).N]; } while (0)
#define P0_PROC(LD, ME) do { _Pragma("unroll") for (int i = 0; i < 32; ++i) scr[(2 * i + (lane >> 5)) * 33 + (lane & 31)] = LD[i] * pg8::F8_SW; } while (0)
#define P0_STORE(ME) do { LDS_WAIT(); asm volatile("" ::: "memory"); const int c = lane & 7; \
        _Pragma("unroll") for (int j = 0; j < 4; ++j) { const int n = (lane >> 3) + 8 * j; const LAS float* s = scr + (8 * c) * 33 + n; \
            v2u o; o.x = pg8::pk4_fp8(s[0 * 33], s[1 * 33], s[2 * 33], s[3 * 33]); o.y = pg8::pk4_fp8(s[4 * 33], s[5 * 33], s[6 * 33], s[7 * 33]); \
            *(GAS v2u*)((ME).WT + (size_t)((ME).inproj ? pg8::inproj_row((ME).n0 + n) : (ME).drow0 + n) * 1024 + (ME).k0 + 8 * c) = o; } \
        LDS_WAIT(); asm volatile("" ::: "memory"); } while (0)
    const int vend = first + count;
    if (first + widx < vend) { const Item t_ = decode(first + widx); P0_LOAD(lda, t_); } if (first + widx + nw < vend) { const Item t_ = decode(first + widx + nw); P0_LOAD(ldb, t_); }
#pragma unroll 1
    for (int it = first + widx; it < vend; it += 2 * nw) {
        { P0_PROC(lda, 0); if (it + 2 * nw < vend) { const Item t_ = decode(it + 2 * nw); P0_LOAD(lda, t_); } const Item me = decode(it); P0_STORE(me); }
        if (it + nw < vend) { P0_PROC(ldb, 0); if (it + 3 * nw < vend) { const Item t_ = decode(it + 3 * nw); P0_LOAD(ldb, t_); } const Item me = decode(it + nw); P0_STORE(me); }
    }
#undef P0_PROC
#undef P0_STORE
#undef P0_LOAD
}
__device__ __forceinline__ void p0_prologue(const Ctx& F, const float* c_in, const float* w_mod, const float* b_mod, const float* w_in, const float* w_out, const float* w1, const float* w2) {
    if (F.vcu < 192) {
        const int l = F.vcu / 96, n0 = (F.vcu % 96) * 64;
        LAS float* cact = (LAS float*)(F.lds + RING_OFF);
        for (int i = F.tid; i < NB * DM; i += NWAVES * 64) { const float v = c_in[i]; cact[i] = v / (1.0f + expf(-v)); }
        __syncthreads();
        float acc[NB];
#pragma unroll
        for (int b = 0; b < NB; ++b) acc[b] = 0.f;
        const float* wp = w_mod + (size_t)l * DM * 6144 + n0 + F.lane;
        const int k0 = F.wave * 128;
        float wn[32];
#pragma unroll
        for (int q = 0; q < 32; ++q) wn[q] = wp[(size_t)(k0 + q) * 6144];
#pragma unroll 1
        for (int kk = 0; kk < 4; ++kk) { const int k = k0 + 32 * kk; float w[32];
#pragma unroll
            for (int q = 0; q < 32; ++q) w[q] = wn[q];
            if (kk < 3) {
#pragma unroll
                for (int q = 0; q < 32; ++q) wn[q] = wp[(size_t)(k + 32 + q) * 6144]; }
#pragma unroll
            for (int b = 0; b < NB; ++b) { float a_ = acc[b];
#pragma unroll
                for (int q = 0; q < 32; q += 8) { const f32x4 c0 = *(const LAS f32x4*)(cact + b * DM + k + q), c1 = *(const LAS f32x4*)(cact + b * DM + k + q + 4);
                    a_ += (c0.x * w[q] + c0.y * w[q + 1] + c0.z * w[q + 2] + c0.w * w[q + 3]) + (c1.x * w[q + 4] + c1.y * w[q + 5] + c1.z * w[q + 6] + c1.w * w[q + 7]); }
                acc[b] = a_; } }
        __syncthreads();
        LAS float* red = (LAS float*)(F.lds + RING_OFF);
#pragma unroll
        for (int b = 0; b < NB; ++b) red[(F.wave * NB + b) * 64 + F.lane] = acc[b];
        __syncthreads();
        float* MOD = (float*)(F.ws + WS_MOD);
        for (int o = F.tid; o < NB * 64; o += NWAVES * 64) { const int b = o >> 6, col = o & 63; float s = b_mod[l * 6144 + n0 + col];
#pragma unroll
            for (int w = 0; w < NWAVES; ++w) s += red[(w * NB + b) * 64 + col];
            MOD[(size_t)(l * NB + b) * 6144 + n0 + col] = s; }
        __syncthreads();
    }
    { float* ROPE = (float*)(F.ws + WS_ROPE);
      for (int idx = F.vcu * NWAVES * 64 + F.tid; idx < SEQ * 32; idx += F.G * NWAVES * 64) { const int pos = idx >> 5, f = idx & 31, fi = f & 15;
          const float freq = powf(10000.0f, -(float)fi / 16.0f); const float p = (float)((f >> 4) ? (pos & 63) : (pos >> 6)); const float ang = p * freq;
          float s, c; sincosf(ang, &s, &c); ROPE[pos * 64 + f] = c; ROPE[pos * 64 + 32 + f] = s; } }
    p_convert(F, w_in, w_out, w1, w2, 0, 0, I_CV_IN + I_CV_OUT, F.vcu * NWAVES + F.wave, F.G * NWAVES);
}

__device__ __forceinline__ void norm_mod_row(const float* xrow, const float* g, const float* sc, const float* sh, bf16* orow, int lane) {
    const GAS f32x4* xr = (const GAS f32x4*)xrow + lane;
    f32x4 v[4]; float s = 0.f;
#pragma unroll
    for (int j = 0; j < 4; ++j) { v[j] = xr[64 * j]; s += (v[j].x * v[j].x + v[j].y * v[j].y) + (v[j].z * v[j].z + v[j].w * v[j].w); }
    const float rinv = 1.0f / sqrtf(wave_sum(s, lane) * (1.f / DM) + EPS);
    GAS unsigned long long* o8 = (GAS unsigned long long*)orow + lane;
#pragma unroll
    for (int j = 0; j < 4; ++j) { const f32x4 gg = ((const GAS f32x4*)g)[64 * j + lane], s1 = ((const GAS f32x4*)sc)[64 * j + lane], s0 = ((const GAS f32x4*)sh)[64 * j + lane];
        const f32x4 y = (v[j] * rinv) * gg * (s1 + 1.0f) + s0;
        o8[64 * j] = (unsigned long long)pk2(y.x, y.y) | ((unsigned long long)pk2(y.z, y.w) << 32); }
}

__device__ __forceinline__ void norm_mod_row2(const float* xa, const float* xb, const float* g, const float* sca, const float* sha, const float* scb, const float* shb, unsigned char* oa, unsigned char* ob, int lane) {
    const GAS f32x4* ra = (const GAS f32x4*)xa + lane; const GAS f32x4* rb = (const GAS f32x4*)xb + lane;
    f32x4 va[4], vb[4]; float sa = 0.f, sb = 0.f;
#pragma unroll
    for (int j = 0; j < 4; ++j) { va[j] = ra[64 * j]; vb[j] = rb[64 * j]; }
#pragma unroll
    for (int j = 0; j < 4; ++j) { sa += (va[j].x * va[j].x + va[j].y * va[j].y) + (va[j].z * va[j].z + va[j].w * va[j].w); sb += (vb[j].x * vb[j].x + vb[j].y * vb[j].y) + (vb[j].z * vb[j].z + vb[j].w * vb[j].w); }
    sa = wave_sum_s(sa); sb = wave_sum_s(sb);
    const float ia = 1.0f / sqrtf(sa * (1.f / DM) + EPS), ib = 1.0f / sqrtf(sb * (1.f / DM) + EPS);
    GAS unsigned* pa = (GAS unsigned*)oa + lane; GAS unsigned* pb = (GAS unsigned*)ob + lane;
#pragma unroll
    for (int j = 0; j < 4; ++j) { const f32x4 gg = ((const GAS f32x4*)g)[64 * j + lane];
        const f32x4 ya = (va[j] * ia) * gg * (((const GAS f32x4*)sca)[64 * j + lane] + 1.0f) + ((const GAS f32x4*)sha)[64 * j + lane];
        const f32x4 yb = (vb[j] * ib) * gg * (((const GAS f32x4*)scb)[64 * j + lane] + 1.0f) + ((const GAS f32x4*)shb)[64 * j + lane];
        pa[64 * j] = pg8::pk4_fp8(ya.x * pg8::F8_SA, ya.y * pg8::F8_SA, ya.z * pg8::F8_SA, ya.w * pg8::F8_SA);
        pb[64 * j] = pg8::pk4_fp8(yb.x * pg8::F8_SA, yb.y * pg8::F8_SA, yb.z * pg8::F8_SA, yb.w * pg8::F8_SA); }
}

__device__ __forceinline__ void p_conv(const Ctx& F, const float* w_dw, const float* b_dw, const float* g_cn, const float* b_cn) {
    const bf16* U = (const bf16*)(F.ws + WS_UU);
    const int c = F.tid; float w[31];
#pragma unroll
    for (int j = 0; j < 31; ++j) w[j] = w_dw[j * CC + c];
    const float bias = b_dw[c];
    LAS float* tile = (LAS float*)(F.lds + RING_OFF);
    unsigned char* MIX = (unsigned char*)(F.ws + WS_MIX);
    const f32x4 g0 = ((const GAS f32x4*)g_cn)[F.lane * 2], g1 = ((const GAS f32x4*)g_cn)[F.lane * 2 + 1], b0 = ((const GAS f32x4*)b_cn)[F.lane * 2], b1 = ((const GAS f32x4*)b_cn)[F.lane * 2 + 1];
    unsigned raw[62];
#define CONV_LOAD(CH) do { const int b_ = (CH) >> 6, s0_ = ((CH) & 63) * 32; _Pragma("unroll") for (int i = 0; i < 62; ++i) { const int s = s0_ - 15 + i; unsigned u = 0u; \
        if (s >= 0 && s < SEQ) u = (unsigned)((const GAS bf16*)U)[(size_t)(b_ * SEQ + s) * CC + c]; raw[i] = u; } } while (0)
    if (F.vcu < NTOK / 32) CONV_LOAD(F.vcu);
    for (int chunk = F.vcu; chunk < NTOK / 32; chunk += F.G) {
        const int b = chunk >> 6, s0 = (chunk & 63) * 32;
        { float win[62];
#pragma unroll
          for (int i = 0; i < 62; ++i) win[i] = __builtin_bit_cast(float, raw[i] << 16);
#pragma unroll
          for (int r = 0; r < 32; ++r) { float a = bias;
#pragma unroll
              for (int j = 0; j < 31; ++j) a += win[r + j] * w[j];
              tile[r * CC + c] = a; } }
        if (chunk + F.G < NTOK / 32) CONV_LOAD(chunk + F.G);
        LDS_WAIT(); __builtin_amdgcn_s_barrier(); asm volatile("" ::: "memory");
        { f32x4 a0[4], a1[4]; float s1[4], s2[4];
#pragma unroll
          for (int rr = 0; rr < 4; ++rr) { const LAS f32x4* tp = (const LAS f32x4*)(tile + (F.wave * 4 + rr) * CC + F.lane * 8); a0[rr] = tp[0]; a1[rr] = tp[1];
              s1[rr] = (a0[rr].x + a0[rr].y) + (a0[rr].z + a0[rr].w) + (a1[rr].x + a1[rr].y) + (a1[rr].z + a1[rr].w); }
#pragma unroll
          for (int rr = 0; rr < 4; ++rr) s1[rr] = wave_sum_s(s1[rr]);
#pragma unroll
          for (int rr = 0; rr < 4; ++rr) { const float mu = s1[rr] * (1.f / CC); a0[rr] = a0[rr] - mu; a1[rr] = a1[rr] - mu;
              s2[rr] = (a0[rr].x * a0[rr].x + a0[rr].y * a0[rr].y) + (a0[rr].z * a0[rr].z + a0[rr].w * a0[rr].w) + (a1[rr].x * a1[rr].x + a1[rr].y * a1[rr].y) + (a1[rr].z * a1[rr].z + a1[rr].w * a1[rr].w); }
#pragma unroll
          for (int rr = 0; rr < 4; ++rr) s2[rr] = wave_sum_s(s2[rr]);
#pragma unroll
          for (int rr = 0; rr < 4; ++rr) { const float rstd = 1.0f / sqrtf(s2[rr] * (1.f / CC) + EPS);
              f32x4 y0 = a0[rr] * rstd * g0 + b0, y1 = a1[rr] * rstd * g1 + b1;
#pragma unroll
              for (int q = 0; q < 4; ++q) { y0[q] = y0[q] / (1.0f + __expf(-y0[q])); y1[q] = y1[q] / (1.0f + __expf(-y1[q])); }
              v2u o; o.x = pg8::pk4_fp8(y0.x * pg8::F8_SMIX, y0.y * pg8::F8_SMIX, y0.z * pg8::F8_SMIX, y0.w * pg8::F8_SMIX); o.y = pg8::pk4_fp8(y1.x * pg8::F8_SMIX, y1.y * pg8::F8_SMIX, y1.z * pg8::F8_SMIX, y1.w * pg8::F8_SMIX);
              *(GAS v2u*)(MIX + (size_t)(b * SEQ + s0 + F.wave * 4 + rr) * 1024 + 512 + F.lane * 8) = o; } }
        LDS_WAIT(); __builtin_amdgcn_s_barrier(); asm volatile("" ::: "memory");
    }
    __syncthreads();
#undef CONV_LOAD
}

typedef short rt_bf16x8 __attribute__((ext_vector_type(8)));
__device__ __forceinline__ unsigned short bf_hi(float f) { return (unsigned short)f2bf(f); }
__device__ __forceinline__ void p_norm2_router(const Ctx& F, const float* g_ffn, const float* w_router, const float* b_router, const float* mod_l, gu32* gcnt) {
    constexpr int APITCH = 2064;
    LAS unsigned char* Ahi = F.lds + RING_OFF; LAS unsigned char* Alo = Ahi + 16 * APITCH; LAS float* PART = (LAS float*)(Alo + 16 * APITCH);
    LAS int* cntL = (LAS int*)(F.lds + LX_TAB); LAS int* baseL = cntL + 32;
    LAS v2u* stg = (LAS v2u*)(F.lds + LX_STG);
    const int lane = F.lane, c16 = lane & 15, kg = lane >> 4, el = lane & 31, half = lane >> 5;
    rt_bf16x8 Bhi[4][2], Blo[4][2];
#pragma unroll
    for (int s = 0; s < 4; ++s)
#pragma unroll
        for (int nt = 0; nt < 2; ++nt) { const float* wp = w_router + (size_t)(128 * F.wave + 32 * s + 8 * kg) * NE + 16 * nt + c16;
#pragma unroll
            for (int q = 0; q < 8; ++q) { const float wv = wp[q * NE]; const unsigned short h = bf_hi(wv); const unsigned short l = bf_hi(wv - __builtin_bit_cast(float, (unsigned)h << 16)); Bhi[s][nt][q] = (short)h; Blo[s][nt][q] = (short)l; } }
    const float brl = b_router[el];
    if (F.tid < 32) cntL[F.tid] = 0;
    __syncthreads();
    const bf16* X = (const bf16*)(F.ws + WS_X); unsigned char* H = (unsigned char*)(F.ws + WS_H);
    const int rbase = F.vcu * (NTOK / F.G);
    const float* sc = mod_l + (size_t)(rbase >> 11) * 6144 + 4 * 1024; const float* sh = mod_l + (size_t)(rbase >> 11) * 6144 + 3 * 1024;
    const int rl0 = 2 * F.wave; constexpr int NTILE = 16;
    f32x4 gs1[4], s0v[4];
#pragma unroll
    for (int j = 0; j < 4; ++j) { gs1[j] = ((const GAS f32x4*)g_ffn)[64 * j + lane] * (((const GAS f32x4*)sc)[64 * j + lane] + 1.0f); s0v[j] = ((const GAS f32x4*)sh)[64 * j + lane]; }
    v2u nxa[4], nxb[4];
    { const GAS v2u* xa = (const GAS v2u*)(X + (size_t)(rbase + rl0) * DM) + lane; const GAS v2u* xb = xa + DM / 4;
#pragma unroll
      for (int j = 0; j < 4; ++j) { nxa[j] = xa[64 * j]; nxb[j] = xb[64 * j]; } }
    for (int t = 0; t < (NTOK / F.G) / NTILE; ++t) {
        const int tok0 = rbase + 16 * t + rl0;
        f32x4 hA[4], hB[4]; float sA = 0.f, sB = 0.f;
#pragma unroll
        for (int j = 0; j < 4; ++j) { const v2u wa = nxa[j], wb = nxb[j];
            hA[j] = (f32x4){bflo(wa.x), bfhi(wa.x), bflo(wa.y), bfhi(wa.y)}; hB[j] = (f32x4){bflo(wb.x), bfhi(wb.x), bflo(wb.y), bfhi(wb.y)}; }
        if (t + 1 < (NTOK / F.G) / NTILE) { const GAS v2u* xa = (const GAS v2u*)(X + (size_t)(tok0 + 16) * DM) + lane; const GAS v2u* xb = xa + DM / 4;
#pragma unroll
            for (int j = 0; j < 4; ++j) { nxa[j] = xa[64 * j]; nxb[j] = xb[64 * j]; } }
#pragma unroll
        for (int j = 0; j < 4; ++j) { sA += (hA[j].x * hA[j].x + hA[j].y * hA[j].y) + (hA[j].z * hA[j].z + hA[j].w * hA[j].w); sB += (hB[j].x * hB[j].x + hB[j].y * hB[j].y) + (hB[j].z * hB[j].z + hB[j].w * hB[j].w); }
        const float rA = 1.0f / sqrtf(wave_sum_s(sA) * (1.f / DM) + EPS), rB = 1.0f / sqrtf(wave_sum_s(sB) * (1.f / DM) + EPS);
        GAS unsigned* oa = (GAS unsigned*)(H + (size_t)tok0 * DM) + lane; GAS unsigned* ob = oa + DM / 4;
#pragma unroll
        for (int j = 0; j < 4; ++j) {
            hA[j] = (hA[j] * rA) * gs1[j] + s0v[j]; hB[j] = (hB[j] * rB) * gs1[j] + s0v[j];
            oa[64 * j] = pg8::pk4_fp8(hA[j].x * pg8::F8_SA, hA[j].y * pg8::F8_SA, hA[j].z * pg8::F8_SA, hA[j].w * pg8::F8_SA);
            ob[64 * j] = pg8::pk4_fp8(hB[j].x * pg8::F8_SA, hB[j].y * pg8::F8_SA, hB[j].z * pg8::F8_SA, hB[j].w * pg8::F8_SA);
            v2u ha, la, hb, lb;
#define SPLIT2(v0, v1, HO, LO) do { const unsigned short h0_ = bf_hi(v0), h1_ = bf_hi(v1); HO = (unsigned)h0_ | ((unsigned)h1_ << 16); \
            LO = (unsigned)bf_hi((v0) - __builtin_bit_cast(float, (unsigned)h0_ << 16)) | ((unsigned)bf_hi((v1) - __builtin_bit_cast(float, (unsigned)h1_ << 16)) << 16); } while (0)
            SPLIT2(hA[j].x, hA[j].y, ha.x, la.x); SPLIT2(hA[j].z, hA[j].w, ha.y, la.y); SPLIT2(hB[j].x, hB[j].y, hb.x, lb.x); SPLIT2(hB[j].z, hB[j].w, hb.y, lb.y);
#undef SPLIT2
            const int cb = (4 * lane + 256 * j) * 2;
            *(LAS v2u*)(Ahi + rl0 * APITCH + cb) = ha; *(LAS v2u*)(Alo + rl0 * APITCH + cb) = la; *(LAS v2u*)(Ahi + (rl0 + 1) * APITCH + cb) = hb; *(LAS v2u*)(Alo + (rl0 + 1) * APITCH + cb) = lb; }
        LDS_WAIT(); __builtin_amdgcn_s_barrier(); asm volatile("" ::: "memory");
        f32x4 acc[2] = {(f32x4){0.f, 0.f, 0.f, 0.f}, (f32x4){0.f, 0.f, 0.f, 0.f}};
#pragma unroll
        for (int s = 0; s < 4; ++s) { const int kb = (128 * F.wave + 32 * s + 8 * kg) * 2;
            const rt_bf16x8 ah = *(const LAS rt_bf16x8*)(Ahi + c16 * APITCH + kb), al = *(const LAS rt_bf16x8*)(Alo + c16 * APITCH + kb);
#pragma unroll
            for (int nt = 0; nt < 2; ++nt) { acc[nt] = __builtin_amdgcn_mfma_f32_16x16x32_bf16(Bhi[s][nt], ah, acc[nt], 0, 0, 0); acc[nt] = __builtin_amdgcn_mfma_f32_16x16x32_bf16(Blo[s][nt], ah, acc[nt], 0, 0, 0);
                acc[nt] = __builtin_amdgcn_mfma_f32_16x16x32_bf16(Bhi[s][nt], al, acc[nt], 0, 0, 0); } }
#pragma unroll
        for (int nt = 0; nt < 2; ++nt) *(LAS f32x4*)(PART + (F.wave * 16 + c16) * 32 + 16 * nt + 4 * kg) = acc[nt];
        LDS_WAIT(); __builtin_amdgcn_s_barrier(); asm volatile("" ::: "memory");
        float v = brl;
#pragma unroll
        for (int w = 0; w < NWAVES; ++w) v += PART[(w * 16 + rl0 + half) * 32 + el];
        float val[4]; int idx[4];
#pragma unroll
        for (int k = 0; k < 4; ++k) {
            float m = v; m = __builtin_fmaxf(m, DPPF(m, m, 0xB1, 0xF)); m = __builtin_fmaxf(m, DPPF(m, m, 0x4E, 0xF)); m = __builtin_fmaxf(m, DPPF(m, m, 0x141, 0xF)); m = __builtin_fmaxf(m, DPPF(m, m, 0x140, 0xF));
            m = __builtin_fmaxf(m, DPPF(m, m, 0x142, 0xA));
            const float mA = __builtin_bit_cast(float, __builtin_amdgcn_readlane(__builtin_bit_cast(int, m), 31)), mB = __builtin_bit_cast(float, __builtin_amdgcn_readlane(__builtin_bit_cast(int, m), 63));
            const float mm = half ? mB : mA;
            const unsigned long long bm = __builtin_amdgcn_ballot_w64(v == mm);
            const int sA_ = __builtin_ctz((unsigned)bm), sB_ = __builtin_ctz((unsigned)(bm >> 32));
            const int sel = half ? sB_ : sA_;
            val[k] = mm; idx[k] = sel; if (el == sel) v = -INFINITY; }
        float g[4]; float sm = 0.f;
#pragma unroll
        for (int k = 0; k < 4; ++k) { g[k] = expf(val[k] - val[0]); sm += g[k]; }
        if (el < 4) { const int k = el; const int e = k == 0 ? idx[0] : k == 1 ? idx[1] : k == 2 ? idx[2] : idx[3]; const float gt = (k == 0 ? g[0] : k == 1 ? g[1] : k == 2 ? g[2] : g[3]) / sm;
            const int pos = __hip_atomic_fetch_add(cntL + e, 1, __ATOMIC_RELAXED, __HIP_MEMORY_SCOPE_WORKGROUP);
            const int lr = 16 * t + rl0 + half;
            v2u ent; ent.x = (unsigned)e | ((unsigned)pos << 8); ent.y = __builtin_bit_cast(unsigned, gt); stg[lr * 4 + k] = ent; }
    }
    __syncthreads();
    if (F.tid < 32) baseL[F.tid] = (int)__hip_atomic_fetch_add(gcnt + F.tid, (unsigned)cntL[F.tid], RLX_AGENT);
    __syncthreads();
    v2u* TOPKB = (v2u*)(F.ws + WS_TOPK);
    for (int i = F.tid; i < (NTOK / F.G) * 4; i += NWAVES * 64) { v2u ent = stg[i]; const int tok = rbase + (i >> 2);
        const unsigned e = ent.x & 255u, pos = (ent.x >> 8) + (unsigned)baseL[e]; ent.x = e | (pos << 8); TOPKB[(size_t)tok * 4 + (i & 3)] = ent; }
    __syncthreads();
}

__device__ __forceinline__ void p_perm(const Ctx& F, gu32* gcnt) {
    LAS int* pst = (LAS int*)(F.lds + LX_TAB + 256); LAS int* pcn = pst + 32;
    if (F.tid < NE) pcn[F.tid] = (int)__hip_atomic_load(gcnt + F.tid, RLX_AGENT);
    __syncthreads();
    if (F.tid == 0) { int acc = 0; for (int e = 0; e < NE; ++e) { pst[e] = acc; acc += (pcn[e] + 255) & ~255; } }
    __syncthreads();
    const v2u* TOPKB = (const v2u*)(F.ws + WS_TOPK); int* SLOT = (int*)(F.ws + WS_SLOT); float* PGATE = (float*)(F.ws + WS_PGATE); int* PERM = (int*)(F.ws + WS_PERM);
    const int gt = (F.vcu * NWAVES + F.wave) * 64 + F.lane, NGT = F.G * NWAVES * 64;
    for (int i = gt; i < NTOK * 4; i += NGT) { const v2u ent = ((const GAS v2u*)TOPKB)[i]; const unsigned ex = ent.x, gbits = ent.y; const int dest = pst[ex & 255u] + (int)(ex >> 8);
        ((GAS int*)SLOT)[i] = dest; ((GAS float*)PGATE)[dest] = __builtin_bit_cast(float, gbits); ((GAS int*)PERM)[dest] = i >> 2; }
    if (F.vcu < NE) { const int e = F.vcu, c = pcn[e], pe = (c + 255) & ~255; for (int r = c + F.tid; r < pe; r += NWAVES * 64) { PERM[pst[e] + r] = 0; PGATE[pst[e] + r] = 0.f; } }
}

__device__ __forceinline__ int build_tile_table(const Ctx& F, gu32* gcnt) {
    LAS int* tst = (LAS int*)(F.lds + LX_TAB + 512); LAS unsigned char* te = (LAS unsigned char*)(F.lds + LX_TILE);
    LAS int* tcn = tst + 40;
    if (F.tid < NE) tcn[F.tid] = (int)__hip_atomic_load(gcnt + F.tid, RLX_AGENT);
    __syncthreads();
    if (F.tid == 0) { int acc = 0; for (int e = 0; e < NE; ++e) { tst[e] = acc; acc += (tcn[e] + 255) >> 8; } tst[NE] = acc; }
    __syncthreads();
    if (F.tid < NE) { const int t0 = tst[F.tid], t1 = tst[F.tid + 1]; for (int t = t0; t < t1; ++t) te[t] = (unsigned char)F.tid; }
    __syncthreads();
    return __builtin_amdgcn_readfirstlane(tst[NE]);
}

template <bool LAST> __device__ __forceinline__ void cb_token(const v2u (&yv)[2][4], const v4u (&xw)[2], const f32x4 (&gy)[4], const f32x4 (&gn)[4], const f32x4 (&s0v)[4], bf16* X, unsigned char* H, float* out, int tok, int lane, bool poison) {
    f32x4 x[4]; float ss = 0.f;
#pragma unroll
    for (int j = 0; j < 2; ++j) {
        const v2u y0 = yv[j][0], y1 = yv[j][1], y2 = yv[j][2], y3 = yv[j][3]; const v4u xx = xw[j];
        const f32x4 xa = (f32x4){bflo(xx.x), bfhi(xx.x), bflo(xx.y), bfhi(xx.y)}, xb = (f32x4){bflo(xx.z), bfhi(xx.z), bflo(xx.w), bfhi(xx.w)};
        f32x4 sa, sb;
#define F8X(w, k) __builtin_amdgcn_cvt_f32_fp8((int)(w), (k))
        sa.x = ((F8X(y0.x, 0) + F8X(y1.x, 0)) + F8X(y2.x, 0)) + F8X(y3.x, 0); sa.y = ((F8X(y0.x, 1) + F8X(y1.x, 1)) + F8X(y2.x, 1)) + F8X(y3.x, 1);
        sa.z = ((F8X(y0.x, 2) + F8X(y1.x, 2)) + F8X(y2.x, 2)) + F8X(y3.x, 2); sa.w = ((F8X(y0.x, 3) + F8X(y1.x, 3)) + F8X(y2.x, 3)) + F8X(y3.x, 3);
        sb.x = ((F8X(y0.y, 0) + F8X(y1.y, 0)) + F8X(y2.y, 0)) + F8X(y3.y, 0); sb.y = ((F8X(y0.y, 1) + F8X(y1.y, 1)) + F8X(y2.y, 1)) + F8X(y3.y, 1);
        sb.z = ((F8X(y0.y, 2) + F8X(y1.y, 2)) + F8X(y2.y, 2)) + F8X(y3.y, 2); sb.w = ((F8X(y0.y, 3) + F8X(y1.y, 3)) + F8X(y2.y, 3)) + F8X(y3.y, 3);
#undef F8X
        x[2 * j] = xa + gy[2 * j] * sa; x[2 * j + 1] = xb + gy[2 * j + 1] * sb;
        ss += (x[2 * j].x * x[2 * j].x + x[2 * j].y * x[2 * j].y) + (x[2 * j].z * x[2 * j].z + x[2 * j].w * x[2 * j].w) + (x[2 * j + 1].x * x[2 * j + 1].x + x[2 * j + 1].y * x[2 * j + 1].y) + (x[2 * j + 1].z * x[2 * j + 1].z + x[2 * j + 1].w * x[2 * j + 1].w); }
    const float rinv = 1.0f / sqrtf(wave_sum(ss, lane) * (1.f / DM) + EPS);
#pragma unroll
    for (int j = 0; j < 2; ++j) { const int col = 512 * j + 8 * lane;
        if (LAST) { f32x4 o0 = (x[2 * j] * rinv) * gn[2 * j], o1 = (x[2 * j + 1] * rinv) * gn[2 * j + 1];
            if (poison) { const float qn = __builtin_nanf(""); o0 = (f32x4){qn, qn, qn, qn}; o1 = o0; }
            *(GAS f32x4*)(out + (size_t)tok * DM + col) = o0; *(GAS f32x4*)(out + (size_t)tok * DM + col + 4) = o1; }
        else { { v4u xo; xo.x = pk2(x[2 * j].x, x[2 * j].y); xo.y = pk2(x[2 * j].z, x[2 * j].w); xo.z = pk2(x[2 * j + 1].x, x[2 * j + 1].y); xo.w = pk2(x[2 * j + 1].z, x[2 * j + 1].w); *(GAS v4u*)(X + (size_t)tok * DM + col) = xo; }
            const f32x4 ya = (x[2 * j] * rinv) * gn[2 * j] + s0v[2 * j], yb = (x[2 * j + 1] * rinv) * gn[2 * j + 1] + s0v[2 * j + 1];
            v2u o; o.x = pg8::pk4_fp8(ya.x * pg8::F8_SA, ya.y * pg8::F8_SA, ya.z * pg8::F8_SA, ya.w * pg8::F8_SA); o.y = pg8::pk4_fp8(yb.x * pg8::F8_SA, yb.y * pg8::F8_SA, yb.z * pg8::F8_SA, yb.w * pg8::F8_SA);
            *(GAS v2u*)(H + (size_t)tok * DM + col) = o; } }
}
template <bool LAST> __device__ __forceinline__ void p_combine(const Ctx& F, const float* mod_l, const float* g_next, const float* mod_next, float* out, bool poison) {
    bf16* X = (bf16*)(F.ws + WS_X); const unsigned char* Y = (const unsigned char*)(F.ws + WS_Y);   const int* SLOT = (const int*)(F.ws + WS_SLOT); unsigned char* H = (unsigned char*)(F.ws + WS_H);
    constexpr int TPW = NTOK / (256 * NWAVES);
    const int lane = F.lane; const int t0 = (F.vcu * NWAVES + F.wave) * TPW; const int b = t0 >> 11;
    f32x4 gy[4], gn[4], s0v[4];
#pragma unroll
    for (int j = 0; j < 2; ++j) { const int col = 512 * j + 8 * lane; const float* gt2 = mod_l + (size_t)b * 6144 + 5 * 1024;
        gy[2 * j] = *(const GAS f32x4*)(gt2 + col) * (1.0f / pg8::F8_SY); gy[2 * j + 1] = *(const GAS f32x4*)(gt2 + col + 4) * (1.0f / pg8::F8_SY);
        gn[2 * j] = *(const GAS f32x4*)(g_next + col); gn[2 * j + 1] = *(const GAS f32x4*)(g_next + col + 4);
        if (!LAST) { const float* sh = mod_next + (size_t)b * 6144; const float* sc = sh + 1024;
            gn[2 * j] = gn[2 * j] * (*(const GAS f32x4*)(sc + col) + 1.0f); gn[2 * j + 1] = gn[2 * j + 1] * (*(const GAS f32x4*)(sc + col + 4) + 1.0f);
            s0v[2 * j] = *(const GAS f32x4*)(sh + col); s0v[2 * j + 1] = *(const GAS f32x4*)(sh + col + 4); }
        else { s0v[2 * j] = (f32x4){0.f, 0.f, 0.f, 0.f}; s0v[2 * j + 1] = s0v[2 * j]; } }
    const v4u my = *(const GAS v4u*)(SLOT + (size_t)(t0 + (lane & (TPW - 1))) * 4);
    const int m0 = (int)my.x, m1 = (int)my.y, m2 = (int)my.z, m3 = (int)my.w;
    v2u yA[2][2][4], yB[2][2][4]; v4u xA[2][2], xB[2][2];
#define CB_ISSUE(YV, XW, I) do { _Pragma("unroll") for (int q_ = 0; q_ < 2; ++q_) { const int ti_ = (I) + q_; \
        const unsigned char* r0_ = Y + (size_t)(unsigned)__builtin_amdgcn_readlane(m0, ti_) * DM; const unsigned char* r1_ = Y + (size_t)(unsigned)__builtin_amdgcn_readlane(m1, ti_) * DM; \
        const unsigned char* r2_ = Y + (size_t)(unsigned)__builtin_amdgcn_readlane(m2, ti_) * DM; const unsigned char* r3_ = Y + (size_t)(unsigned)__builtin_amdgcn_readlane(m3, ti_) * DM; \
        _Pragma("unroll") for (int j_ = 0; j_ < 2; ++j_) { const int col_ = 512 * j_ + 8 * lane; \
            YV[q_][j_][0] = *(const GAS v2u*)(r0_ + col_); YV[q_][j_][1] = *(const GAS v2u*)(r1_ + col_); YV[q_][j_][2] = *(const GAS v2u*)(r2_ + col_); YV[q_][j_][3] = *(const GAS v2u*)(r3_ + col_); \
            XW[q_][j_] = *(const GAS v4u*)(X + (size_t)(t0 + ti_) * DM + col_); } } } while (0)
#define CB_COMP(YV, XW, I) do { cb_token<LAST>(YV[0], XW[0], gy, gn, s0v, X, H, out, t0 + (I), lane, poison); cb_token<LAST>(YV[1], XW[1], gy, gn, s0v, X, H, out, t0 + (I) + 1, lane, poison); } while (0)
    CB_ISSUE(yA, xA, 0);
#pragma unroll 1
    for (int i = 0; i < TPW; i += 4) {
        CB_ISSUE(yB, xB, i + 2);
        CB_COMP(yA, xA, i);
        if (i + 4 < TPW) CB_ISSUE(yA, xA, i + 4);
        CB_COMP(yB, xB, i + 2);
    }
#undef CB_ISSUE
#undef CB_COMP
}
struct Args { const float* in[21]; float* out; unsigned char* ws; int ph_lo, ph_hi, li, pad; };
enum { I_X = 0, I_C, I_WMOD, I_BMOD, I_GMIX, I_WIN, I_GQ, I_GK, I_WDW, I_BDW, I_GCN, I_BCN, I_WOUT, I_GFFN, I_WR, I_BR, I_W1, I_B1, I_W2, I_B2, I_GFIN };

#define IN(k) (lo <= (k) && (k) < hi)
#define KAS __attribute__((address_space(4)))
#define ARG(k) (*(const float* const KAS*)(kap + 8 * (k)))
#define ARG_OUT (*(float* const KAS*)(kap + 8 * 21))
#define LAUNDER(P) const KAS char* kap = (const KAS char*)__builtin_amdgcn_kernarg_segment_ptr(); asm volatile("" : "+s"(kap)); Ctx P = F0; { unsigned z_ = 0u; asm volatile("" : "+v"(z_)); P.lane = (int)__builtin_amdgcn_mbcnt_hi(~0u, __builtin_amdgcn_mbcnt_lo(~0u, z_)); }     P.tid = P.wave * 64 + P.lane; asm volatile("" : "+v"(P.tid), "+v"(P.lane), "+s"(P.ws), "+s"(P.ctl))
#ifndef DBG_REP
#define DBG_REP -1
#endif
#define REPP(k) for (int rep_ = 0; rep_ < ((DBG_REP == (k)) ? 2 : 1); ++rep_)
#ifdef DBG_BAR2
#define SEAM(k) do { if (IN(k) && IN((k) + 1)) { xcd_barrier(bar); xcd_barrier(bar); } } while (0)
#else
#define SEAM(k) do { if (IN(k) && IN((k) + 1)) xcd_barrier(bar); } while (0)
#endif

template <int L> __device__ __forceinline__ void layer_body(const Ctx& F0, const Args& args, const XcdBarrier& bar, const int lo, const int hi, unsigned char* lds_generic) {
    constexpr int pb = 1 + 10 * L;
    if (L == 0 && IN(pb)) REPP(pb) { LAUNDER(F);
        constexpr int TPW = NTOK / (256 * NWAVES); const int lane = F.lane; const int t0 = (F.vcu * NWAVES + F.wave) * TPW;
        const float* x = ARG(I_X); const float* g = ARG(I_GMIX); const float* ma = (const float*)(F.ws + WS_MOD) + (size_t)L * NB * 6144 + (size_t)(t0 >> 11) * 6144; unsigned char* H = (unsigned char*)(F.ws + WS_H);
        f32x4 gs1[4], s0v[4];
#pragma unroll
        for (int j = 0; j < 4; ++j) { gs1[j] = ((const GAS f32x4*)g)[64 * j + lane] * (((const GAS f32x4*)(ma + 1024))[64 * j + lane] + 1.0f); s0v[j] = ((const GAS f32x4*)ma)[64 * j + lane]; }
        f32x4 vA[2][4], vB[2][4];
#define N1_ISSUE(V, I) do { _Pragma("unroll") for (int q_ = 0; q_ < 2; ++q_) _Pragma("unroll") for (int j_ = 0; j_ < 4; ++j_) V[q_][j_] = ((const GAS f32x4*)(x + (size_t)(t0 + (I) + q_) * DM))[64 * j_ + lane]; } while (0)
#define N1_COMP(V, I) do { _Pragma("unroll") for (int q_ = 0; q_ < 2; ++q_) { float ss_ = 0.f; \
            _Pragma("unroll") for (int j_ = 0; j_ < 4; ++j_) ss_ += (V[q_][j_].x * V[q_][j_].x + V[q_][j_].y * V[q_][j_].y) + (V[q_][j_].z * V[q_][j_].z + V[q_][j_].w * V[q_][j_].w); \
            const float ia_ = 1.0f / sqrtf(wave_sum_s(ss_) * (1.f / DM) + EPS); GAS unsigned* po_ = (GAS unsigned*)(H + (size_t)(t0 + (I) + q_) * DM) + lane; \
            _Pragma("unroll") for (int j_ = 0; j_ < 4; ++j_) { const f32x4 y_ = (V[q_][j_] * ia_) * gs1[j_] + s0v[j_]; po_[64 * j_] = pg8::pk4_fp8(y_.x * pg8::F8_SA, y_.y * pg8::F8_SA, y_.z * pg8::F8_SA, y_.w * pg8::F8_SA); } } } while (0)
        N1_ISSUE(vA, 0);
#pragma unroll 1
        for (int i = 0; i < TPW; i += 4) { N1_ISSUE(vB, i + 2); N1_COMP(vA, i); if (i + 4 < TPW) N1_ISSUE(vA, i + 4); N1_COMP(vB, i + 2); }
#undef N1_ISSUE
#undef N1_COMP
        SEAM(pb);
    }
    if (IN(pb + 1)) REPP(pb + 1) { LAUNDER(F);
        pg8::Gemm g{(const bf16*)(F.ws + WS_H), (const bf16*)(F.ws + WS_WIN + (size_t)L * INW * 1024), NTOK, INW, DM / 2, 0};
        pg8::StaticOrder S; S.init(NTOK, INW, F.G, (int)blockIdx.x);
        pg8::EpiInProj E{(bf16*)(F.ws + WS_Q), (bf16*)(F.ws + WS_KN), (bf16*)(F.ws + WS_V), (bf16*)(F.ws + WS_UU), ARG(I_GQ) + L * 64, ARG(I_GK) + L * 64, (const float*)(F.ws + WS_ROPE)};
        pg8::gemm_phase<pg8::EpiInProj, pg8::StaticOrder, true, true, true>(F.lds + RING_OFF, g, S, E, F.tid);
        SEAM(pb + 1);
    }
    if (IN(pb + 2)) REPP(pb + 2) { LAUNDER(F);
        p_conv(F, ARG(I_WDW) + (size_t)L * 31 * CC, ARG(I_BDW) + L * CC, ARG(I_GCN) + L * CC, ARG(I_BCN) + L * CC);
        SEAM(pb + 2);
    }
    if (IN(pb + 3)) REPP(pb + 3) { LAUNDER(F);
        static_assert(attn_body::ATTN_LDS_BYTES <= RING_BYTES, "attention body LDS vs frame");
        const attn_body::AttnTensors AT{(const attn_body::bf16*)(F.ws + WS_Q), (const attn_body::bf16*)(F.ws + WS_KN), (const attn_body::bf16*)(F.ws + WS_V), (attn_body::bf16*)(F.ws + WS_MIX)};
        const attn_body::StaticOrder S((int)F.G, (int)blockIdx.x);
        float mfix; bool afixed;
        { const float gq_ = wave_max_s(__builtin_fabsf(((const GAS float*)(ARG(I_GQ) + L * 64))[F.lane])), gk_ = wave_max_s(__builtin_fabsf(((const GAS float*)(ARG(I_GK) + L * 64))[F.lane]));
          mfix = attn_body::C2 * 64.0f * gq_ * gk_ * 1.01f + 0.25f; afixed = mfix <= 48.0f; }
        constexpr int ATT_SPLIT = 2; const int grp = F.vcu >> 7;
        if (afixed) {
#pragma unroll 1
        for (int seg = 0; seg < 3; ++seg) {
            const int kind = grp == 0 ? (seg == 0 ? 1 : seg == 1 ? 2 : 0) : (seg == 0 ? 3 : seg == 1 ? 1 : 4);
            if (kind == 1) { __syncthreads(); p_convert(F, ARG(I_WIN), ARG(I_WOUT), ARG(I_W1), ARG(I_W2), 1, L, (I_CV_W1L + I_CV_W2L) / 2, (F.vcu & 127) * NWAVES + F.wave, 128 * NWAVES, grp * ((I_CV_W1L + I_CV_W2L) / 2)); __syncthreads(); }
            else if (kind >= 2) attn_body::attn_phase<attn_body::StaticOrder, true>((char*)lds_generic + RING_OFF, AT, S, F.tid, kind == 4 ? ATT_SPLIT : 0, kind == 3 ? ATT_SPLIT : (1 << 30), mfix);
        }
        } else {
#pragma unroll 1
        for (int seg = 0; seg < 3; ++seg) {
            const int kind = grp == 0 ? (seg == 0 ? 1 : seg == 1 ? 2 : 0) : (seg == 0 ? 3 : seg == 1 ? 1 : 4);
            if (kind == 1) { __syncthreads(); p_convert(F, ARG(I_WIN), ARG(I_WOUT), ARG(I_W1), ARG(I_W2), 1, L, (I_CV_W1L + I_CV_W2L) / 2, (F.vcu & 127) * NWAVES + F.wave, 128 * NWAVES, grp * ((I_CV_W1L + I_CV_W2L) / 2)); __syncthreads(); }
            else if (kind >= 2) attn_body::attn_phase<attn_body::StaticOrder, false>((char*)lds_generic + RING_OFF, AT, S, F.tid, kind == 4 ? ATT_SPLIT : 0, kind == 3 ? ATT_SPLIT : (1 << 30), 0.f);
        }
        }
        SEAM(pb + 3);
    }
    if (IN(pb + 4)) REPP(pb + 4) { LAUNDER(F);
        pg8::Gemm g{(const bf16*)(F.ws + WS_MIX), (const bf16*)(F.ws + WS_WOUT + (size_t)L * 1024 * 1024), NTOK, DM, DM / 2, 0};
        pg8::StaticOrder S; S.init(NTOK, DM, F.G, (int)blockIdx.x);
        bf16* X = (bf16*)(F.ws + WS_X);
        pg8::EpiResGate<L == 0> E{L == 0 ? (const void*)ARG(I_X) : (const void*)X, X, (const float*)(F.ws + WS_MOD) + (size_t)L * NB * 6144 + 2 * 1024};
        pg8::gemm_phase<pg8::EpiResGate<L == 0>, pg8::StaticOrder, true, true, true>(F.lds + RING_OFF, g, S, E, F.tid);
        SEAM(pb + 4);
    }
    if (IN(pb + 5)) REPP(pb + 5) { LAUNDER(F);
        p_norm2_router(F, ARG(I_GFFN) + L * DM, ARG(I_WR) + (size_t)L * DM * NE, ARG(I_BR) + L * NE, (const float*)(F.ws + WS_MOD) + (size_t)L * NB * 6144, F.ctl + CW_CNT + 64 * L + ((DBG_REP == pb + 5 && rep_ == 0) ? 4096 : 0));
        SEAM(pb + 5);
    }
    if (IN(pb + 6)) REPP(pb + 6) { LAUNDER(F); p_perm(F, F.ctl + CW_CNT + 64 * L); SEAM(pb + 6); }
    if (IN(pb + 7)) REPP(pb + 7) { LAUNDER(F);
        const int T = build_tile_table(F, F.ctl + CW_CNT + 64 * L);
        pg8::Gemm g{(const bf16*)(F.ws + WS_H), (const bf16*)(F.ws + WS_W1 + (size_t)L * NE * 2048 * 1024), T * 256, 2048, DM / 2, (size_t)2048 * 1024};
        const unsigned long long pp_ = (unsigned long long)(F.ws + WS_PERM);
        const int* permp = (const int*)(((unsigned long long)(unsigned)__builtin_amdgcn_readfirstlane((int)(pp_ >> 32)) << 32) | (unsigned)__builtin_amdgcn_readfirstlane((int)(unsigned)pp_));
        pg8::MoeOrder<true, true> S{(const LAS unsigned char*)(F.lds + LX_TILE), T, F.G, F.vcu, permp, (LAS int*)(F.lds + LX_STG)};
        pg8::EpiSwiglu E{(unsigned char*)(F.ws + WS_ACT), ARG(I_B1) + (size_t)L * NE * 2048};
        pg8::gemm_phase<pg8::EpiSwiglu, pg8::MoeOrder<true, true>, true, true, true>(F.lds + RING_OFF, g, S, E, F.tid);
        SEAM(pb + 7);
    }
#ifdef DBG_DUP8
    if (L == 0 && IN(pb + 7)) { LAUNDER(F);
        const int T = build_tile_table(F, F.ctl + CW_CNT + 64 * L);
        pg8::Gemm g{(const bf16*)(F.ws + WS_H), (const bf16*)(F.ws + WS_W1 + (size_t)L * NE * 2048 * 1024), T * 256, 2048, DM / 2, (size_t)2048 * 1024};
        const unsigned long long pp_ = (unsigned long long)(F.ws + WS_PERM);
        const int* permp = (const int*)(((unsigned long long)(unsigned)__builtin_amdgcn_readfirstlane((int)(pp_ >> 32)) << 32) | (unsigned)__builtin_amdgcn_readfirstlane((int)(unsigned)pp_));
        pg8::MoeOrder<true, true> S{(const LAS unsigned char*)(F.lds + LX_TILE), T, F.G, F.vcu, permp, (LAS int*)(F.lds + LX_STG)};
        pg8::EpiSwiglu E{(unsigned char*)(F.ws + WS_ACT), ARG(I_B1) + (size_t)L * NE * 2048};
        pg8::gemm_phase<pg8::EpiSwiglu, pg8::MoeOrder<true, true>, true, true, true>(F.lds + RING_OFF, g, S, E, F.tid);
        SEAM(pb + 7);
    }
#endif
    if (IN(pb + 8)) REPP(pb + 8) { LAUNDER(F);
        const int T = build_tile_table(F, F.ctl + CW_CNT + 64 * L);
        pg8::Gemm g{(const bf16*)(F.ws + WS_ACT), (const bf16*)(F.ws + WS_W2 + (size_t)L * NE * 1024 * 1024), T * 256, DM, DM / 2, (size_t)1024 * 1024};
        pg8::MoeOrder<false, false, true> S{(const LAS unsigned char*)(F.lds + LX_TILE), T, F.G, F.vcu, nullptr, nullptr};
        pg8::EpiY E{(unsigned char*)(F.ws + WS_Y), ARG(I_B2) + (size_t)L * NE * 1024, (const float*)(F.ws + WS_PGATE)};
        pg8::gemm_phase<pg8::EpiY, pg8::MoeOrder<false, false, true>, true, true, true>(F.lds + RING_OFF, g, S, E, F.tid);
        SEAM(pb + 8);
    }
#ifdef DBG_DUP9
    if (L == 0 && IN(pb + 8)) { LAUNDER(F);
        const int T = build_tile_table(F, F.ctl + CW_CNT + 64 * L);
        pg8::Gemm g{(const bf16*)(F.ws + WS_ACT), (const bf16*)(F.ws + WS_W2 + (size_t)L * NE * 1024 * 1024), T * 256, DM, DM / 2, (size_t)1024 * 1024};
        pg8::MoeOrder<false, false, true> S{(const LAS unsigned char*)(F.lds + LX_TILE), T, F.G, F.vcu, nullptr, nullptr};
        pg8::EpiY E{(unsigned char*)(F.ws + WS_Y), ARG(I_B2) + (size_t)L * NE * 1024, (const float*)(F.ws + WS_PGATE)};
        pg8::gemm_phase<pg8::EpiY, pg8::MoeOrder<false, false, true>, true, true, true>(F.lds + RING_OFF, g, S, E, F.tid);
        SEAM(pb + 8);
    }
#endif
    if (IN(pb + 9)) REPP(pb + 9) { LAUNDER(F);
        const float* mod_l = (const float*)(F.ws + WS_MOD) + (size_t)L * NB * 6144;
        if (L == DEPTH - 1) {
            bool poison = false;
            for (int r = 0; r < NPH; ++r) poison |= __hip_atomic_load((gu32*)(F.ctl + CW_BAR + r * XCD_BAR_WORDS + XB_TMO), RLX_AGENT) != 0u;
            p_combine<true>(F, mod_l, ARG(I_GFIN), nullptr, ARG_OUT, poison);
        } else {
            p_combine<false>(F, mod_l, ARG(I_GMIX) + (L + 1) * DM, (const float*)(F.ws + WS_MOD) + (size_t)(L + 1) * NB * 6144, nullptr, false);
        }
        SEAM(pb + 9);
    }
}

__global__ void __launch_bounds__(NWAVES * 64, 2) enc_fwd(Args args) {
    extern __shared__ __attribute__((aligned(16))) unsigned char lds[];
    Ctx F0;
    F0.lds = (LAS unsigned char*)lds; F0.ws = args.ws; F0.ctl = (gu32*)(args.ws + WS_CTL);
    F0.tid = 0; F0.lane = 0; F0.wave = __builtin_amdgcn_readfirstlane((int)threadIdx.x >> 6);
    F0.G = gridDim.x; { const int bx = blockIdx.x; F0.vcu = (F0.G % 8 == 0) ? (bx % 8) * (F0.G / 8) + bx / 8 : bx; }
    volatile LAS unsigned* MISC = (volatile LAS unsigned*)(F0.lds + LX_MISC);
    for (int u = threadIdx.x; u < 128; u += NWAVES * 64) ((LAS unsigned*)(F0.lds + LX_MISC))[u] = 0u;
    __syncthreads();
    unsigned* barw = (unsigned*)(F0.ctl + CW_BAR) + args.li * XCD_BAR_WORDS;
    const XcdBarrier bar = xcd_barrier_post(barw, MISC + 8, (unsigned)F0.wave);
    const int lo = args.ph_lo, hi = args.ph_hi;
    if (IN(0)) REPP(0) { LAUNDER(F); p0_prologue(F, ARG(I_C), ARG(I_WMOD), ARG(I_BMOD), ARG(I_WIN), ARG(I_WOUT), ARG(I_W1), ARG(I_W2)); SEAM(0); }
    layer_body<0>(F0, args, bar, lo, hi, lds);
    layer_body<1>(F0, args, bar, lo, hi, lds);
#ifdef DBG_STOP
    if (IN(21)) { LAUNDER(F); const int gw = F.vcu * NWAVES + F.wave, NGW = F.G * NWAVES, lane = F.lane; const float* X = (DBG_STOP == 0) ? ARG(I_X) : (const float*)(F.ws + WS_X); const float* g = ARG(I_GFIN);
        for (int tok = gw; tok < NTOK; tok += NGW) { const GAS f32x4* xr = (const GAS f32x4*)(X + (size_t)tok * DM) + lane; f32x4 v[4]; float ss = 0.f;
            for (int j = 0; j < 4; ++j) { v[j] = xr[64 * j]; ss += (v[j].x * v[j].x + v[j].y * v[j].y) + (v[j].z * v[j].z + v[j].w * v[j].w); }
            const float rinv = 1.0f / sqrtf(wave_sum(ss, lane) * (1.f / DM) + EPS);
            for (int j = 0; j < 4; ++j) ((GAS f32x4*)(ARG_OUT + (size_t)tok * DM))[64 * j + lane] = (v[j] * rinv) * ((const GAS f32x4*)g)[64 * j + lane]; } }
#endif
}
#undef IN
#undef SEAM
#undef LAUNDER

extern "C" void kernel_launch(void* const* d_in, const int* in_sizes, int n_in, void* d_out, int out_size, void* d_ws, size_t ws_size, hipStream_t stream) {
    static int grid = 0;
    if (grid == 0) {
        if (n_in != 21 || in_sizes[0] != NTOK * DM || out_size != NTOK * DM || ws_size < WS_END) { fprintf(stderr, "kernel_launch: shape/workspace mismatch (n_in %d, in0 %d, out %d, ws %zu, need %zu); nothing launched\n", n_in, n_in > 0 ? in_sizes[0] : -1, out_size, ws_size, (size_t)WS_END); grid = -1; return; }
        int dev = 0, cus = 0, per_cu = 0;
        if (hipGetDevice(&dev) != hipSuccess || hipDeviceGetAttribute(&cus, hipDeviceAttributeMultiprocessorCount, dev) != hipSuccess) { fprintf(stderr, "kernel_launch: device query failed\n"); grid = -1; return; }
        if (hipFuncSetAttribute((const void*)enc_fwd, hipFuncAttributeMaxDynamicSharedMemorySize, LDS_BYTES) != hipSuccess) { fprintf(stderr, "kernel_launch: hipFuncSetAttribute failed\n"); grid = -1; return; }
        if (hipOccupancyMaxActiveBlocksPerMultiprocessor(&per_cu, (const void*)enc_fwd, NWAVES * 64, LDS_BYTES) != hipSuccess || per_cu < 1) fprintf(stderr, "kernel_launch: note: occupancy query reports %d workgroups per CU\n", per_cu);
        (void)hipGetLastError();
        if (cus != 256) { fprintf(stderr, "kernel_launch: built for a 256-CU device, found %d; nothing launched\n", cus); grid = -1; return; }
        grid = cus;
    }
    if (grid < 0) return;
    if (hipMemsetAsync((char*)d_ws + WS_CTL, 0, CTL_ZERO_BYTES, stream) != hipSuccess) { fprintf(stderr, "kernel_launch: hipMemsetAsync failed\n"); return; }
    Args a{};
    for (int i = 0; i < 21; ++i) a.in[i] = (const float*)d_in[i];
    a.out = (float*)d_out; a.ws = (unsigned char*)d_ws;
#if MK_PER_PHASE
    for (int li = 0; li < NPH; ++li) { if (li == 11) continue;
#ifdef DBG_STOP
        if (li > DBG_STOP) continue;
#endif
        a.ph_lo = li; a.ph_hi = li + 1; a.li = li;
        hipLaunchKernelGGL(enc_fwd, dim3(grid), dim3(NWAVES * 64), LDS_BYTES, stream, a); }
#ifdef DBG_STOP
    a.ph_lo = 21; a.ph_hi = 22; a.li = 20; hipLaunchKernelGGL(enc_fwd, dim3(grid), dim3(NWAVES * 64), LDS_BYTES, stream, a);
#endif
#else
    a.ph_lo = 0; a.ph_hi = NPH; a.li = 0;
    hipLaunchKernelGGL(enc_fwd, dim3(grid), dim3(NWAVES * 64), LDS_BYTES, stream, a);
#endif
    const hipError_t le = hipPeekAtLastError();
    if (le != hipSuccess) fprintf(stderr, "kernel_launch: launch failed: %s\n", hipGetErrorName(le));
}
```

```cpp
#include <hip/hip_runtime.h>
#include <hip/hip_bf16.h>
#include <cstdio>
#include <cstdint>
#include <cmath>
#ifndef MK_PER_PHASE
#define MK_PER_PHASE 0
#endif
namespace pg8 {
#define PG8_LAS __attribute__((address_space(3)))
typedef unsigned short bf16_t;
typedef short bf16x8 __attribute__((ext_vector_type(8)));
typedef float f32x4 __attribute__((ext_vector_type(4)));
typedef unsigned u32x4 __attribute__((ext_vector_type(4)));
constexpr int BM = 256, BK = 64, HALF = 128, HTB = HALF * BK * 2  , STAGE_BYTES = 8 * HTB, NXCD = 8, WGM = 8;

__host__ __device__ __forceinline__ int lds_byte(int r, int c) { const int st = (r >> 4) * 2 + (c >> 5), rr = r & 15, cc = c & 31, ob = rr * 64 + cc * 2; return st * 1024 + (ob ^ (((ob >> 9) & 1) << 5)); }
__host__ __device__ __forceinline__ void stage_rc(int b, int& R, int& C) { const int st = b / 1024, sb = b % 1024, swz = sb ^ (((sb >> 9) & 1) << 5); R = (st >> 1) * 16 + swz / 64; C = (st & 1) * 32 + (swz % 64) / 2; }
__host__ __device__ __forceinline__ int perm32(int rho) { const int n = rho >> 4, i = rho & 15; return 8 * (i >> 2) + 4 * n + (i & 3); }


#define PG8_GAS __attribute__((address_space(1)))
typedef int v8i_t __attribute__((ext_vector_type(8)));
typedef int v4i_t __attribute__((ext_vector_type(4)));
#ifndef PG8_F8_SCALE
#define PG8_F8_SCALE 0
#endif
__device__ __forceinline__ void pg8_glds(const void* sbase, unsigned voff, unsigned ldsdst) { unsigned keep;
    asm volatile("s_mov_b32 %0, m0\n\ts_mov_b32 m0, %3\n\ts_nop 0\n\tglobal_load_lds_dwordx4 %1, %2\n\ts_mov_b32 m0, %0" : "=&s"(keep) : "v"(voff), "s"(sbase), "s"(ldsdst) : "memory"); }
template <class T> __device__ __forceinline__ T* pg8_uniform(T* p) { const unsigned long long v = (unsigned long long)p;
    return (T*)(((unsigned long long)(unsigned)__builtin_amdgcn_readfirstlane((int)(v >> 32)) << 32) | (unsigned)__builtin_amdgcn_readfirstlane((int)(unsigned)v)); }
__device__ __forceinline__ v8i_t pg8_cat(bf16x8 lo, bf16x8 hi) { const v4i_t a = __builtin_bit_cast(v4i_t, lo), b = __builtin_bit_cast(v4i_t, hi); return __builtin_shufflevector(a, b, 0, 1, 2, 3, 4, 5, 6, 7); }

struct Unit { int pm, pn, e; };
struct Gemm { const bf16_t* A; const bf16_t* Bt; int M, N, K; size_t estride; };

struct StaticOrder {
    static constexpr bool GATHER = false; const int* perm; PG8_LAS int* ptab;
    int nM, nN, nwg, G, c;
    __host__ __device__ void init(int M, int N, int G_, int c_) { nM = M / BM; nN = N / BM; nwg = nM * nN; G = G_; c = c_; }
    __host__ __device__ bool next(int i, Unit& u) const {
        const long L = (long)i * G + c; if (L >= nwg) return false;
        int wgid = (int)L; { const int q = nwg / NXCD, r = nwg % NXCD, xcd = wgid % NXCD, off = wgid / NXCD; wgid = (xcd < r ? xcd * (q + 1) : r * (q + 1) + (xcd - r) * q) + off; }
        const int nig = WGM * nN, gid = wgid / nig, fm = gid * WGM, gsz = (nM - fm) < WGM ? (nM - fm) : WGM;
        u.pm = fm + ((wgid % nig) % gsz); u.pn = (wgid % nig) / gsz; u.e = 0; return true;
    }
    __device__ __forceinline__ void a_ready(const Unit&) const {}
    __device__ __forceinline__ void done(const Unit&) const {}
};
struct RowOrder {
    static constexpr bool GATHER = false; const int* perm; PG8_LAS int* ptab;
    int nM, nN, G, vcu;
    __device__ __forceinline__ bool next(int i, Unit& u) const { const int lap = i / nN, pm = lap * G + vcu; if (pm >= nM) return false; u.pm = pm; u.pn = i - lap * nN; u.e = 0; return true; }
    __device__ __forceinline__ void a_ready(const Unit&) const {}
    __device__ __forceinline__ void done(const Unit&) const {}
};
template <int LOGN, bool GATHER_ = false> struct MoeRowOrder {
    static constexpr bool GATHER = GATHER_;
    const PG8_LAS unsigned char* tile_e; int T, G, vcu; const int* perm; PG8_LAS int* ptab;
    __device__ __forceinline__ bool next(int i, Unit& u) const {
        const int fl = T / G, nfull = fl << LOGN;
        int t, pn;
        if (i < nfull) { t = (i >> LOGN) * G + vcu; pn = i & ((1 << LOGN) - 1); }
        else { const int v = (i - nfull) * G + vcu; t = fl * G + (v >> LOGN); pn = v & ((1 << LOGN) - 1); if (t >= T) return false; }
        u.pm = t; u.pn = pn; u.e = __builtin_amdgcn_readfirstlane((int)tile_e[t]); return true;
    }
    __device__ __forceinline__ void a_ready(const Unit&) const {}
    __device__ __forceinline__ void done(const Unit&) const {}
};
template <bool NN8, bool GATHER_ = false, bool REV = false> struct MoeOrder {
    static constexpr bool GATHER = GATHER_;
    const PG8_LAS unsigned char* tile_e; int T, G, vcu; const int* perm; PG8_LAS int* ptab;
    __device__ __forceinline__ bool next(int i, Unit& u) const {
        const int v = i * G + vcu, grp = v >> 5, j = v & 31;
        const int t = NN8 ? (4 * grp + (j & 3)) : (8 * grp + (j & 7));
        if (t >= T) return false;
        u.pm = REV ? (T - 1 - t) : t; u.pn = NN8 ? (j >> 2) : (j >> 3); u.e = __builtin_amdgcn_readfirstlane((int)tile_e[u.pm]); return true;
    }
    __device__ __forceinline__ void a_ready(const Unit&) const {}
    __device__ __forceinline__ void done(const Unit&) const {}
};

__device__ __forceinline__ unsigned cvt_pk_bf16(float lo, float hi) { unsigned r; asm volatile("v_cvt_pk_bf16_f32 %0, %1, %2" : "=v"(r) : "v"(lo), "v"(hi)); return r; }

constexpr float F8_SA = 8.f, F8_SW = 1024.f, F8_SACT = 8.f;
constexpr float F8_SMIX = 16.f;
constexpr float F8_DQ_OUT = 1.0f / (F8_SMIX * F8_SW);
constexpr float F8_DQ_IN = 1.0f / (F8_SA * F8_SW);
struct EpiInProj {
    static constexpr bool PERM = true, AFTER_DRAIN = false, STAGED = false;
    bf16_t* Q; bf16_t* KN; bf16_t* V; bf16_t* U; const float* g_q; const float* g_k; const float* rope;
    __device__ __forceinline__ void operator()(const f32x4 (&acc)[2][2][4][2], const Unit& u, int wr, int wc, int fr, int fq) const {
        const int row0 = u.pm * BM + wr * 64 + fr;
        if (u.pn >= 3) {
            bf16_t* op = U + (size_t)row0 * 512 + (u.pn - 3) * HALF + wc * 32 + 8 * fq;
#pragma unroll
            for (int ai = 0; ai < 2; ++ai)
#pragma unroll
                for (int m = 0; m < 4; ++m) { float o[8];
#pragma unroll
                    for (int n = 0; n < 2; ++n)
#pragma unroll
                        for (int j = 0; j < 4; ++j) o[4 * n + j] = (acc[ai][0][m][n][j] * F8_DQ_IN) * __builtin_amdgcn_rcpf(1.0f + __builtin_amdgcn_exp2f((-1.4426950408889634f * F8_DQ_IN) * acc[ai][1][m][n][j]));
                    u32x4 w; w.x = cvt_pk_bf16(o[0], o[1]); w.y = cvt_pk_bf16(o[2], o[3]); w.z = cvt_pk_bf16(o[4], o[5]); w.w = cvt_pk_bf16(o[6], o[7]);
                    *(PG8_GAS u32x4*)(op + (size_t)(ai * HALF + m * 16) * 512) = w; }
            return;
        }
        if (u.pn == 2 && wc >= 2) {
            bf16_t* op = V + (size_t)row0 * 128 + (wc - 2) * 64 + 8 * fq;
#pragma unroll
            for (int ai = 0; ai < 2; ++ai)
#pragma unroll
                for (int m = 0; m < 4; ++m)
#pragma unroll
                    for (int bj = 0; bj < 2; ++bj) { const f32x4 v0 = acc[ai][bj][m][0] * F8_DQ_IN, v1 = acc[ai][bj][m][1] * F8_DQ_IN;
                        u32x4 w; w.x = cvt_pk_bf16(v0[0], v0[1]); w.y = cvt_pk_bf16(v0[2], v0[3]); w.z = cvt_pk_bf16(v1[0], v1[1]); w.w = cvt_pk_bf16(v1[2], v1[3]);
                        *(PG8_GAS u32x4*)(op + (size_t)(ai * HALF + m * 16) * 128 + bj * 32) = w; }
            return;
        }
        const bool isq = u.pn < 2; const int lane = fr + 16 * fq;
        const float* gp = (isq ? g_q : g_k) + 32 * (fq >> 1) + 8 * (fq & 1);
        f32x4 g1[2], g2[2];
#pragma unroll
        for (int n = 0; n < 2; ++n) { g1[n] = *(const PG8_GAS f32x4*)(gp + 4 * n); g2[n] = *(const PG8_GAS f32x4*)(gp + 16 + 4 * n); }
        const float qs = isq ? 0.125f * 1.4426950408889634f : 1.0f;
        bf16_t* op = isq ? (Q + (size_t)row0 * 512 + (4 * u.pn + wc) * 64 + 8 * fq) : (KN + (size_t)row0 * 128 + wc * 64 + 8 * fq);
        const int ostride = isq ? 512 : 128;
#pragma unroll
        for (int ai = 0; ai < 2; ++ai)
#pragma unroll
            for (int m = 0; m < 4; ++m) { const int rr = ai * HALF + m * 16;
                const f32x4 a0 = acc[ai][0][m][0] * F8_DQ_IN, a1 = acc[ai][0][m][1] * F8_DQ_IN, b0 = acc[ai][1][m][0] * F8_DQ_IN, b1 = acc[ai][1][m][1] * F8_DQ_IN;
                float ss = (a0[0] * a0[0] + a0[1] * a0[1]) + (a0[2] * a0[2] + a0[3] * a0[3]) + (a1[0] * a1[0] + a1[1] * a1[1]) + (a1[2] * a1[2] + a1[3] * a1[3])
                         + (b0[0] * b0[0] + b0[1] * b0[1]) + (b0[2] * b0[2] + b0[3] * b0[3]) + (b1[0] * b1[0] + b1[1] * b1[1]) + (b1[2] * b1[2] + b1[3] * b1[3]);
                ss += __builtin_bit_cast(float, __builtin_amdgcn_ds_bpermute((lane ^ 16) << 2, __builtin_bit_cast(int, ss)));
                ss += __builtin_bit_cast(float, __builtin_amdgcn_ds_bpermute((lane ^ 32) << 2, __builtin_bit_cast(int, ss)));
                const float rinv = qs / __builtin_sqrtf(ss * (1.0f / 64.0f) + 1e-6f);
                const float* rp = rope + (size_t)((row0 + rr) & 2047) * 64 + 8 * fq;
                const f32x4 c0 = *(const PG8_GAS f32x4*)(rp), c1 = *(const PG8_GAS f32x4*)(rp + 4), s0 = *(const PG8_GAS f32x4*)(rp + 32), s1 = *(const PG8_GAS f32x4*)(rp + 36);
                const f32x4 y10 = a0 * rinv * g1[0], y11 = a1 * rinv * g1[1], y20 = b0 * rinv * g2[0], y21 = b1 * rinv * g2[1];
                const f32x4 o10 = y10 * c0 - y20 * s0, o11 = y11 * c1 - y21 * s1, o20 = y20 * c0 + y10 * s0, o21 = y21 * c1 + y11 * s1;
                u32x4 w; w.x = cvt_pk_bf16(o10[0], o10[1]); w.y = cvt_pk_bf16(o10[2], o10[3]); w.z = cvt_pk_bf16(o11[0], o11[1]); w.w = cvt_pk_bf16(o11[2], o11[3]);
                *(PG8_GAS u32x4*)(op + (size_t)rr * ostride) = w;
                w.x = cvt_pk_bf16(o20[0], o20[1]); w.y = cvt_pk_bf16(o20[2], o20[3]); w.z = cvt_pk_bf16(o21[0], o21[1]); w.w = cvt_pk_bf16(o21[2], o21[3]);
                *(PG8_GAS u32x4*)(op + (size_t)rr * ostride + 32) = w; }
    }
};
__host__ __device__ __forceinline__ int inproj_row(int n) {
    if (n < 640) { const int head = n >> 6, d = n & 63, a = d >> 5, p = (d >> 4) & 1, f = d & 15; const int tile = head < 8 ? (head >> 2) : 2, wc = head & 3; return tile * 256 + 128 * p + 32 * wc + 16 * a + f; }
    if (n < 768) { const int c = n - 640, vh = c >> 6, d = c & 63; return 2 * 256 + 128 * (d >> 5) + 32 * (2 + vh) + (d & 31); }
    if (n < 1280) { const int c = n - 768; return (3 + (c >> 7)) * 256 + (c & 127); }
    { const int c = n - 1280; return (3 + (c >> 7)) * 256 + 128 + (c & 127); }
}
template <bool XIN_F32> struct EpiResGate {
    static constexpr bool PERM = true, AFTER_DRAIN = false, STAGED = false;
    const void* xin; bf16_t* xout; const float* gate;
    __device__ __forceinline__ void operator()(const f32x4 (&acc)[2][2][4][2], const Unit& u, int wr, int wc, int fr, int fq) const {
        const int row0 = u.pm * BM + wr * 64 + fr, col0 = u.pn * BM + wc * 32 + 8 * fq;
        const float* gp = gate + (size_t)((u.pm * BM) >> 11) * 6144 + col0;
        f32x4 gv[2][2];
#pragma unroll
        for (int bj = 0; bj < 2; ++bj)
#pragma unroll
            for (int n = 0; n < 2; ++n) gv[bj][n] = *(const PG8_GAS f32x4*)(gp + bj * HALF + 4 * n) * F8_DQ_OUT;
#pragma unroll
        for (int ai = 0; ai < 2; ++ai)
#pragma unroll
            for (int m = 0; m < 4; ++m) { const size_t ro = (size_t)(row0 + ai * HALF + m * 16) * 1024 + col0;
#pragma unroll
                for (int bj = 0; bj < 2; ++bj) { f32x4 x0, x1;
                    if constexpr (XIN_F32) { x0 = *(const PG8_GAS f32x4*)((const float*)xin + ro + bj * HALF); x1 = *(const PG8_GAS f32x4*)((const float*)xin + ro + bj * HALF + 4); }
                    else { const u32x4 xw = *(const PG8_GAS u32x4*)((const bf16_t*)xin + ro + bj * HALF);
                        x0 = (f32x4){__builtin_bit_cast(float, xw.x << 16), __builtin_bit_cast(float, xw.x & 0xffff0000u), __builtin_bit_cast(float, xw.y << 16), __builtin_bit_cast(float, xw.y & 0xffff0000u)};
                        x1 = (f32x4){__builtin_bit_cast(float, xw.z << 16), __builtin_bit_cast(float, xw.z & 0xffff0000u), __builtin_bit_cast(float, xw.w << 16), __builtin_bit_cast(float, xw.w & 0xffff0000u)}; }
                    const f32x4 v0 = x0 + gv[bj][0] * acc[ai][bj][m][0], v1 = x1 + gv[bj][1] * acc[ai][bj][m][1];
                    u32x4 w; w.x = cvt_pk_bf16(v0[0], v0[1]); w.y = cvt_pk_bf16(v0[2], v0[3]); w.z = cvt_pk_bf16(v1[0], v1[1]); w.w = cvt_pk_bf16(v1[2], v1[3]);
                    *(PG8_GAS u32x4*)(xout + ro + bj * HALF) = w; } }
    }
};
__device__ __forceinline__ unsigned pk4_fp8(float a, float b, float c, float d) {
    a = __builtin_amdgcn_fmed3f(a, -448.f, 448.f); b = __builtin_amdgcn_fmed3f(b, -448.f, 448.f); c = __builtin_amdgcn_fmed3f(c, -448.f, 448.f); d = __builtin_amdgcn_fmed3f(d, -448.f, 448.f);
    int w = 0; w = __builtin_amdgcn_cvt_pk_fp8_f32(a, b, w, false); w = __builtin_amdgcn_cvt_pk_fp8_f32(c, d, w, true); return (unsigned)w; }
struct EpiSwiglu {
    static constexpr bool PERM = true, AFTER_DRAIN = false, STAGED = true;
    __device__ __forceinline__ const float* stage_addr(const Unit& u, int tid) const { const int t8 = tid & 255; return b1 + (size_t)u.e * 2048 + (t8 < 128 ? u.pn * HALF + t8 : 1024 + u.pn * HALF + t8 - 128); }
    __device__ __forceinline__ float stage(const Unit& u, int tid) const { return tid < 256 ? ((const PG8_GAS float*)b1)[(size_t)u.e * 2048 + (tid < 128 ? u.pn * HALF + tid : 1024 + u.pn * HALF + tid - 128)] : 0.f; }
    unsigned char* O; const float* b1;
    typedef float f32x2 __attribute__((ext_vector_type(2)));
    __device__ __forceinline__ void operator()(const f32x4 (&acc)[2][2][4][2], const Unit& u, int wr, int wc, int fr, int fq, const PG8_LAS float* st) const {
        const int row0 = u.pm * BM + wr * 64 + fr; const int colh = u.pn * HALF + wc * 32 + 8 * fq;
        const PG8_LAS float* bp = st + wc * 32 + 8 * fq; constexpr float dq = 1.0f / (F8_SA * F8_SW);
        constexpr float NC = -1.702f * 1.4426950408889634f;
        f32x4 bg[2], bl[2];
#pragma unroll
        for (int n = 0; n < 2; ++n) { bg[n] = *(const PG8_LAS f32x4*)(bp + 4 * n); bl[n] = *(const PG8_LAS f32x4*)(bp + 128 + 4 * n) * F8_SACT + F8_SACT; }
        typedef unsigned u32x2 __attribute__((ext_vector_type(2)));
#pragma unroll
        for (int ai = 0; ai < 2; ++ai)
#pragma unroll
            for (int m = 0; m < 4; ++m) { f32x2 a[4];
#pragma unroll
                for (int n = 0; n < 2; ++n)
#pragma unroll
                    for (int h = 0; h < 2; ++h) { const f32x2 ag = (f32x2){acc[ai][0][m][n][2 * h], acc[ai][0][m][n][2 * h + 1]}, al = (f32x2){acc[ai][1][m][n][2 * h], acc[ai][1][m][n][2 * h + 1]};
                        const f32x2 bgv = (f32x2){bg[n][2 * h], bg[n][2 * h + 1]}, blv = (f32x2){bl[n][2 * h], bl[n][2 * h + 1]};
                        f32x2 g = ag * dq + bgv; g.x = __builtin_fminf(g.x, 7.0f); g.y = __builtin_fminf(g.y, 7.0f);
                        f32x2 l = al * (dq * F8_SACT) + blv; l.x = __builtin_amdgcn_fmed3f(l.x, -6.0f * F8_SACT, 8.0f * F8_SACT); l.y = __builtin_amdgcn_fmed3f(l.y, -6.0f * F8_SACT, 8.0f * F8_SACT);
                        f32x2 t = g * NC; t.x = __builtin_amdgcn_exp2f(t.x); t.y = __builtin_amdgcn_exp2f(t.y); t = t + 1.0f; t.x = __builtin_amdgcn_rcpf(t.x); t.y = __builtin_amdgcn_rcpf(t.y);
                        a[2 * n + h] = (g * t) * l; }
                u32x2 w; int w0 = 0, w1 = 0;
                w0 = __builtin_amdgcn_cvt_pk_fp8_f32(a[0].x, a[0].y, w0, false); w0 = __builtin_amdgcn_cvt_pk_fp8_f32(a[1].x, a[1].y, w0, true);
                w1 = __builtin_amdgcn_cvt_pk_fp8_f32(a[2].x, a[2].y, w1, false); w1 = __builtin_amdgcn_cvt_pk_fp8_f32(a[3].x, a[3].y, w1, true);
                w.x = (unsigned)w0; w.y = (unsigned)w1;
                *(PG8_GAS u32x2*)(O + (size_t)(row0 + ai * HALF + m * 16) * 1024 + colh) = w; }
    }
};
constexpr float F8_SY = 64.f;
struct EpiY {
    static constexpr bool PERM = true, AFTER_DRAIN = false, STAGED = true;
    unsigned char* O; const float* b2; const float* rowgate;
    __device__ __forceinline__ const float* stage_addr(const Unit& u, int tid) const { return tid < 256 ? rowgate + u.pm * BM + tid : b2 + (size_t)u.e * 1024 + u.pn * BM + tid - 256; }
    __device__ __forceinline__ float stage(const Unit& u, int tid) const { return tid < 256 ? ((const PG8_GAS float*)rowgate)[u.pm * BM + tid] : ((const PG8_GAS float*)b2)[(size_t)u.e * 1024 + u.pn * BM + tid - 256]; }
    __device__ __forceinline__ void operator()(const f32x4 (&acc)[2][2][4][2], const Unit& u, int wr, int wc, int fr, int fq, const PG8_LAS float* st) const {
        const int rl0 = wr * 64 + fr; const int col0 = u.pn * BM + wc * 32 + 8 * fq;
        const PG8_LAS float* bp = st + 256 + wc * 32 + 8 * fq; constexpr float dq = 1.0f / (F8_SACT * F8_SW);
        f32x4 bv[2][2];
#pragma unroll
        for (int bj = 0; bj < 2; ++bj)
#pragma unroll
            for (int n = 0; n < 2; ++n) bv[bj][n] = *(const PG8_LAS f32x4*)(bp + bj * HALF + 4 * n);
        typedef unsigned u32x2 __attribute__((ext_vector_type(2)));
#pragma unroll
        for (int ai = 0; ai < 2; ++ai)
#pragma unroll
            for (int m = 0; m < 4; ++m) { const int rl = rl0 + ai * HALF + m * 16; const float gt = st[rl] * F8_SY; unsigned char* rowp = O + (size_t)(u.pm * BM + rl) * 1024 + col0;
#pragma unroll
                for (int bj = 0; bj < 2; ++bj) { const f32x4 v0 = (acc[ai][bj][m][0] * dq + bv[bj][0]) * gt, v1 = (acc[ai][bj][m][1] * dq + bv[bj][1]) * gt;
                    u32x2 w; w.x = pk4_fp8(v0[0], v0[1], v0[2], v0[3]); w.y = pk4_fp8(v1[0], v1[1], v1[2], v1[3]);
                    *(PG8_GAS u32x2*)(rowp + bj * HALF) = w; } }
    }
};

template <class Epi, class Sched, bool ALIGN_EPI = false, bool SP2 = false, bool F8 = false>
__device__ __forceinline__ void gemm_phase(PG8_LAS unsigned char* lds, const Gemm g_in, const Sched& S, const Epi& E, const int tid_in) {
    Gemm g = g_in; g.A = pg8_uniform(g_in.A); g.Bt = pg8_uniform(g_in.Bt);
    int tid_ = tid_in; asm volatile("" : "+v"(tid_));
    const int tid = tid_, wid = __builtin_amdgcn_readfirstlane(tid >> 6), lane = tid & 63, wr = wid >> 2, wc = wid & 3, fr = lane & 15, fq = lane >> 4;
    const int K = g.K, nt = K / BK;
    unsigned voffA, voffB;
    { int R, C; stage_rc(tid * 16, R, C); const int Rb = Epi::PERM ? ((R & ~31) + perm32(R & 31)) : R; voffA = (unsigned)(R * K + C) * 2u; voffB = (unsigned)(Rb * K + C) * 2u; }
    constexpr bool GATHER = Sched::GATHER;
    unsigned tabR, tabC;
    { int R, C; stage_rc(tid * 16, R, C); tabR = (unsigned)R; tabC = (unsigned)C * 2u; }
    const unsigned rowb = (unsigned)K * 2u;
#define PG8_GA_RD(h, PAR) unsigned gr0_ = 0, gr1_ = 0; if constexpr (GATHER) { gr0_ = (unsigned)S.ptab[(PAR) * 256 + (h) * 128 + (int)tabR]; gr1_ = (unsigned)S.ptab[(PAR) * 256 + (h) * 128 + 64 + (int)tabR]; }
#define PG8_GA_IS(bufoff, kofs) do { unsigned vo0_ = gr0_ * rowb + tabC, vo1_ = gr1_ * rowb + tabC; asm volatile("" : "+v"(vo0_), "+v"(vo1_)); \
        __builtin_amdgcn_global_load_lds((const unsigned*)((const char*)g.A + (kofs) + vo0_), (PG8_LAS unsigned*)(lds + (bufoff) + ldsw), 16, 0, 0); \
        __builtin_amdgcn_global_load_lds((const unsigned*)((const char*)g.A + (kofs) + vo1_), (PG8_LAS unsigned*)(lds + (bufoff) + ldsw + 8192), 16, 0, 0); } while (0)
#define PG8_GA(bufoff, kofs, h, PAR) do { PG8_GA_RD(h, PAR); PG8_GA_IS(bufoff, kofs); } while (0)
#define PG8_STAGE_A2(bufoff, ptr, kofs) do { if constexpr (GATHER) { PG8_GA_IS(bufoff, kofs); } else { PG8_STAGE(bufoff, ptr, voffA); } } while (0)
#define PG8_STAGE_A(bufoff, ptr, kofs, h, PAR) do { if constexpr (GATHER) { PG8_GA(bufoff, kofs, h, PAR); } else { PG8_STAGE(bufoff, ptr, voffA); } } while (0)
    const size_t kstep = (size_t)(BK * 2);
    const size_t hstep = (size_t)HALF * K * 2;
    const size_t tstep = 2 * hstep;
    const unsigned ldsw = (unsigned)wid * 1024u;
    const int aoff = lds_byte(wr * 64 + fr, fq * 8), boff = lds_byte(wc * 32 + fr, fq * 8);
#define PG8_SA(b, h) (((b) * 2 + (h)) * HTB)
#define PG8_SB(b, h) ((4 + (b) * 2 + (h)) * HTB)
#define PG8_STAGE(bufoff, gbase, voff) do { _Pragma("unroll") for (int _i = 0; _i < 2; ++_i) { unsigned vo_ = (voff); asm volatile("" : "+v"(vo_));     \
        __builtin_amdgcn_global_load_lds((const unsigned*)((const char*)(gbase) + (size_t)_i * 64 * rowb + vo_), (PG8_LAS unsigned*)(lds + (bufoff) + ldsw + _i * 8192), 16, 0, 0); } } while (0)
#define PG8_LDA(dst, b, h) do { _Pragma("unroll") for (int m = 0; m < 4; ++m) _Pragma("unroll") for (int k = 0; k < 2; ++k) dst[m][k] = *(const PG8_LAS bf16x8*)(lds + PG8_SA(b, h) + aoff + m * 2048 + k * 1024); } while (0)
#define PG8_LDB(dst, b, h) do { _Pragma("unroll") for (int n = 0; n < 2; ++n) _Pragma("unroll") for (int k = 0; k < 2; ++k) dst[n][k] = *(const PG8_LAS bf16x8*)(lds + PG8_SB(b, h) + boff + n * 2048 + k * 1024); } while (0)
#define PG8_MMA(ai, bj, At, Bt) do { __builtin_amdgcn_s_setprio(1); if constexpr (F8) { _Pragma("unroll") for (int m = 0; m < 4; ++m) _Pragma("unroll") for (int n = 0; n < 2; ++n) \
        acc[ai][bj][m][n] = __builtin_amdgcn_mfma_scale_f32_16x16x128_f8f6f4(pg8_cat(Bt[n][0], Bt[n][1]), pg8_cat(At[m][0], At[m][1]), acc[ai][bj][m][n], 0, 0, 0, PG8_F8_SCALE, 0, PG8_F8_SCALE); } \
        else { _Pragma("unroll") for (int m = 0; m < 4; ++m) _Pragma("unroll") for (int n = 0; n < 2; ++n) _Pragma("unroll") for (int k = 0; k < 2; ++k) \
        acc[ai][bj][m][n] = __builtin_amdgcn_mfma_f32_16x16x32_bf16(Bt[n][k], At[m][k], acc[ai][bj][m][n], 0, 0, 0); } __builtin_amdgcn_s_setprio(0); } while (0)
#define PG8_WAIT_V(n) asm volatile("s_waitcnt vmcnt(" #n ")" ::: "memory")
#define PG8_WAIT_L(n) asm volatile("s_waitcnt lgkmcnt(" #n ")" ::: "memory")
#define PG8_BAR __builtin_amdgcn_s_barrier()
#define PG8_SCHED __builtin_amdgcn_sched_barrier(0)
    Unit cur, nxt; int ui = 0;
    if (!S.next(0, cur)) return;
    f32x4 acc[2][2][4][2];
#pragma unroll
    for (int a = 0; a < 2; ++a)
#pragma unroll
        for (int b = 0; b < 2; ++b)
#pragma unroll
            for (int m = 0; m < 4; ++m)
#pragma unroll
                for (int n = 0; n < 2; ++n) acc[a][b][m][n] = (f32x4){0.f, 0.f, 0.f, 0.f};
    bf16x8 At[4][2], B0[2][2], B1[2][2];
    const char* cA = (const char*)g.A + (size_t)cur.pm * tstep; const char* cB = (const char*)g.Bt + (size_t)cur.e * g.estride + (size_t)cur.pn * tstep;
    S.a_ready(cur);
    int par = 0;
    PG8_LAS float* const etab = (PG8_LAS float*)(lds + STAGE_BYTES + 4096 + 2048);
    if constexpr (Epi::STAGED) { etab[tid] = E.stage(cur, tid); if constexpr (!GATHER) { PG8_WAIT_L(0); PG8_BAR; } }
    if constexpr (GATHER) { if (tid < 256) { unsigned po_ = (unsigned)(cur.pm * 256 + tid) * 4u; asm volatile("" : "+v"(po_)); S.ptab[tid] = *(const __attribute__((address_space(1))) int*)((const char*)S.perm + po_); } PG8_WAIT_L(0); PG8_BAR; }
    if constexpr (SP2) {
        PG8_STAGE(PG8_SB(0, 0), cB, voffB); PG8_STAGE(PG8_SB(0, 1), cB + hstep, voffB); PG8_STAGE_A(PG8_SA(0, 0), cA, (size_t)0, 0, par); PG8_STAGE_A(PG8_SA(0, 1), cA + hstep, (size_t)0, 1, par);
        if (wr == 1) PG8_BAR;
        PG8_WAIT_V(2); PG8_BAR;
        PG8_STAGE(PG8_SB(1, 0), cB + kstep, voffB); PG8_STAGE_A(PG8_SA(1, 0), cA + kstep, kstep, 0, par); PG8_STAGE(PG8_SB(1, 1), cB + hstep + kstep, voffB);
        PG8_WAIT_V(6); PG8_BAR;
    } else {
        PG8_STAGE(PG8_SB(0, 0), cB, voffB); PG8_STAGE_A(PG8_SA(0, 0), cA, (size_t)0, 0, par); PG8_STAGE(PG8_SB(0, 1), cB + hstep, voffB); PG8_STAGE_A(PG8_SA(0, 1), cA + hstep, (size_t)0, 1, par);
        if (wr == 1) PG8_BAR;
        PG8_WAIT_V(4); PG8_BAR;
        PG8_STAGE(PG8_SB(1, 0), cB + kstep, voffB); PG8_STAGE_A(PG8_SA(1, 0), cA + kstep, kstep, 0, par); PG8_STAGE(PG8_SB(1, 1), cB + hstep + kstep, voffB);
        PG8_WAIT_V(6); PG8_BAR;
    }
    for (;;) {
        const bool has_next = S.next(ui + 1, nxt);
        const char* nA = has_next ? (const char*)g.A + (size_t)nxt.pm * tstep : cA; const char* nB = has_next ? (const char*)g.Bt + (size_t)nxt.e * g.estride + (size_t)nxt.pn * tstep : cB;
        int pv = 0; if constexpr (GATHER) { if (has_next) { unsigned po_ = (unsigned)(nxt.pm * 256 + (tid & 255)) * 4u; asm volatile("" : "+v"(po_)); const int* pa_ = (const int*)((const char*)S.perm + po_); asm volatile("global_load_dword %0, %1, off" : "+v"(pv) : "v"(pa_) : "memory"); } }
        const int npar = has_next ? (par ^ 1) : par;
        float ev = 0.f; if constexpr (Epi::STAGED) { if (has_next) { const float* ea_ = E.stage_addr(nxt, tid); asm volatile("global_load_dword %0, %1, off" : "+v"(ev) : "v"(ea_) : "memory"); } }
#pragma unroll 1
        for (int t = 0; t < nt; t += 2) {
            const bool last = (t == nt - 2);
            if constexpr (GATHER) { if (t == 2 && has_next) { int tl_ = tid; asm volatile("" : "+v"(tl_)); if (tl_ < 256) S.ptab[(par ^ 1) * 256 + tl_] = pv; } }
            if constexpr (Epi::STAGED) { if (t == 2 && has_next) { int tl_ = tid; asm volatile("" : "+v"(tl_)); etab[(par ^ 1) * 512 + tl_] = ev; } }
            const size_t k2 = last ? (size_t)0 : (size_t)(t + 2) * kstep; const int p2 = last ? npar : par;
            const char* a1 = cA + (size_t)(t + 1) * kstep;
            const char* a2 = last ? nA : cA + (size_t)(t + 2) * kstep; const char* b2 = last ? nB : cB + (size_t)(t + 2) * kstep;
            const char* a3 = a2 + kstep; const char* b3 = b2 + kstep;
            if (last && has_next) S.a_ready(nxt);
            if constexpr (SP2) {
            { PG8_GA_RD(1, par); PG8_LDB(B0, 0, 0); PG8_LDB(B1, 0, 1); PG8_SCHED; PG8_LDA(At, 0, 0); PG8_STAGE_A2(PG8_SA(1, 1), a1 + hstep, (size_t)(t + 1) * kstep); }
            PG8_WAIT_V(8); PG8_WAIT_L(0); PG8_BAR; PG8_MMA(0, 0, At, B0); PG8_MMA(0, 1, At, B1); PG8_BAR; PG8_SCHED;
            { PG8_GA_RD(0, p2); PG8_LDA(At, 0, 1); PG8_STAGE(PG8_SB(0, 0), b2, voffB); PG8_STAGE(PG8_SB(0, 1), b2 + hstep, voffB); PG8_STAGE_A2(PG8_SA(0, 0), a2, k2); }
            PG8_WAIT_V(8); PG8_WAIT_L(0); PG8_BAR; PG8_MMA(1, 0, At, B0); PG8_MMA(1, 1, At, B1); PG8_BAR; PG8_SCHED;
            { PG8_GA_RD(1, p2); PG8_LDB(B0, 1, 0); PG8_LDB(B1, 1, 1); PG8_SCHED; PG8_LDA(At, 1, 0); PG8_STAGE_A2(PG8_SA(0, 1), a2 + hstep, k2); }
            PG8_WAIT_V(8); PG8_WAIT_L(0); PG8_BAR; PG8_MMA(0, 0, At, B0); PG8_MMA(0, 1, At, B1); PG8_BAR; PG8_SCHED;
            { PG8_GA_RD(0, p2); PG8_LDA(At, 1, 1); PG8_STAGE(PG8_SB(1, 0), b3, voffB); PG8_STAGE(PG8_SB(1, 1), b3 + hstep, voffB); PG8_STAGE_A2(PG8_SA(1, 0), a3, k2 + kstep); }
            PG8_WAIT_V(8); PG8_WAIT_L(0); PG8_BAR; PG8_MMA(1, 0, At, B0); PG8_MMA(1, 1, At, B1); PG8_BAR; PG8_SCHED;
            } else {
            { PG8_GA_RD(1, par); PG8_LDB(B0, 0, 0); PG8_SCHED; PG8_LDA(At, 0, 0); PG8_STAGE_A2(PG8_SA(1, 1), a1 + hstep, (size_t)(t + 1) * kstep); }
            PG8_WAIT_L(8); PG8_BAR; PG8_WAIT_L(0); PG8_MMA(0, 0, At, B0); PG8_BAR; PG8_SCHED;
            PG8_LDB(B1, 0, 1); PG8_STAGE(PG8_SB(0, 0), b2, voffB);
            PG8_BAR; PG8_WAIT_L(0); PG8_MMA(0, 1, At, B1); PG8_BAR;
            { PG8_GA_RD(0, p2); PG8_LDA(At, 0, 1); PG8_STAGE_A2(PG8_SA(0, 0), a2, k2); }
            PG8_BAR; PG8_WAIT_L(0); PG8_MMA(1, 0, At, B0); PG8_BAR; PG8_SCHED;
            PG8_STAGE(PG8_SB(0, 1), b2 + hstep, voffB);
            PG8_WAIT_V(6); PG8_BAR; PG8_MMA(1, 1, At, B1); PG8_BAR;
            { PG8_GA_RD(1, p2); PG8_LDB(B0, 1, 0); PG8_SCHED; PG8_LDA(At, 1, 0); PG8_STAGE_A2(PG8_SA(0, 1), a2 + hstep, k2); }
            PG8_WAIT_L(8); PG8_BAR; PG8_WAIT_L(0); PG8_MMA(0, 0, At, B0); PG8_BAR; PG8_SCHED;
            PG8_LDB(B1, 1, 1); PG8_STAGE(PG8_SB(1, 0), b3, voffB);
            PG8_BAR; PG8_WAIT_L(0); PG8_MMA(0, 1, At, B1); PG8_BAR;
            { PG8_GA_RD(0, p2); PG8_LDA(At, 1, 1); PG8_STAGE_A2(PG8_SA(1, 0), a3, k2 + kstep); }
            PG8_BAR; PG8_WAIT_L(0); PG8_MMA(1, 0, At, B0); PG8_BAR; PG8_SCHED;
            PG8_STAGE(PG8_SB(1, 1), b3 + hstep, voffB);
            PG8_WAIT_V(6); PG8_BAR; PG8_MMA(1, 1, At, B1); PG8_BAR;
            }
        }
        if constexpr (ALIGN_EPI) { if (wr == 0) PG8_BAR; }
        if constexpr (!Epi::AFTER_DRAIN) { int tl_ = tid; asm volatile("" : "+v"(tl_)); const int ln_ = tl_ & 63;
            if constexpr (Epi::STAGED) E(acc, cur, wr, wc, ln_ & 15, ln_ >> 4, etab + par * 512); else E(acc, cur, wr, wc, ln_ & 15, ln_ >> 4);
#ifdef DBG_EPI2
            if constexpr (F8 && Sched::GATHER) { asm volatile("" : "+v"(tl_)); const int l2_ = tl_ & 63; E(acc, cur, wr, wc, l2_ & 15, l2_ >> 4, etab + par * 512); }
#endif
#ifdef DBG_EPI2Y
            if constexpr (F8 && !Sched::GATHER && !SP2) { asm volatile("" : "+v"(tl_)); const int l2_ = tl_ & 63; E(acc, cur, wr, wc, l2_ & 15, l2_ >> 4, etab + par * 512); }
#endif
            S.done(cur); }
        if (!has_next) break;
#pragma unroll
        for (int a = 0; a < 2; ++a)
#pragma unroll
            for (int b = 0; b < 2; ++b)
#pragma unroll
                for (int m = 0; m < 4; ++m)
#pragma unroll
                    for (int n = 0; n < 2; ++n) acc[a][b][m][n] = (f32x4){0.f, 0.f, 0.f, 0.f};
        cur = nxt; cA = nA; cB = nB; ++ui; par = npar;
        if constexpr (ALIGN_EPI) { if (wr == 1) PG8_BAR; }
    }
    PG8_WAIT_V(0);
    if constexpr (!ALIGN_EPI) { if (wr == 0) PG8_BAR; }
    PG8_BAR;
    if constexpr (Epi::AFTER_DRAIN) { E.fused(acc, cur, wr, wc, fr, fq, lds, wid, lane); S.done(cur); }
#undef PG8_SA
#undef PG8_SB
#undef PG8_STAGE
#undef PG8_GA
#undef PG8_GA_RD
#undef PG8_GA_IS
#undef PG8_STAGE_A2
#undef PG8_STAGE_A
#undef PG8_LDA
#undef PG8_LDB
#undef PG8_MMA
#undef PG8_WAIT_V
#undef PG8_WAIT_L
#undef PG8_BAR
#undef PG8_SCHED
}
}
namespace attn_body {
using bf16=__hip_bfloat16;
using bf16x8=__attribute__((ext_vector_type(8)))short;
using s16x4=__attribute__((ext_vector_type(4)))short;
using f32x16=__attribute__((ext_vector_type(16)))float;
using u32x4=__attribute__((ext_vector_type(4)))unsigned;
constexpr int BATCH=32,NHEAD=8,NGRP=4,SEQ=2048,D=64;
constexpr int PQ=512,PK=128,PV=128,PO=1024;
constexpr float ATTN_OSCALE=16.f;
constexpr int NW=8,QBLK=32,QB=QBLK*NW,KVBLK=64,NQB=SEQ/QB;
constexpr int ATTN_UNIT_ROWS=QB;
__device__ __forceinline__ int crow(int r,int hi){return (r&3)+8*(r>>2)+4*hi;}
#define SBAR() __builtin_amdgcn_sched_barrier(0)
__device__ __forceinline__ void cmask(f32x16&p0,f32x16&p1,int jb,int qrel,int hi){
  const float NEG=-INFINITY; int kb=64*jb+4*hi;
  #pragma unroll
  for(int r=0;r<16;++r){int kv=kb+(r&3)+8*(r>>2); if(kv>qrel)p0[r]=NEG; if(kv+32>qrel)p1[r]=NEG;}
}

constexpr int NSLOT=3, SLOTB=8192;
constexpr int LDS_K=0, LDS_V=NSLOT*SLOTB, LDS_WS=2*NSLOT*SLOTB, LDS_OST=LDS_WS+NW*64*4, LDS_BYTES=LDS_OST+NW*4096;
constexpr float C2=0.125f*1.4426950408889634f;
__device__ __forceinline__ void glds16(const void*gsrc,unsigned lds_dst){unsigned keep;
  asm volatile("s_mov_b32 %0, m0\n\ts_mov_b32 m0, %2\n\ts_nop 0\n\tglobal_load_lds_dwordx4 %1, off\n\ts_mov_b32 m0, %0":"=&s"(keep):"v"(gsrc),"s"(lds_dst):"memory");}
__device__ __forceinline__ float max3f(float a,float b,float c){float r;asm("v_max3_f32 %0, %1, %2, %3":"=v"(r):"v"(a),"v"(b),"v"(c));return r;}
__device__ __forceinline__ float max2f(float a,float b){float r;asm("v_max_f32_e32 %0, %1, %2":"=v"(r):"v"(a),"v"(b));return r;}
__device__ __forceinline__ float fadd_s(float a,float b){float r;asm("v_add_f32_e32 %0, %1, %2":"=v"(r):"v"(a),"v"(b));return r;}
__device__ __forceinline__ float fsub_s(float a,float b){float r;asm("v_sub_f32_e32 %0, %1, %2":"=v"(r):"v"(a),"v"(b));return r;}
typedef float f32x2_t __attribute__((ext_vector_type(2))); typedef __bf16 bf16x2_t __attribute__((ext_vector_type(2)));
__device__ __forceinline__ unsigned cvtpk_s(float lo,float hi){f32x2_t v={lo,hi};bf16x2_t b=__builtin_convertvector(v,bf16x2_t);return __builtin_bit_cast(unsigned,b);}
#define WAIT_BAR(N) asm volatile("s_waitcnt vmcnt(" #N ") lgkmcnt(0)\n\ts_barrier":::"memory")

__device__ __forceinline__ void qkt(f32x16&p0,f32x16&p1,const char*Kslot,const bf16x8*qr,const f32x16&negm,int r32,int hi){
  const char*kb=Kslot+hi*1024+r32*16;
  #pragma unroll
  for(int d0=0;d0<4;++d0){
    const bf16x8 b0=*reinterpret_cast<const bf16x8*>(kb+d0*2048);
    const bf16x8 b1=*reinterpret_cast<const bf16x8*>(kb+d0*2048+512);
    if(d0==0){p0=__builtin_amdgcn_mfma_f32_32x32x16_bf16(b0,qr[0],negm,0,0,0);p1=__builtin_amdgcn_mfma_f32_32x32x16_bf16(b1,qr[0],negm,0,0,0);}
    else{p0=__builtin_amdgcn_mfma_f32_32x32x16_bf16(b0,qr[d0],p0,0,0,0);p1=__builtin_amdgcn_mfma_f32_32x32x16_bf16(b1,qr[d0],p1,0,0,0);}}
}
typedef __attribute__((address_space(3))) const char* lds_cptr;
typedef short v4i16_t __attribute__((ext_vector_type(4)));
__device__ __forceinline__ void kload8(bf16x8*kf,lds_cptr kp){
  kf[0]=*(const __attribute__((address_space(3))) bf16x8*)(kp);      kf[1]=*(const __attribute__((address_space(3))) bf16x8*)(kp+512);
  kf[2]=*(const __attribute__((address_space(3))) bf16x8*)(kp+2048); kf[3]=*(const __attribute__((address_space(3))) bf16x8*)(kp+2560);
  kf[4]=*(const __attribute__((address_space(3))) bf16x8*)(kp+4096); kf[5]=*(const __attribute__((address_space(3))) bf16x8*)(kp+4608);
  kf[6]=*(const __attribute__((address_space(3))) bf16x8*)(kp+6144); kf[7]=*(const __attribute__((address_space(3))) bf16x8*)(kp+6656);
}
__device__ __forceinline__ void kload2(bf16x8*kf,lds_cptr kp,int j){ kf[2*j]=*(const __attribute__((address_space(3))) bf16x8*)(kp+j*2048); kf[2*j+1]=*(const __attribute__((address_space(3))) bf16x8*)(kp+j*2048+512); }
__device__ __forceinline__ s16x4 vtr(lds_cptr p){ return __builtin_bit_cast(s16x4,__builtin_amdgcn_ds_read_tr16_b64_v4i16((__attribute__((address_space(3))) v4i16_t*)p)); }
__device__ __forceinline__ float rowmax(const f32x16&p0,const f32x16&p1){
  float a=max3f(p0[0],p0[1],p1[0]),b=max3f(p0[2],p0[3],p1[1]);a=max3f(a,p1[2],p1[3]);
  #pragma unroll
  for(int r=4;r<16;r+=4){a=max3f(a,p0[r],p0[r+1]);b=max3f(b,p0[r+2],p0[r+3]);a=max3f(a,p1[r],p1[r+1]);b=max3f(b,p1[r+2],p1[r+3]);}
  const float m=max2f(a,b);
  auto rr=__builtin_amdgcn_permlane32_swap(__float_as_uint(m),__float_as_uint(m),false,false);
  return max2f(__uint_as_float(rr[0]),__uint_as_float(rr[1]));
}
__device__ __forceinline__ void pv(f32x16*o,int vb,bf16x8 pa0,bf16x8 pa1,bf16x8 pa2,bf16x8 pa3){
  #pragma unroll
  for(int d0=0;d0<2;++d0){s16x4 lo[4],hi[4];
    #pragma unroll
    for(int ks=0;ks<4;++ks){
      asm volatile("ds_read_b64_tr_b16 %0,%1 offset:%c2":"=&v"(lo[ks]):"v"(vb),"i"(d0*4096+ks*1024):"memory");
      asm volatile("ds_read_b64_tr_b16 %0,%1 offset:%c2":"=&v"(hi[ks]):"v"(vb),"i"(d0*4096+ks*1024+512):"memory");}
    asm volatile("s_waitcnt lgkmcnt(0)":::"memory");SBAR();
    #define PK(k) (bf16x8){lo[k][0],lo[k][1],lo[k][2],lo[k][3],hi[k][0],hi[k][1],hi[k][2],hi[k][3]}
    o[d0]=__builtin_amdgcn_mfma_f32_32x32x16_bf16(pa0,PK(0),o[d0],0,0,0);
    o[d0]=__builtin_amdgcn_mfma_f32_32x32x16_bf16(pa1,PK(1),o[d0],0,0,0);
    o[d0]=__builtin_amdgcn_mfma_f32_32x32x16_bf16(pa2,PK(2),o[d0],0,0,0);
    o[d0]=__builtin_amdgcn_mfma_f32_32x32x16_bf16(pa3,PK(3),o[d0],0,0,0);
    #undef PK
  }
}

#ifndef ATTN_STORE16
#define ATTN_STORE16(p,v) (*(u32x4*)(p)=(v))
#endif
template<int THRL,bool FIXED> __device__ __forceinline__ void attn_unit(int b,int h,int qb,const bf16*Q,const bf16*__restrict__ K,const bf16*__restrict__ V,bf16*O,char*shm,const int tid_in,const float mfix){
  int tid_=tid_in; asm volatile("":"+v"(tid_)); const int tid=tid_,lane=tid&63,r32=lane&31,hi=lane>>5; const int wid=__builtin_amdgcn_readfirstlane(tid>>6);
  const long rowbase=(long)b*SEQ; const int q0=qb*QB;
  const bf16*Qw=Q+(rowbase+q0+wid*QBLK)*PQ+h*D;
  const bf16*Kh=K+rowbase*PK+(h/NGRP)*D,*Vh=V+rowbase*PV+(h/NGRP)*D;
  const unsigned lds0=(unsigned)(uintptr_t)shm;
  float*wsf=(float*)(shm+LDS_WS)+wid*64;
  const bf16*ksrc=Kh+(long)lane*PK+wid*8;
  const bf16*vsrc=Vh+(long)(16*(wid&3)+(lane>>2))*PV+(wid>>2)*32+(lane&3)*8;
  const unsigned kdst=lds0+LDS_K+wid*1024, vdst=lds0+LDS_V+wid*1024;
  #define DMA_K(t,slot) glds16(ksrc+(long)(t)*KVBLK*PK,(unsigned)__builtin_amdgcn_readfirstlane(kdst+(slot)))
  #define DMA_V(t,slot) glds16(vsrc+(long)(t)*KVBLK*PV,(unsigned)__builtin_amdgcn_readfirstlane(vdst+(slot)))
  const int vb0=(int)(lds0+LDS_V)+((lane>>4)&1)*32+(lane&3)*8+(4*hi+((lane&15)>>2))*64;
  const char*Kbase=shm+LDS_K; bf16x8 kf[8];
  const lds_cptr shm3=(lds_cptr)shm; const lds_cptr kp0=shm3+LDS_K+hi*1024+r32*16; const lds_cptr vp0=shm3+LDS_V+((lane>>4)&1)*32+(lane&3)*8+(4*hi+((lane&15)>>2))*64;
  constexpr int NT=SEQ/KVBLK;
  DMA_K(0,0);DMA_V(0,0);DMA_K(1,SLOTB);
  bf16x8 qr[4];
  #pragma unroll
  for(int d0=0;d0<4;++d0)qr[d0]=*(const __attribute__((address_space(1))) bf16x8*)(&Qw[(long)r32*PQ+d0*16+hi*8]);
  float mhat=0.f,l_reg=0.f;f32x16 o[2];o[0]=f32x16{};o[1]=f32x16{};f32x16 negm=f32x16{}; if constexpr(!FIXED){ asm volatile("":"+v"(negm)); } (void)mfix;
  #define NEGMC (FIXED?f32x16{}:negm)
  #define CMASK(P0,P1,t) do{}while(0)
  bool resc=false;
  #define START(P0,P1) do{ if constexpr(!FIXED){ const float rm=rowmax(P0,P1); resc=false; \
    { const float dl=rm; mhat=fadd_s(mhat,dl); \
      _Pragma("unroll") for(int r=0;r<16;++r){P0[r]=fsub_s(P0[r],dl);P1[r]=fsub_s(P1[r],dl);} \
      _Pragma("unroll") for(int r=0;r<16;++r)negm[r]=-mhat; asm volatile("":"+v"(negm)); } } \
    _Pragma("unroll") for(int r=0;r<16;++r)P0[r]=__builtin_amdgcn_exp2f(P0[r]); }while(0)
  #define RESC() do{ if(resc){ asm volatile("s_waitcnt lgkmcnt(0)":::"memory"); \
      _Pragma("unroll") for(int d_=0;d_<2;++d_) _Pragma("unroll") for(int r=0;r<16;++r)o[d_][r]*=wsf[crow(r,hi)]; } }while(0)
  f32x16 pA0,pA1,pB0,pB1;
  int sl_prev=0,sl_cur=0,sl_next=SLOTB;
  #define ROT() do{sl_prev=sl_cur;sl_cur=sl_next;sl_next=(sl_next==(NSLOT-1)*SLOTB)?0:sl_next+SLOTB;}while(0)
  DMA_K(2,2*SLOTB);
  WAIT_BAR(3);
  qkt(pA0,pA1,Kbase,qr,NEGMC,r32,hi);asm volatile("s_nop 15\n\ts_nop 7":"+v"(pA0),"+v"(pA1));CMASK(pA0,pA1,0);
  START(pA0,pA1);
  _Pragma("unroll") for(int r=0;r<16;++r)pA1[r]=__builtin_amdgcn_exp2f(pA1[r]);
  WAIT_BAR(0);
  DMA_K(3,0);DMA_V(1,SLOTB);
  ROT();
  kload8(kf,kp0+sl_cur);
  WAIT_BAR(2);
  s16x4 vlo[8],vhi[8]; u32x4 pw0,pw1,pw2,pw3;
  #define PKW(P,B) cvtpk_s(P[B],P[B+1])
  #define PAF(k) __builtin_bit_cast(bf16x8,pw##k)
  #define VFR(i) (bf16x8){vlo[i][0],vlo[i][1],vlo[i][2],vlo[i][3],vhi[i][0],vhi[i][1],vhi[i][2],vhi[i][3]}
  #define PIN(x) asm volatile("":"+v"(x))
  #define MX3(a,b,c) __builtin_fmaxf(__builtin_fmaxf((a),(b)),(c))
  #define GAPA(MF,A0,A1,A2,A3,W0,W1,PW) do{ MF; sacc+=A0; sacc+=A1; sacc+=A2; sacc+=A3; PIN(sacc); W0; W1; PIN(PW); SBAR(); }while(0)
  #define OLM(k) do{}while(0)
  #define EX(v) __builtin_amdgcn_exp2f(v)
  #define GAPB(MF,X,B) do{ MF; X[B]=EX(X[B]); X[B+1]=EX(X[B+1]); X[B+2]=EX(X[B+2]); X[B+3]=EX(X[B+3]); PIN(X); SBAR(); }while(0)
  #define VRD(i) do{ vlo[i]=vtr(vp_+(((i)>>2)*4096+((i)&3)*1024)); vhi[i]=vtr(vp_+(((i)>>2)*4096+((i)&3)*1024+512)); }while(0)
  #define KRD(G,j) do{ if(G){ kload2(kf,kp0+sl_next,j); SBAR(); } }while(0)
  #define STEP(C0,C1,P0,P1,t,GK,GV,GL) do{ SBAR(); \
    const lds_cptr vp_=vp0+sl_prev; \
    VRD(0); SBAR(); float sacc=(P0[0]+P0[1]); \
    GAPA(C0=__builtin_amdgcn_mfma_f32_32x32x16_bf16(kf[0],qr[0],NEGMC,0,0,0), P0[2],P0[3],P0[4],P0[5],     pw0[0]=PKW(P0,0), pw0[1]=PKW(P0,2), pw0); \
    VRD(4); SBAR(); GAPA(C1=__builtin_amdgcn_mfma_f32_32x32x16_bf16(kf[1],qr[0],NEGMC,0,0,0), P0[6],P0[7],P0[8],P0[9],     pw0[2]=PKW(P0,4), pw0[3]=PKW(P0,6), pw0); \
    VRD(1); SBAR(); GAPA(C0=__builtin_amdgcn_mfma_f32_32x32x16_bf16(kf[2],qr[1],C0,0,0,0),   P0[10],P0[11],P0[12],P0[13], pw1[0]=PKW(P0,8), pw1[1]=PKW(P0,10), pw1); \
    VRD(5); SBAR(); GAPA(C1=__builtin_amdgcn_mfma_f32_32x32x16_bf16(kf[3],qr[1],C1,0,0,0),   P0[14],P0[15],P1[0],P1[1],   pw1[2]=PKW(P0,12),pw1[3]=PKW(P0,14), pw1); \
    VRD(2); SBAR(); GAPA(C0=__builtin_amdgcn_mfma_f32_32x32x16_bf16(kf[4],qr[2],C0,0,0,0),   P1[2],P1[3],P1[4],P1[5],     pw2[0]=PKW(P1,0), pw2[1]=PKW(P1,2), pw2); \
    VRD(6); SBAR(); GAPA(C1=__builtin_amdgcn_mfma_f32_32x32x16_bf16(kf[5],qr[2],C1,0,0,0),   P1[6],P1[7],P1[8],P1[9],     pw2[2]=PKW(P1,4), pw2[3]=PKW(P1,6), pw2); \
    VRD(3); SBAR(); GAPA(C0=__builtin_amdgcn_mfma_f32_32x32x16_bf16(kf[6],qr[3],C0,0,0,0),   P1[10],P1[11],P1[12],P1[13], pw3[0]=PKW(P1,8), pw3[1]=PKW(P1,10), pw3); \
    VRD(7); SBAR(); GAPA(C1=__builtin_amdgcn_mfma_f32_32x32x16_bf16(kf[7],qr[3],C1,0,0,0),   P1[14],P1[15],0.f,0.f,       pw3[2]=PKW(P1,12),pw3[3]=PKW(P1,14), pw3); \
    l_reg+=sacc; \
    if(GK){DMA_K((t)+3,sl_cur);} if(GV){DMA_V((t)+1,sl_next);} \
    CMASK(C0,C1,t); \
    if constexpr(!FIXED){ float a=MX3(C0[0],C0[1],C1[0]),b=MX3(C0[2],C0[3],C1[1]); a=MX3(a,C1[2],C1[3]); \
      _Pragma("unroll") for(int r=4;r<16;r+=4){a=MX3(a,C0[r],C0[r+1]);b=MX3(b,C0[r+2],C0[r+3]);a=MX3(a,C1[r],C1[r+1]);b=MX3(b,C1[r+2],C1[r+3]);} \
      float rm=__builtin_fmaxf(a,b); { auto rr=__builtin_amdgcn_permlane32_swap(__float_as_uint(rm),__float_as_uint(rm),false,false); rm=__builtin_fmaxf(__uint_as_float(rr[0]),__uint_as_float(rr[1])); } \
      resc=false; \
      if(__builtin_expect(__any(rm>(float)THRL),0)){ const float dl=__builtin_fmaxf(rm,0.f); mhat+=dl; \
        _Pragma("unroll") for(int r=0;r<16;++r){C0[r]-=dl;C1[r]-=dl;} \
        _Pragma("unroll") for(int r=0;r<16;++r)negm[r]=-mhat; asm volatile("":"+v"(negm)); \
        const float f=__builtin_amdgcn_exp2f(-dl); l_reg*=f; if(hi==0)wsf[r32]=f; resc=true; } } \
    SBAR(); \
    GAPB(o[0]=__builtin_amdgcn_mfma_f32_32x32x16_bf16(PAF(0),VFR(0),o[0],0,0,0), C0,0); \
    GAPB(o[1]=__builtin_amdgcn_mfma_f32_32x32x16_bf16(PAF(0),VFR(4),o[1],0,0,0), C0,4); OLM(0); \
    KRD(GL,0); GAPB(o[0]=__builtin_amdgcn_mfma_f32_32x32x16_bf16(PAF(1),VFR(1),o[0],0,0,0), C0,8); \
    KRD(GL,1); GAPB(o[1]=__builtin_amdgcn_mfma_f32_32x32x16_bf16(PAF(1),VFR(5),o[1],0,0,0), C0,12); OLM(1); \
    KRD(GL,2); GAPB(o[0]=__builtin_amdgcn_mfma_f32_32x32x16_bf16(PAF(2),VFR(2),o[0],0,0,0), C1,0); \
    KRD(GL,3); GAPB(o[1]=__builtin_amdgcn_mfma_f32_32x32x16_bf16(PAF(2),VFR(6),o[1],0,0,0), C1,4); OLM(2); \
    GAPB(o[0]=__builtin_amdgcn_mfma_f32_32x32x16_bf16(PAF(3),VFR(3),o[0],0,0,0), C1,8); \
    GAPB(o[1]=__builtin_amdgcn_mfma_f32_32x32x16_bf16(PAF(3),VFR(7),o[1],0,0,0), C1,12); OLM(3); \
    }while(0)
  int t=1;
  #undef CMASK
  #define CMASK(P0,P1,t) do{}while(0)
  for(;t+5<NT;t+=2){
    STEP(pB0,pB1,pA0,pA1,t,true,true,true);     WAIT_BAR(2); RESC(); ROT();
    STEP(pA0,pA1,pB0,pB1,t+1,true,true,true);   WAIT_BAR(2); RESC(); ROT();
  }
  #undef CMASK
  #define CMASK(P0,P1,t) do{}while(0)
  #define ENDW(tt) do{ if((tt)+3<NT){WAIT_BAR(2);} else if((tt)+2<NT){WAIT_BAR(1);} else {WAIT_BAR(0);} }while(0)
  for(;t+1<NT;t+=2){
    STEP(pB0,pB1,pA0,pA1,t,(t+3<NT),(t+1<NT),(t+1<NT));       ENDW(t);   RESC(); ROT();
    STEP(pA0,pA1,pB0,pB1,t+1,(t+4<NT),(t+2<NT),(t+2<NT));     ENDW(t+1); RESC(); ROT();
  }
  STEP(pB0,pB1,pA0,pA1,NT-1,false,false,false); RESC();
  { float sacc=pB0[0]+pB0[1]; _Pragma("unroll") for(int r=2;r<16;++r)sacc+=pB0[r]; _Pragma("unroll") for(int r=0;r<16;++r)sacc+=pB1[r]; l_reg+=sacc;
    pw0=(u32x4){PKW(pB0,0),PKW(pB0,2),PKW(pB0,4),PKW(pB0,6)};pw1=(u32x4){PKW(pB0,8),PKW(pB0,10),PKW(pB0,12),PKW(pB0,14)};pw2=(u32x4){PKW(pB1,0),PKW(pB1,2),PKW(pB1,4),PKW(pB1,6)};pw3=(u32x4){PKW(pB1,8),PKW(pB1,10),PKW(pB1,12),PKW(pB1,14)};
    SBAR(); pv(o,vb0+sl_cur,PAF(0),PAF(1),PAF(2),PAF(3)); OLM(0); OLM(1); OLM(2); OLM(3); }
  #undef PKW
  #undef PAF
  #undef VFR
  #undef PIN
  #undef MX3
  #undef GAPA
  #undef NEGMC
  #undef OLM
  #undef GAPB
  #undef EX
  #undef VRD
  #undef KRD
  #undef STEP
  #undef ENDW
  {auto rr=__builtin_amdgcn_permlane32_swap(__float_as_uint(l_reg),__float_as_uint(l_reg),false,false);l_reg=__uint_as_float(rr[0])+__uint_as_float(rr[1]);}
  if(hi==0)wsf[32+r32]=l_reg;asm volatile("s_waitcnt lgkmcnt(0)":::"memory");
  float rli[16];
  #pragma unroll
  for(int r=0;r<16;++r)rli[r]=__builtin_amdgcn_rcpf(wsf[32+crow(r,hi)]);
  unsigned char*Ow=(unsigned char*)O+(rowbase+q0+wid*QBLK)*PO+h*D;
  { unsigned char*stg=(unsigned char*)(shm+LDS_OST)+wid*2048;
    #pragma unroll
    for(int r=0;r<16;++r){const int orow=crow(r,hi);
      #pragma unroll
      for(int d0=0;d0<2;++d0){ float ov=o[d0][r]*rli[r]*ATTN_OSCALE; ov=__builtin_amdgcn_fmed3f(ov,-448.f,448.f); stg[orow*64+d0*32+r32]=(unsigned char)__builtin_amdgcn_cvt_pk_fp8_f32(ov,ov,0,false);}}
    asm volatile("s_waitcnt lgkmcnt(0)":::"memory");
    #pragma unroll
    for(int i=0;i<2;++i){const int row=i*16+(lane>>2),ch=lane&3; const u32x4 v=*(const u32x4*)(stg+row*64+ch*16); ATTN_STORE16(Ow+(long)row*PO+ch*16,v);} }
  asm volatile("s_waitcnt lgkmcnt(0)\n\ts_barrier":::"memory");
  #undef DMA_K
  #undef DMA_V
  #undef CMASK
  #undef START
  #undef RESC
  #undef ROT
}
constexpr int ATTN_LDS_BYTES=LDS_BYTES;
struct AttnTensors { const bf16* Q; const bf16* K; const bf16* V; bf16* O; };
struct AttnUnit { int bh; int qb; };
struct StaticOrder {
  int vcu,G;
  __device__ __forceinline__ explicit StaticOrder(int grid,int block):vcu((grid%8==0)?(block%8)*(grid/8)+block/8:block),G(grid){}
  __device__ __forceinline__ bool next(int i,AttnUnit&u)const{ const int L=i*G+vcu; if(L>=BATCH*NHEAD*(SEQ/QB))return false; const int pair=L/32,j=L%32; const int b=pair/2,kvh=pair%2; u.bh=b*NHEAD+kvh*NGRP+(j>>3); u.qb=j&7; return true; }
  __device__ __forceinline__ void a_ready(const AttnUnit&)const{}
  __device__ __forceinline__ void done(const AttnUnit&)const{}
};
template<class Sched,bool FIXED,int THRL=8> __device__ __forceinline__ void attn_phase(char*lds,const AttnTensors&T,const Sched&S,const int tid_in,const int i0,const int i1,const float mfix){
  AttnUnit u;
  for(int i=i0;i<i1&&S.next(i,u);++i){ S.a_ready(u); attn_unit<THRL,FIXED>(u.bh/NHEAD,u.bh%NHEAD,u.qb,T.Q,T.K,T.V,T.O,lds,tid_in,mfix); S.done(u); }
}
#undef SBAR
#undef WAIT_BAR
}
#define XB_TMO      128
#define XB_XCNT(j)  (256  + 64 * (j))
#define XB_XSUB(j)  (1280 + 64 * (j))
#define XB_XGEN(j)  (2304 + 64 * (j))
#define XB_TOP      3328
#define XB_TOPGEN   3392
#define XCD_BAR_WORDS 3456
#define XB_SPIN_CAP (1u << 18)
constexpr int NWAVES = 8;
#ifndef MK_PER_PHASE
#define MK_PER_PHASE 0
#endif
constexpr int DM = 1024, NB = 32, SEQ = 2048, NTOK = NB * SEQ, DEPTH = 2;
constexpr int INW = 1792, COL_K = 512, COL_V = 640, COL_CA = 768, COL_CG = 1280, CC = 512;
constexpr int NE = 32, TOPK = 4, NK = NTOK * TOPK;
constexpr int PMAX = NK + NE * 256, TMAX = PMAX / 256;
constexpr float EPS = 1e-6f;
constexpr int NPH = 21;

constexpr size_t MiB = 1u << 20;
constexpr size_t WS_CTL = 0, CTL_ZERO_BYTES = 1 * MiB;
constexpr size_t WS_MOD = 1 * MiB;
constexpr size_t WS_ROPE = 3 * MiB;
constexpr size_t WS_WIN = 4 * MiB;
constexpr size_t WS_WOUT = 11 * MiB;
constexpr size_t WS_TOPK = 15 * MiB;
constexpr size_t WS_SLOT = 17 * MiB;
constexpr size_t WS_PGATE = 18 * MiB;
constexpr size_t WS_PERM = 20 * MiB;
constexpr size_t WS_IDENT = 22 * MiB;
constexpr size_t WS_W1 = 24 * MiB;
constexpr size_t WS_W2 = 152 * MiB;
constexpr size_t WS_X = 216 * MiB;
constexpr size_t WS_H = 472 * MiB;
constexpr size_t WS_U = 600 * MiB;
constexpr size_t WS_UU = WS_U;
constexpr size_t WS_Q = WS_U + 64 * MiB;
constexpr size_t WS_KN = WS_U + 128 * MiB;
constexpr size_t WS_V = WS_U + 144 * MiB;
constexpr size_t WS_MIX = WS_U + 160 * MiB;
constexpr size_t WS_Y = WS_U;
constexpr size_t WS_ACT = 1128 * MiB;
constexpr size_t WS_END = 1392 * MiB;
static_assert(WS_MIX + (size_t)NTOK * 1024 * 2 <= WS_ACT && WS_Y + (size_t)PMAX * 1024 * 2 <= WS_ACT && WS_ACT + (size_t)PMAX * 1024 <= WS_END && WS_PERM + (size_t)PMAX * 4 <= WS_W1, "d_ws map");
constexpr int CW_BAR = 4096;
constexpr int CW_CNT = 131072;
constexpr int RING_OFF = 0, RING_BYTES = 131072;
constexpr int LDSX_OFF = RING_BYTES;
constexpr int LX_MISC = LDSX_OFF, LX_TAB = LDSX_OFF + 512, LX_TILE = LDSX_OFF + 2048, LX_STG = LDSX_OFF + 4096;
constexpr int LDS_BYTES = 147456;

#define GAS __attribute__((address_space(1)))
#define LAS __attribute__((address_space(3)))
typedef unsigned short bf16;
typedef unsigned v4u __attribute__((ext_vector_type(4)));
typedef unsigned v2u __attribute__((ext_vector_type(2)));
typedef float f32x4 __attribute__((ext_vector_type(4)));
typedef GAS unsigned gu32;
#define RLX_AGENT __ATOMIC_RELAXED, __HIP_MEMORY_SCOPE_AGENT
#define LDS_WAIT() asm volatile("s_waitcnt lgkmcnt(0)" ::: "memory")
#define VM_WAIT() asm volatile("s_waitcnt vmcnt(0)" ::: "memory")
__device__ __forceinline__ unsigned f2bf(float f) { unsigned u = __builtin_bit_cast(unsigned, f); return (u + 0x7fffu + ((u >> 16) & 1u)) >> 16; }
__device__ __forceinline__ unsigned pk2(float lo, float hi) { return f2bf(lo) | (f2bf(hi) << 16); }
__device__ __forceinline__ float bflo(unsigned w) { return __builtin_bit_cast(float, w << 16); }
__device__ __forceinline__ float bfhi(unsigned w) { return __builtin_bit_cast(float, w & 0xffff0000u); }
__device__ __forceinline__ float shx(float v, int mask, int lane) { return __builtin_bit_cast(float, __builtin_amdgcn_ds_bpermute((lane ^ mask) << 2, __builtin_bit_cast(int, v))); }
__device__ __forceinline__ int shxi(int v, int mask, int lane) { return __builtin_amdgcn_ds_bpermute((lane ^ mask) << 2, v); }
#define DPPF(old, src, ctrl, rmask) __builtin_bit_cast(float, __builtin_amdgcn_update_dpp(__builtin_bit_cast(int, (float)(old)), __builtin_bit_cast(int, (float)(src)), (ctrl), (rmask), 0xF, false))
__device__ __forceinline__ float wave_sum_s(float v) {
    v += DPPF(0.f, v, 0xB1, 0xF); v += DPPF(0.f, v, 0x4E, 0xF); v += DPPF(0.f, v, 0x141, 0xF); v += DPPF(0.f, v, 0x140, 0xF);
    v += DPPF(0.f, v, 0x142, 0xA); v += DPPF(0.f, v, 0x143, 0xC);
    return __builtin_bit_cast(float, __builtin_amdgcn_readlane(__builtin_bit_cast(int, v), 63));
}
__device__ __forceinline__ float wave_max_s(float v) {
    v = __builtin_fmaxf(v, DPPF(v, v, 0xB1, 0xF)); v = __builtin_fmaxf(v, DPPF(v, v, 0x4E, 0xF)); v = __builtin_fmaxf(v, DPPF(v, v, 0x141, 0xF)); v = __builtin_fmaxf(v, DPPF(v, v, 0x140, 0xF));
    v = __builtin_fmaxf(v, DPPF(v, v, 0x142, 0xA)); v = __builtin_fmaxf(v, DPPF(v, v, 0x143, 0xC));
    return __builtin_bit_cast(float, __builtin_amdgcn_readlane(__builtin_bit_cast(int, v), 63));
}
__device__ __forceinline__ float wave_sum(float v, int lane) { (void)lane; return wave_sum_s(v); }
__device__ __forceinline__ unsigned xb_ld(unsigned* p)              { return __hip_atomic_load(p, __ATOMIC_RELAXED, __HIP_MEMORY_SCOPE_AGENT); }
__device__ __forceinline__ unsigned xb_add(unsigned* p, unsigned v) { return __hip_atomic_fetch_add(p, v, __ATOMIC_RELAXED, __HIP_MEMORY_SCOPE_AGENT); }
__device__ __forceinline__ unsigned xb_xcc_id() { return (unsigned)__builtin_amdgcn_s_getreg((3 << 11) | 20) & 0xFu; }
#define XB_SPIN(cond, bar) do { unsigned _sp = 0; while (cond) { __builtin_amdgcn_s_sleep(1); \
    if ((++_sp & 255u) == 0u) { if (xb_ld(&(bar)[XB_TMO])) break; if (_sp > XB_SPIN_CAP) { atomicAdd(&(bar)[XB_TMO], 1u); break; } } } } while (0)

struct XcdBarrier {
    unsigned* bar; unsigned x;
    unsigned wave;
    volatile LAS unsigned* st;
};

__device__ __forceinline__ bool xb_thread0(unsigned wave) { unsigned z_ = 0u; asm volatile("" : "+v"(z_)); return wave == 0u && __builtin_amdgcn_mbcnt_hi(~0u, __builtin_amdgcn_mbcnt_lo(~0u, z_)) == 0u; }
__device__ __forceinline__ XcdBarrier xcd_barrier_post(unsigned* bar, volatile LAS unsigned* st, unsigned wave) {
    XcdBarrier b; b.bar = bar; b.x = xb_xcc_id(); b.st = st; b.wave = wave;
    if (xb_thread0(wave)) (void)xb_add(&bar[XB_XCNT(b.x)], 1u);
    return b;
}
__device__ __forceinline__ void xcd_barrier_complete(unsigned* bar, unsigned x, unsigned& nloc, unsigned& nx) {
    const unsigned G = gridDim.x * gridDim.y * gridDim.z;
    unsigned sum, cnt, mine, sp = 0u;
    for (;;) {
        sum = 0u; cnt = 0u; mine = 0u;
#pragma unroll
        for (unsigned j = 0; j < 16; ++j) { const unsigned c = xb_ld(&bar[XB_XCNT(j)]); sum += c; cnt += (c > 0u) ? 1u : 0u; mine = (j == x) ? c : mine; }
        if (sum == G) break;
        __builtin_amdgcn_s_sleep(1);
        if ((++sp & 255u) == 0u) { if (xb_ld(&bar[XB_TMO])) break; if (sp > XB_SPIN_CAP) { atomicAdd(&bar[XB_TMO], 1u); break; } }
    }
    nloc = mine > 0u ? mine : 1u; nx = cnt > 0u ? cnt : 1u;
}

__device__ __forceinline__ void xcd_barrier(const XcdBarrier& b) {
    asm volatile("s_waitcnt vmcnt(0)" ::: "memory");
    __syncthreads();
    if (xb_thread0(b.wave)) {
        unsigned* bar = b.bar;
        __builtin_amdgcn_s_waitcnt(0);
        unsigned nloc = b.st[0], nx = b.st[1];
        if (nloc == 0u) { xcd_barrier_complete(bar, b.x, nloc, nx); b.st[0] = nloc; b.st[1] = nx; }
        const unsigned old = xb_add(&bar[XB_XSUB(b.x)], 1u);
        const unsigned gen = old / nloc;
        if (old + 1u == (gen + 1u) * nloc) {
            __builtin_amdgcn_fence(__ATOMIC_RELEASE, "agent");
            asm volatile("s_waitcnt vmcnt(0)" ::: "memory");
            const unsigned og = xb_add(&bar[XB_TOP], 1u);
            const unsigned tg = og / nx;
            if (og + 1u == (tg + 1u) * nx) xb_add(&bar[XB_TOPGEN], 1u);
            else XB_SPIN(xb_ld(&bar[XB_TOPGEN]) == tg, bar);
            __builtin_amdgcn_fence(__ATOMIC_ACQUIRE, "agent");
            xb_add(&bar[XB_XGEN(b.x)], 1u);
            asm volatile("s_waitcnt vmcnt(0)" ::: "memory");
        } else {
            XB_SPIN(xb_ld(&bar[XB_XGEN(b.x)]) == gen, bar);
            __builtin_amdgcn_fence(__ATOMIC_ACQUIRE, "agent");
            asm volatile("s_waitcnt vmcnt(0)" ::: "memory");
        }
    }
    __syncthreads();
}
struct Ctx { LAS unsigned char* lds; unsigned char* ws; gu32* ctl; int tid, lane, wave, vcu, G; };

template <bool INPROJ = false> __device__ __forceinline__ void transpose_item(const float* W, int K, int N, bf16* WT, int kb, int n0, int drow0, LAS float* scr, int lane) {
    const int k0 = 64 * kb;
    float ld_[32];
#pragma unroll
    for (int i = 0; i < 32; ++i) ld_[i] = W[(size_t)(k0 + 2 * i + (lane >> 5)) * N + n0 + (lane & 31)];
#pragma unroll
    for (int i = 0; i < 32; ++i) scr[(2 * i + (lane >> 5)) * 33 + (lane & 31)] = ld_[i];
    LDS_WAIT(); asm volatile("" ::: "memory");
    const int c = lane & 7;
#pragma unroll
    for (int j = 0; j < 4; ++j) { const int n = (lane >> 3) + 8 * j; const LAS float* s = scr + (8 * c) * 33 + n;
        v4u o; o.x = pk2(s[0 * 33], s[1 * 33]); o.y = pk2(s[2 * 33], s[3 * 33]); o.z = pk2(s[4 * 33], s[5 * 33]); o.w = pk2(s[6 * 33], s[7 * 33]);
        *(GAS v4u*)(WT + (size_t)(INPROJ ? pg8::inproj_row(n0 + n) : drow0 + n) * K + k0 + 8 * c) = o; }
    LDS_WAIT(); asm volatile("" ::: "memory");
}

template <bool INPROJ = false> __device__ __forceinline__ void transpose_item_f8(const float* W, int K, int N, unsigned char* WT, int kb, int n0, int drow0, LAS float* scr, int lane, float scale) {
    const int k0 = 64 * kb;
    float ld_[32];
#pragma unroll
    for (int i = 0; i < 32; ++i) ld_[i] = W[(size_t)(k0 + 2 * i + (lane >> 5)) * N + n0 + (lane & 31)];
#pragma unroll
    for (int i = 0; i < 32; ++i) scr[(2 * i + (lane >> 5)) * 33 + (lane & 31)] = ld_[i];
    LDS_WAIT(); asm volatile("" ::: "memory");
    const int c = lane & 7;
#pragma unroll
    for (int j = 0; j < 4; ++j) { const int n = (lane >> 3) + 8 * j; const LAS float* s = scr + (8 * c) * 33 + n;
        v2u o; o.x = pg8::pk4_fp8(s[0 * 33] * scale, s[1 * 33] * scale, s[2 * 33] * scale, s[3 * 33] * scale); o.y = pg8::pk4_fp8(s[4 * 33] * scale, s[5 * 33] * scale, s[6 * 33] * scale, s[7 * 33] * scale);
        *(GAS v2u*)(WT + (size_t)(INPROJ ? pg8::inproj_row(n0 + n) : drow0 + n) * K + k0 + 8 * c) = o; }
    LDS_WAIT(); asm volatile("" ::: "memory");
}

constexpr int I_CV_W1 = 64 * 1024, I_CV_W2 = 64 * 512, I_CV_IN = 2 * 896, I_CV_OUT = 2 * 512, I_CV_W1L = 32 * 1024, I_CV_W2L = 32 * 512;
__device__ __forceinline__ void p_convert(const Ctx& F, const float* w_in, const float* w_out, const float* w1, const float* w2, const int mode, const int l, const int count, const int widx_in, const int nw, const int first = 0) {
    LAS float* scr = (LAS float*)(F.lds + RING_OFF + F.wave * 16384);
    const int lane = F.lane; const int widx = __builtin_amdgcn_readfirstlane(widx_in);
    constexpr int I_W1 = I_CV_W1, I_W2 = I_CV_W2, I_IN = I_CV_IN;
    struct Item { const float* W; unsigned char* WT; int N, k0, n0, drow0; bool inproj; };
    auto decode = [&](int v) -> Item { Item r; int q = mode == 0 ? I_W1 + I_W2 + v : (v < I_CV_W1L ? l * I_CV_W1L + v : I_W1 + l * I_CV_W2L + (v - I_CV_W1L));
        if (q < I_W1) { const int m = q >> 10, qq = q & 1023, n0 = (qq & 63) * 32, half = n0 >> 10, nn = n0 & 1023;
            r.W = w1 + (size_t)m * 1024 * 2048; r.WT = (unsigned char*)(F.ws + WS_W1) + (size_t)m * 2048 * 1024; r.N = 2048; r.k0 = 64 * (qq >> 6); r.n0 = n0; r.drow0 = (nn >> 7) * 256 + half * 128 + (nn & 127); r.inproj = false; return r; }
        q -= I_W1;
        if (q < I_W2) { const int m = q >> 9, qq = q & 511, n0 = (qq & 31) * 32;
            r.W = w2 + (size_t)m * 1024 * 1024; r.WT = (unsigned char*)(F.ws + WS_W2) + (size_t)m * 1024 * 1024; r.N = 1024; r.k0 = 64 * (qq >> 5); r.n0 = n0; r.drow0 = n0; r.inproj = false; return r; }
        q -= I_W2;
        if (q < I_IN) { const int m = q / 896, qq = q % 896, n0 = (qq % 56) * 32;
            r.W = w_in + (size_t)m * 1024 * INW; r.WT = (unsigned char*)(F.ws + WS_WIN) + (size_t)m * INW * 1024; r.N = INW; r.k0 = 64 * (qq / 56); r.n0 = n0; r.drow0 = n0; r.inproj = true; return r; }
        q -= I_IN;
        { const int m = q >> 9, qq = q & 511, n0 = (qq & 31) * 32;
            r.W = w_out + (size_t)m * 1024 * 1024; r.WT = (unsigned char*)(F.ws + WS_WOUT) + (size_t)m * 1024 * 1024; r.N = 1024; r.k0 = 64 * (qq >> 5); r.n0 = n0; r.drow0 = n0; r.inproj = false; return r; } };
    float lda[32], ldb[32];
#define P0_LOAD(LD, I) do { int ll_ = lane; asm volatile("" : "+v"(ll_));     \
        const GAS float* wp_ = (const GAS float*)((I).W + (size_t)((I).k0 + (ll_ >> 5)) * (I).N + (I).n0 + (ll_ & 31)); _Pragma("unroll") for (int i = 0; i < 32; ++i) LD[i] = wp_[(size_t)(2 * i) * (I).N]; } while (0)
#define P0_PROC(LD, ME) do { _Pragma("unroll") for (int i = 0; i < 32; ++i) scr[(2 * i + (lane >> 5)) * 33 + (lane & 31)] = LD[i] * pg8::F8_SW; } while (0)
#define P0_STORE(ME) do { LDS_WAIT(); asm volatile("" ::: "memory"); const int c = lane & 7; \
        _Pragma("unroll") for (int j = 0; j < 4; ++j) { const int n = (lane >> 3) + 8 * j; const LAS float* s = scr + (8 * c) * 33 + n; \
            v2u o; o.x = pg8::pk4_fp8(s[0 * 33], s[1 * 33], s[2 * 33], s[3 * 33]); o.y = pg8::pk4_fp8(s[4 * 33], s[5 * 33], s[6 * 33], s[7 * 33]); \
            *(GAS v2u*)((ME).WT + (size_t)((ME).inproj ? pg8::inproj_row((ME).n0 + n) : (ME).drow0 + n) * 1024 + (ME).k0 + 8 * c) = o; } \
        LDS_WAIT(); asm volatile("" ::: "memory"); } while (0)
    const int vend = first + count;
    if (first + widx < vend) { const Item t_ = decode(first + widx); P0_LOAD(lda, t_); } if (first + widx + nw < vend) { const Item t_ = decode(first + widx + nw); P0_LOAD(ldb, t_); }
#pragma unroll 1
    for (int it = first + widx; it < vend; it += 2 * nw) {
        { P0_PROC(lda, 0); if (it + 2 * nw < vend) { const Item t_ = decode(it + 2 * nw); P0_LOAD(lda, t_); } const Item me = decode(it); P0_STORE(me); }
        if (it + nw < vend) { P0_PROC(ldb, 0); if (it + 3 * nw < vend) { const Item t_ = decode(it + 3 * nw); P0_LOAD(ldb, t_); } const Item me = decode(it + nw); P0_STORE(me); }
    }
#undef P0_PROC
#undef P0_STORE
#undef P0_LOAD
}
__device__ __forceinline__ void p0_prologue(const Ctx& F, const float* c_in, const float* w_mod, const float* b_mod, const float* w_in, const float* w_out, const float* w1, const float* w2) {
    if (F.vcu < 192) {
        const int l = F.vcu / 96, n0 = (F.vcu % 96) * 64;
        LAS float* cact = (LAS float*)(F.lds + RING_OFF);
        for (int i = F.tid; i < NB * DM; i += NWAVES * 64) { const float v = c_in[i]; cact[i] = v / (1.0f + expf(-v)); }
        __syncthreads();
        float acc[NB];
#pragma unroll
        for (int b = 0; b < NB; ++b) acc[b] = 0.f;
        const float* wp = w_mod + (size_t)l * DM * 6144 + n0 + F.lane;
        const int k0 = F.wave * 128;
        float wn[32];
#pragma unroll
        for (int q = 0; q < 32; ++q) wn[q] = wp[(size_t)(k0 + q) * 6144];
#pragma unroll 1
        for (int kk = 0; kk < 4; ++kk) { const int k = k0 + 32 * kk; float w[32];
#pragma unroll
            for (int q = 0; q < 32; ++q) w[q] = wn[q];
            if (kk < 3) {
#pragma unroll
                for (int q = 0; q < 32; ++q) wn[q] = wp[(size_t)(k + 32 + q) * 6144]; }
#pragma unroll
            for (int b = 0; b < NB; ++b) { float a_ = acc[b];
#pragma unroll
                for (int q = 0; q < 32; q += 8) { const f32x4 c0 = *(const LAS f32x4*)(cact + b * DM + k + q), c1 = *(const LAS f32x4*)(cact + b * DM + k + q + 4);
                    a_ += (c0.x * w[q] + c0.y * w[q + 1] + c0.z * w[q + 2] + c0.w * w[q + 3]) + (c1.x * w[q + 4] + c1.y * w[q + 5] + c1.z * w[q + 6] + c1.w * w[q + 7]); }
                acc[b] = a_; } }
        __syncthreads();
        LAS float* red = (LAS float*)(F.lds + RING_OFF);
#pragma unroll
        for (int b = 0; b < NB; ++b) red[(F.wave * NB + b) * 64 + F.lane] = acc[b];
        __syncthreads();
        float* MOD = (float*)(F.ws + WS_MOD);
        for (int o = F.tid; o < NB * 64; o += NWAVES * 64) { const int b = o >> 6, col = o & 63; float s = b_mod[l * 6144 + n0 + col];
#pragma unroll
            for (int w = 0; w < NWAVES; ++w) s += red[(w * NB + b) * 64 + col];
            MOD[(size_t)(l * NB + b) * 6144 + n0 + col] = s; }
        __syncthreads();
    }
    { float* ROPE = (float*)(F.ws + WS_ROPE);
      for (int idx = F.vcu * NWAVES * 64 + F.tid; idx < SEQ * 32; idx += F.G * NWAVES * 64) { const int pos = idx >> 5, f = idx & 31, fi = f & 15;
          const float freq = powf(10000.0f, -(float)fi / 16.0f); const float p = (float)((f >> 4) ? (pos & 63) : (pos >> 6)); const float ang = p * freq;
          float s, c; sincosf(ang, &s, &c); ROPE[pos * 64 + f] = c; ROPE[pos * 64 + 32 + f] = s; } }
    p_convert(F, w_in, w_out, w1, w2, 0, 0, I_CV_IN + I_CV_OUT, F.vcu * NWAVES + F.wave, F.G * NWAVES);
}

__device__ __forceinline__ void norm_mod_row(const float* xrow, const float* g, const float* sc, const float* sh, bf16* orow, int lane) {
    const GAS f32x4* xr = (const GAS f32x4*)xrow + lane;
    f32x4 v[4]; float s = 0.f;
#pragma unroll
    for (int j = 0; j < 4; ++j) { v[j] = xr[64 * j]; s += (v[j].x * v[j].x + v[j].y * v[j].y) + (v[j].z * v[j].z + v[j].w * v[j].w); }
    const float rinv = 1.0f / sqrtf(wave_sum(s, lane) * (1.f / DM) + EPS);
    GAS unsigned long long* o8 = (GAS unsigned long long*)orow + lane;
#pragma unroll
    for (int j = 0; j < 4; ++j) { const f32x4 gg = ((const GAS f32x4*)g)[64 * j + lane], s1 = ((const GAS f32x4*)sc)[64 * j + lane], s0 = ((const GAS f32x4*)sh)[64 * j + lane];
        const f32x4 y = (v[j] * rinv) * gg * (s1 + 1.0f) + s0;
        o8[64 * j] = (unsigned long long)pk2(y.x, y.y) | ((unsigned long long)pk2(y.z, y.w) << 32); }
}

__device__ __forceinline__ void norm_mod_row2(const float* xa, const float* xb, const float* g, const float* sca, const float* sha, const float* scb, const float* shb, unsigned char* oa, unsigned char* ob, int lane) {
    const GAS f32x4* ra = (const GAS f32x4*)xa + lane; const GAS f32x4* rb = (const GAS f32x4*)xb + lane;
    f32x4 va[4], vb[4]; float sa = 0.f, sb = 0.f;
#pragma unroll
    for (int j = 0; j < 4; ++j) { va[j] = ra[64 * j]; vb[j] = rb[64 * j]; }
#pragma unroll
    for (int j = 0; j < 4; ++j) { sa += (va[j].x * va[j].x + va[j].y * va[j].y) + (va[j].z * va[j].z + va[j].w * va[j].w); sb += (vb[j].x * vb[j].x + vb[j].y * vb[j].y) + (vb[j].z * vb[j].z + vb[j].w * vb[j].w); }
    sa = wave_sum_s(sa); sb = wave_sum_s(sb);
    const float ia = 1.0f / sqrtf(sa * (1.f / DM) + EPS), ib = 1.0f / sqrtf(sb * (1.f / DM) + EPS);
    GAS unsigned* pa = (GAS unsigned*)oa + lane; GAS unsigned* pb = (GAS unsigned*)ob + lane;
#pragma unroll
    for (int j = 0; j < 4; ++j) { const f32x4 gg = ((const GAS f32x4*)g)[64 * j + lane];
        const f32x4 ya = (va[j] * ia) * gg * (((const GAS f32x4*)sca)[64 * j + lane] + 1.0f) + ((const GAS f32x4*)sha)[64 * j + lane];
        const f32x4 yb = (vb[j] * ib) * gg * (((const GAS f32x4*)scb)[64 * j + lane] + 1.0f) + ((const GAS f32x4*)shb)[64 * j + lane];
        pa[64 * j] = pg8::pk4_fp8(ya.x * pg8::F8_SA, ya.y * pg8::F8_SA, ya.z * pg8::F8_SA, ya.w * pg8::F8_SA);
        pb[64 * j] = pg8::pk4_fp8(yb.x * pg8::F8_SA, yb.y * pg8::F8_SA, yb.z * pg8::F8_SA, yb.w * pg8::F8_SA); }
}

__device__ __forceinline__ void p_conv(const Ctx& F, const float* w_dw, const float* b_dw, const float* g_cn, const float* b_cn) {
    const bf16* U = (const bf16*)(F.ws + WS_UU);
    const int c = F.tid; float w[31];
#pragma unroll
    for (int j = 0; j < 31; ++j) w[j] = w_dw[j * CC + c];
    const float bias = b_dw[c];
    LAS float* tile = (LAS float*)(F.lds + RING_OFF);
    unsigned char* MIX = (unsigned char*)(F.ws + WS_MIX);
    const f32x4 g0 = ((const GAS f32x4*)g_cn)[F.lane * 2], g1 = ((const GAS f32x4*)g_cn)[F.lane * 2 + 1], b0 = ((const GAS f32x4*)b_cn)[F.lane * 2], b1 = ((const GAS f32x4*)b_cn)[F.lane * 2 + 1];
    unsigned raw[62];
#define CONV_LOAD(CH) do { const int b_ = (CH) >> 6, s0_ = ((CH) & 63) * 32; _Pragma("unroll") for (int i = 0; i < 62; ++i) { const int s = s0_ - 15 + i; unsigned u = 0u; \
        if (s >= 0 && s < SEQ) u = (unsigned)((const GAS bf16*)U)[(size_t)(b_ * SEQ + s) * CC + c]; raw[i] = u; } } while (0)
    if (F.vcu < NTOK / 32) CONV_LOAD(F.vcu);
    for (int chunk = F.vcu; chunk < NTOK / 32; chunk += F.G) {
        const int b = chunk >> 6, s0 = (chunk & 63) * 32;
        { float win[62];
#pragma unroll
          for (int i = 0; i < 62; ++i) win[i] = __builtin_bit_cast(float, raw[i] << 16);
#pragma unroll
          for (int r = 0; r < 32; ++r) { float a = bias;
#pragma unroll
              for (int j = 0; j < 31; ++j) a += win[r + j] * w[j];
              tile[r * CC + c] = a; } }
        if (chunk + F.G < NTOK / 32) CONV_LOAD(chunk + F.G);
        LDS_WAIT(); __builtin_amdgcn_s_barrier(); asm volatile("" ::: "memory");
        { f32x4 a0[4], a1[4]; float s1[4], s2[4];
#pragma unroll
          for (int rr = 0; rr < 4; ++rr) { const LAS f32x4* tp = (const LAS f32x4*)(tile + (F.wave * 4 + rr) * CC + F.lane * 8); a0[rr] = tp[0]; a1[rr] = tp[1];
              s1[rr] = (a0[rr].x + a0[rr].y) + (a0[rr].z + a0[rr].w) + (a1[rr].x + a1[rr].y) + (a1[rr].z + a1[rr].w); }
#pragma unroll
          for (int rr = 0; rr < 4; ++rr) s1[rr] = wave_sum_s(s1[rr]);
#pragma unroll
          for (int rr = 0; rr < 4; ++rr) { const float mu = s1[rr] * (1.f / CC); a0[rr] = a0[rr] - mu; a1[rr] = a1[rr] - mu;
              s2[rr] = (a0[rr].x * a0[rr].x + a0[rr].y * a0[rr].y) + (a0[rr].z * a0[rr].z + a0[rr].w * a0[rr].w) + (a1[rr].x * a1[rr].x + a1[rr].y * a1[rr].y) + (a1[rr].z * a1[rr].z + a1[rr].w * a1[rr].w); }
#pragma unroll
          for (int rr = 0; rr < 4; ++rr) s2[rr] = wave_sum_s(s2[rr]);
#pragma unroll
          for (int rr = 0; rr < 4; ++rr) { const float rstd = 1.0f / sqrtf(s2[rr] * (1.f / CC) + EPS);
              f32x4 y0 = a0[rr] * rstd * g0 + b0, y1 = a1[rr] * rstd * g1 + b1;
#pragma unroll
              for (int q = 0; q < 4; ++q) { y0[q] = y0[q] / (1.0f + __expf(-y0[q])); y1[q] = y1[q] / (1.0f + __expf(-y1[q])); }
              v2u o; o.x = pg8::pk4_fp8(y0.x * pg8::F8_SMIX, y0.y * pg8::F8_SMIX, y0.z * pg8::F8_SMIX, y0.w * pg8::F8_SMIX); o.y = pg8::pk4_fp8(y1.x * pg8::F8_SMIX, y1.y * pg8::F8_SMIX, y1.z * pg8::F8_SMIX, y1.w * pg8::F8_SMIX);
              *(GAS v2u*)(MIX + (size_t)(b * SEQ + s0 + F.wave * 4 + rr) * 1024 + 512 + F.lane * 8) = o; } }
        LDS_WAIT(); __builtin_amdgcn_s_barrier(); asm volatile("" ::: "memory");
    }
    __syncthreads();
#undef CONV_LOAD
}

typedef short rt_bf16x8 __attribute__((ext_vector_type(8)));
__device__ __forceinline__ unsigned short bf_hi(float f) { return (unsigned short)f2bf(f); }
__device__ __forceinline__ void p_norm2_router(const Ctx& F, const float* g_ffn, const float* w_router, const float* b_router, const float* mod_l, gu32* gcnt) {
    constexpr int APITCH = 2064;
    LAS unsigned char* Ahi = F.lds + RING_OFF; LAS unsigned char* Alo = Ahi + 16 * APITCH; LAS float* PART = (LAS float*)(Alo + 16 * APITCH);
    LAS int* cntL = (LAS int*)(F.lds + LX_TAB); LAS int* baseL = cntL + 32;
    LAS v2u* stg = (LAS v2u*)(F.lds + LX_STG);
    const int lane = F.lane, c16 = lane & 15, kg = lane >> 4, el = lane & 31, half = lane >> 5;
    rt_bf16x8 Bhi[4][2], Blo[4][2];
#pragma unroll
    for (int s = 0; s < 4; ++s)
#pragma unroll
        for (int nt = 0; nt < 2; ++nt) { const float* wp = w_router + (size_t)(128 * F.wave + 32 * s + 8 * kg) * NE + 16 * nt + c16;
#pragma unroll
            for (int q = 0; q < 8; ++q) { const float wv = wp[q * NE]; const unsigned short h = bf_hi(wv); const unsigned short l = bf_hi(wv - __builtin_bit_cast(float, (unsigned)h << 16)); Bhi[s][nt][q] = (short)h; Blo[s][nt][q] = (short)l; } }
    const float brl = b_router[el];
    if (F.tid < 32) cntL[F.tid] = 0;
    __syncthreads();
    const bf16* X = (const bf16*)(F.ws + WS_X); unsigned char* H = (unsigned char*)(F.ws + WS_H);
    const int rbase = F.vcu * (NTOK / F.G);
    const float* sc = mod_l + (size_t)(rbase >> 11) * 6144 + 4 * 1024; const float* sh = mod_l + (size_t)(rbase >> 11) * 6144 + 3 * 1024;
    const int rl0 = 2 * F.wave; constexpr int NTILE = 16;
    f32x4 gs1[4], s0v[4];
#pragma unroll
    for (int j = 0; j < 4; ++j) { gs1[j] = ((const GAS f32x4*)g_ffn)[64 * j + lane] * (((const GAS f32x4*)sc)[64 * j + lane] + 1.0f); s0v[j] = ((const GAS f32x4*)sh)[64 * j + lane]; }
    v2u nxa[4], nxb[4];
    { const GAS v2u* xa = (const GAS v2u*)(X + (size_t)(rbase + rl0) * DM) + lane; const GAS v2u* xb = xa + DM / 4;
#pragma unroll
      for (int j = 0; j < 4; ++j) { nxa[j] = xa[64 * j]; nxb[j] = xb[64 * j]; } }
    for (int t = 0; t < (NTOK / F.G) / NTILE; ++t) {
        const int tok0 = rbase + 16 * t + rl0;
        f32x4 hA[4], hB[4]; float sA = 0.f, sB = 0.f;
#pragma unroll
        for (int j = 0; j < 4; ++j) { const v2u wa = nxa[j], wb = nxb[j];
            hA[j] = (f32x4){bflo(wa.x), bfhi(wa.x), bflo(wa.y), bfhi(wa.y)}; hB[j] = (f32x4){bflo(wb.x), bfhi(wb.x), bflo(wb.y), bfhi(wb.y)}; }
        if (t + 1 < (NTOK / F.G) / NTILE) { const GAS v2u* xa = (const GAS v2u*)(X + (size_t)(tok0 + 16) * DM) + lane; const GAS v2u* xb = xa + DM / 4;
#pragma unroll
            for (int j = 0; j < 4; ++j) { nxa[j] = xa[64 * j]; nxb[j] = xb[64 * j]; } }
#pragma unroll
        for (int j = 0; j < 4; ++j) { sA += (hA[j].x * hA[j].x + hA[j].y * hA[j].y) + (hA[j].z * hA[j].z + hA[j].w * hA[j].w); sB += (hB[j].x * hB[j].x + hB[j].y * hB[j].y) + (hB[j].z * hB[j].z + hB[j].w * hB[j].w); }
        const float rA = 1.0f / sqrtf(wave_sum_s(sA) * (1.f / DM) + EPS), rB = 1.0f / sqrtf(wave_sum_s(sB) * (1.f / DM) + EPS);
        GAS unsigned* oa = (GAS unsigned*)(H + (size_t)tok0 * DM) + lane; GAS unsigned* ob = oa + DM / 4;
#pragma unroll
        for (int j = 0; j < 4; ++j) {
            hA[j] = (hA[j] * rA) * gs1[j] + s0v[j]; hB[j] = (hB[j] * rB) * gs1[j] + s0v[j];
            oa[64 * j] = pg8::pk4_fp8(hA[j].x * pg8::F8_SA, hA[j].y * pg8::F8_SA, hA[j].z * pg8::F8_SA, hA[j].w * pg8::F8_SA);
            ob[64 * j] = pg8::pk4_fp8(hB[j].x * pg8::F8_SA, hB[j].y * pg8::F8_SA, hB[j].z * pg8::F8_SA, hB[j].w * pg8::F8_SA);
            v2u ha, la, hb, lb;
#define SPLIT2(v0, v1, HO, LO) do { const unsigned short h0_ = bf_hi(v0), h1_ = bf_hi(v1); HO = (unsigned)h0_ | ((unsigned)h1_ << 16); \
            LO = (unsigned)bf_hi((v0) - __builtin_bit_cast(float, (unsigned)h0_ << 16)) | ((unsigned)bf_hi((v1) - __builtin_bit_cast(float, (unsigned)h1_ << 16)) << 16); } while (0)
            SPLIT2(hA[j].x, hA[j].y, ha.x, la.x); SPLIT2(hA[j].z, hA[j].w, ha.y, la.y); SPLIT2(hB[j].x, hB[j].y, hb.x, lb.x); SPLIT2(hB[j].z, hB[j].w, hb.y, lb.y);
#undef SPLIT2
            const int cb = (4 * lane + 256 * j) * 2;
            *(LAS v2u*)(Ahi + rl0 * APITCH + cb) = ha; *(LAS v2u*)(Alo + rl0 * APITCH + cb) = la; *(LAS v2u*)(Ahi + (rl0 + 1) * APITCH + cb) = hb; *(LAS v2u*)(Alo + (rl0 + 1) * APITCH + cb) = lb; }
        LDS_WAIT(); __builtin_amdgcn_s_barrier(); asm volatile("" ::: "memory");
        f32x4 acc[2] = {(f32x4){0.f, 0.f, 0.f, 0.f}, (f32x4){0.f, 0.f, 0.f, 0.f}};
#pragma unroll
        for (int s = 0; s < 4; ++s) { const int kb = (128 * F.wave + 32 * s + 8 * kg) * 2;
            const rt_bf16x8 ah = *(const LAS rt_bf16x8*)(Ahi + c16 * APITCH + kb), al = *(const LAS rt_bf16x8*)(Alo + c16 * APITCH + kb);
#pragma unroll
            for (int nt = 0; nt < 2; ++nt) { acc[nt] = __builtin_amdgcn_mfma_f32_16x16x32_bf16(Bhi[s][nt], ah, acc[nt], 0, 0, 0); acc[nt] = __builtin_amdgcn_mfma_f32_16x16x32_bf16(Blo[s][nt], ah, acc[nt], 0, 0, 0);
                acc[nt] = __builtin_amdgcn_mfma_f32_16x16x32_bf16(Bhi[s][nt], al, acc[nt], 0, 0, 0); } }
#pragma unroll
        for (int nt = 0; nt < 2; ++nt) *(LAS f32x4*)(PART + (F.wave * 16 + c16) * 32 + 16 * nt + 4 * kg) = acc[nt];
        LDS_WAIT(); __builtin_amdgcn_s_barrier(); asm volatile("" ::: "memory");
        float v = brl;
#pragma unroll
        for (int w = 0; w < NWAVES; ++w) v += PART[(w * 16 + rl0 + half) * 32 + el];
        float val[4]; int idx[4];
#pragma unroll
        for (int k = 0; k < 4; ++k) {
            float m = v; m = __builtin_fmaxf(m, DPPF(m, m, 0xB1, 0xF)); m = __builtin_fmaxf(m, DPPF(m, m, 0x4E, 0xF)); m = __builtin_fmaxf(m, DPPF(m, m, 0x141, 0xF)); m = __builtin_fmaxf(m, DPPF(m, m, 0x140, 0xF));
            m = __builtin_fmaxf(m, DPPF(m, m, 0x142, 0xA));
            const float mA = __builtin_bit_cast(float, __builtin_amdgcn_readlane(__builtin_bit_cast(int, m), 31)), mB = __builtin_bit_cast(float, __builtin_amdgcn_readlane(__builtin_bit_cast(int, m), 63));
            const float mm = half ? mB : mA;
            const unsigned long long bm = __builtin_amdgcn_ballot_w64(v == mm);
            const int sA_ = __builtin_ctz((unsigned)bm), sB_ = __builtin_ctz((unsigned)(bm >> 32));
            const int sel = half ? sB_ : sA_;
            val[k] = mm; idx[k] = sel; if (el == sel) v = -INFINITY; }
        float g[4]; float sm = 0.f;
#pragma unroll
        for (int k = 0; k < 4; ++k) { g[k] = expf(val[k] - val[0]); sm += g[k]; }
        if (el < 4) { const int k = el; const int e = k == 0 ? idx[0] : k == 1 ? idx[1] : k == 2 ? idx[2] : idx[3]; const float gt = (k == 0 ? g[0] : k == 1 ? g[1] : k == 2 ? g[2] : g[3]) / sm;
            const int pos = __hip_atomic_fetch_add(cntL + e, 1, __ATOMIC_RELAXED, __HIP_MEMORY_SCOPE_WORKGROUP);
            const int lr = 16 * t + rl0 + half;
            v2u ent; ent.x = (unsigned)e | ((unsigned)pos << 8); ent.y = __builtin_bit_cast(unsigned, gt); stg[lr * 4 + k] = ent; }
    }
    __syncthreads();
    if (F.tid < 32) baseL[F.tid] = (int)__hip_atomic_fetch_add(gcnt + F.tid, (unsigned)cntL[F.tid], RLX_AGENT);
    __syncthreads();
    v2u* TOPKB = (v2u*)(F.ws + WS_TOPK);
    for (int i = F.tid; i < (NTOK / F.G) * 4; i += NWAVES * 64) { v2u ent = stg[i]; const int tok = rbase + (i >> 2);
        const unsigned e = ent.x & 255u, pos = (ent.x >> 8) + (unsigned)baseL[e]; ent.x = e | (pos << 8); TOPKB[(size_t)tok * 4 + (i & 3)] = ent; }
    __syncthreads();
}

__device__ __forceinline__ void p_perm(const Ctx& F, gu32* gcnt) {
    LAS int* pst = (LAS int*)(F.lds + LX_TAB + 256); LAS int* pcn = pst + 32;
    if (F.tid < NE) pcn[F.tid] = (int)__hip_atomic_load(gcnt + F.tid, RLX_AGENT);
    __syncthreads();
    if (F.tid == 0) { int acc = 0; for (int e = 0; e < NE; ++e) { pst[e] = acc; acc += (pcn[e] + 255) & ~255; } }
    __syncthreads();
    const v2u* TOPKB = (const v2u*)(F.ws + WS_TOPK); int* SLOT = (int*)(F.ws + WS_SLOT); float* PGATE = (float*)(F.ws + WS_PGATE); int* PERM = (int*)(F.ws + WS_PERM);
    const int gt = (F.vcu * NWAVES + F.wave) * 64 + F.lane, NGT = F.G * NWAVES * 64;
    for (int i = gt; i < NTOK * 4; i += NGT) { const v2u ent = ((const GAS v2u*)TOPKB)[i]; const unsigned ex = ent.x, gbits = ent.y; const int dest = pst[ex & 255u] + (int)(ex >> 8);
        ((GAS int*)SLOT)[i] = dest; ((GAS float*)PGATE)[dest] = __builtin_bit_cast(float, gbits); ((GAS int*)PERM)[dest] = i >> 2; }
    if (F.vcu < NE) { const int e = F.vcu, c = pcn[e], pe = (c + 255) & ~255; for (int r = c + F.tid; r < pe; r += NWAVES * 64) { PERM[pst[e] + r] = 0; PGATE[pst[e] + r] = 0.f; } }
}

__device__ __forceinline__ int build_tile_table(const Ctx& F, gu32* gcnt) {
    LAS int* tst = (LAS int*)(F.lds + LX_TAB + 512); LAS unsigned char* te = (LAS unsigned char*)(F.lds + LX_TILE);
    LAS int* tcn = tst + 40;
    if (F.tid < NE) tcn[F.tid] = (int)__hip_atomic_load(gcnt + F.tid, RLX_AGENT);
    __syncthreads();
    if (F.tid == 0) { int acc = 0; for (int e = 0; e < NE; ++e) { tst[e] = acc; acc += (tcn[e] + 255) >> 8; } tst[NE] = acc; }
    __syncthreads();
    if (F.tid < NE) { const int t0 = tst[F.tid], t1 = tst[F.tid + 1]; for (int t = t0; t < t1; ++t) te[t] = (unsigned char)F.tid; }
    __syncthreads();
    return __builtin_amdgcn_readfirstlane(tst[NE]);
}

template <bool LAST> __device__ __forceinline__ void cb_token(const v2u (&yv)[2][4], const v4u (&xw)[2], const f32x4 (&gy)[4], const f32x4 (&gn)[4], const f32x4 (&s0v)[4], bf16* X, unsigned char* H, float* out, int tok, int lane, bool poison) {
    f32x4 x[4]; float ss = 0.f;
#pragma unroll
    for (int j = 0; j < 2; ++j) {
        const v2u y0 = yv[j][0], y1 = yv[j][1], y2 = yv[j][2], y3 = yv[j][3]; const v4u xx = xw[j];
        const f32x4 xa = (f32x4){bflo(xx.x), bfhi(xx.x), bflo(xx.y), bfhi(xx.y)}, xb = (f32x4){bflo(xx.z), bfhi(xx.z), bflo(xx.w), bfhi(xx.w)};
        f32x4 sa, sb;
#define F8X(w, k) __builtin_amdgcn_cvt_f32_fp8((int)(w), (k))
        sa.x = ((F8X(y0.x, 0) + F8X(y1.x, 0)) + F8X(y2.x, 0)) + F8X(y3.x, 0); sa.y = ((F8X(y0.x, 1) + F8X(y1.x, 1)) + F8X(y2.x, 1)) + F8X(y3.x, 1);
        sa.z = ((F8X(y0.x, 2) + F8X(y1.x, 2)) + F8X(y2.x, 2)) + F8X(y3.x, 2); sa.w = ((F8X(y0.x, 3) + F8X(y1.x, 3)) + F8X(y2.x, 3)) + F8X(y3.x, 3);
        sb.x = ((F8X(y0.y, 0) + F8X(y1.y, 0)) + F8X(y2.y, 0)) + F8X(y3.y, 0); sb.y = ((F8X(y0.y, 1) + F8X(y1.y, 1)) + F8X(y2.y, 1)) + F8X(y3.y, 1);
        sb.z = ((F8X(y0.y, 2) + F8X(y1.y, 2)) + F8X(y2.y, 2)) + F8X(y3.y, 2); sb.w = ((F8X(y0.y, 3) + F8X(y1.y, 3)) + F8X(y2.y, 3)) + F8X(y3.y, 3);
#undef F8X
        x[2 * j] = xa + gy[2 * j] * sa; x[2 * j + 1] = xb + gy[2 * j + 1] * sb;
        ss += (x[2 * j].x * x[2 * j].x + x[2 * j].y * x[2 * j].y) + (x[2 * j].z * x[2 * j].z + x[2 * j].w * x[2 * j].w) + (x[2 * j + 1].x * x[2 * j + 1].x + x[2 * j + 1].y * x[2 * j + 1].y) + (x[2 * j + 1].z * x[2 * j + 1].z + x[2 * j + 1].w * x[2 * j + 1].w); }
    const float rinv = 1.0f / sqrtf(wave_sum(ss, lane) * (1.f / DM) + EPS);
#pragma unroll
    for (int j = 0; j < 2; ++j) { const int col = 512 * j + 8 * lane;
        if (LAST) { f32x4 o0 = (x[2 * j] * rinv) * gn[2 * j], o1 = (x[2 * j + 1] * rinv) * gn[2 * j + 1];
            if (poison) { const float qn = __builtin_nanf(""); o0 = (f32x4){qn, qn, qn, qn}; o1 = o0; }
            *(GAS f32x4*)(out + (size_t)tok * DM + col) = o0; *(GAS f32x4*)(out + (size_t)tok * DM + col + 4) = o1; }
        else { { v4u xo; xo.x = pk2(x[2 * j].x, x[2 * j].y); xo.y = pk2(x[2 * j].z, x[2 * j].w); xo.z = pk2(x[2 * j + 1].x, x[2 * j + 1].y); xo.w = pk2(x[2 * j + 1].z, x[2 * j + 1].w); *(GAS v4u*)(X + (size_t)tok * DM + col) = xo; }
            const f32x4 ya = (x[2 * j] * rinv) * gn[2 * j] + s0v[2 * j], yb = (x[2 * j + 1] * rinv) * gn[2 * j + 1] + s0v[2 * j + 1];
            v2u o; o.x = pg8::pk4_fp8(ya.x * pg8::F8_SA, ya.y * pg8::F8_SA, ya.z * pg8::F8_SA, ya.w * pg8::F8_SA); o.y = pg8::pk4_fp8(yb.x * pg8::F8_SA, yb.y * pg8::F8_SA, yb.z * pg8::F8_SA, yb.w * pg8::F8_SA);
            *(GAS v2u*)(H + (size_t)tok * DM + col) = o; } }
}
template <bool LAST> __device__ __forceinline__ void p_combine(const Ctx& F, const float* mod_l, const float* g_next, const float* mod_next, float* out, bool poison) {
    bf16* X = (bf16*)(F.ws + WS_X); const unsigned char* Y = (const unsigned char*)(F.ws + WS_Y);   const int* SLOT = (const int*)(F.ws + WS_SLOT); unsigned char* H = (unsigned char*)(F.ws + WS_H);
    constexpr int TPW = NTOK / (256 * NWAVES);
    const int lane = F.lane; const int t0 = (F.vcu * NWAVES + F.wave) * TPW; const int b = t0 >> 11;
    f32x4 gy[4], gn[4], s0v[4];
#pragma unroll
    for (int j = 0; j < 2; ++j) { const int col = 512 * j + 8 * lane; const float* gt2 = mod_l + (size_t)b * 6144 + 5 * 1024;
        gy[2 * j] = *(const GAS f32x4*)(gt2 + col) * (1.0f / pg8::F8_SY); gy[2 * j + 1] = *(const GAS f32x4*)(gt2 + col + 4) * (1.0f / pg8::F8_SY);
        gn[2 * j] = *(const GAS f32x4*)(g_next + col); gn[2 * j + 1] = *(const GAS f32x4*)(g_next + col + 4);
        if (!LAST) { const float* sh = mod_next + (size_t)b * 6144; const float* sc = sh + 1024;
            gn[2 * j] = gn[2 * j] * (*(const GAS f32x4*)(sc + col) + 1.0f); gn[2 * j + 1] = gn[2 * j + 1] * (*(const GAS f32x4*)(sc + col + 4) + 1.0f);
            s0v[2 * j] = *(const GAS f32x4*)(sh + col); s0v[2 * j + 1] = *(const GAS f32x4*)(sh + col + 4); }
        else { s0v[2 * j] = (f32x4){0.f, 0.f, 0.f, 0.f}; s0v[2 * j + 1] = s0v[2 * j]; } }
    const v4u my = *(const GAS v4u*)(SLOT + (size_t)(t0 + (lane & (TPW - 1))) * 4);
    const int m0 = (int)my.x, m1 = (int)my.y, m2 = (int)my.z, m3 = (int)my.w;
    v2u yA[2][2][4], yB[2][2][4]; v4u xA[2][2], xB[2][2];
#define CB_ISSUE(YV, XW, I) do { _Pragma("unroll") for (int q_ = 0; q_ < 2; ++q_) { const int ti_ = (I) + q_; \
        const unsigned char* r0_ = Y + (size_t)(unsigned)__builtin_amdgcn_readlane(m0, ti_) * DM; const unsigned char* r1_ = Y + (size_t)(unsigned)__builtin_amdgcn_readlane(m1, ti_) * DM; \
        const unsigned char* r2_ = Y + (size_t)(unsigned)__builtin_amdgcn_readlane(m2, ti_) * DM; const unsigned char* r3_ = Y + (size_t)(unsigned)__builtin_amdgcn_readlane(m3, ti_) * DM; \
        _Pragma("unroll") for (int j_ = 0; j_ < 2; ++j_) { const int col_ = 512 * j_ + 8 * lane; \
            YV[q_][j_][0] = *(const GAS v2u*)(r0_ + col_); YV[q_][j_][1] = *(const GAS v2u*)(r1_ + col_); YV[q_][j_][2] = *(const GAS v2u*)(r2_ + col_); YV[q_][j_][3] = *(const GAS v2u*)(r3_ + col_); \
            XW[q_][j_] = *(const GAS v4u*)(X + (size_t)(t0 + ti_) * DM + col_); } } } while (0)
#define CB_COMP(YV, XW, I) do { cb_token<LAST>(YV[0], XW[0], gy, gn, s0v, X, H, out, t0 + (I), lane, poison); cb_token<LAST>(YV[1], XW[1], gy, gn, s0v, X, H, out, t0 + (I) + 1, lane, poison); } while (0)
    CB_ISSUE(yA, xA, 0);
#pragma unroll 1
    for (int i = 0; i < TPW; i += 4) {
        CB_ISSUE(yB, xB, i + 2);
        CB_COMP(yA, xA, i);
        if (i + 4 < TPW) CB_ISSUE(yA, xA, i + 4);
        CB_COMP(yB, xB, i + 2);
    }
#undef CB_ISSUE
#undef CB_COMP
}
struct Args { const float* in[21]; float* out; unsigned char* ws; int ph_lo, ph_hi, li, pad; };
enum { I_X = 0, I_C, I_WMOD, I_BMOD, I_GMIX, I_WIN, I_GQ, I_GK, I_WDW, I_BDW, I_GCN, I_BCN, I_WOUT, I_GFFN, I_WR, I_BR, I_W1, I_B1, I_W2, I_B2, I_GFIN };

#define IN(k) (lo <= (k) && (k) < hi)
#define KAS __attribute__((address_space(4)))
#define ARG(k) (*(const float* const KAS*)(kap + 8 * (k)))
#define ARG_OUT (*(float* const KAS*)(kap + 8 * 21))
#define LAUNDER(P) const KAS char* kap = (const KAS char*)__builtin_amdgcn_kernarg_segment_ptr(); asm volatile("" : "+s"(kap)); Ctx P = F0; { unsigned z_ = 0u; asm volatile("" : "+v"(z_)); P.lane = (int)__builtin_amdgcn_mbcnt_hi(~0u, __builtin_amdgcn_mbcnt_lo(~0u, z_)); }     P.tid = P.wave * 64 + P.lane; asm volatile("" : "+v"(P.tid), "+v"(P.lane), "+s"(P.ws), "+s"(P.ctl))
#ifndef DBG_REP
#define DBG_REP -1
#endif
#define REPP(k) for (int rep_ = 0; rep_ < ((DBG_REP == (k)) ? 2 : 1); ++rep_)
#ifdef DBG_BAR2
#define SEAM(k) do { if (IN(k) && IN((k) + 1)) { xcd_barrier(bar); xcd_barrier(bar); } } while (0)
#else
#define SEAM(k) do { if (IN(k) && IN((k) + 1)) xcd_barrier(bar); } while (0)
#endif

template <int L> __device__ __forceinline__ void layer_body(const Ctx& F0, const Args& args, const XcdBarrier& bar, const int lo, const int hi, unsigned char* lds_generic) {
    constexpr int pb = 1 + 10 * L;
    if (L == 0 && IN(pb)) REPP(pb) { LAUNDER(F);
        constexpr int TPW = NTOK / (256 * NWAVES); const int lane = F.lane; const int t0 = (F.vcu * NWAVES + F.wave) * TPW;
        const float* x = ARG(I_X); const float* g = ARG(I_GMIX); const float* ma = (const float*)(F.ws + WS_MOD) + (size_t)L * NB * 6144 + (size_t)(t0 >> 11) * 6144; unsigned char* H = (unsigned char*)(F.ws + WS_H);
        f32x4 gs1[4], s0v[4];
#pragma unroll
        for (int j = 0; j < 4; ++j) { gs1[j] = ((const GAS f32x4*)g)[64 * j + lane] * (((const GAS f32x4*)(ma + 1024))[64 * j + lane] + 1.0f); s0v[j] = ((const GAS f32x4*)ma)[64 * j + lane]; }
        f32x4 vA[2][4], vB[2][4];
#define N1_ISSUE(V, I) do { _Pragma("unroll") for (int q_ = 0; q_ < 2; ++q_) _Pragma("unroll") for (int j_ = 0; j_ < 4; ++j_) V[q_][j_] = ((const GAS f32x4*)(x + (size_t)(t0 + (I) + q_) * DM))[64 * j_ + lane]; } while (0)
#define N1_COMP(V, I) do { _Pragma("unroll") for (int q_ = 0; q_ < 2; ++q_) { float ss_ = 0.f; \
            _Pragma("unroll") for (int j_ = 0; j_ < 4; ++j_) ss_ += (V[q_][j_].x * V[q_][j_].x + V[q_][j_].y * V[q_][j_].y) + (V[q_][j_].z * V[q_][j_].z + V[q_][j_].w * V[q_][j_].w); \
            const float ia_ = 1.0f / sqrtf(wave_sum_s(ss_) * (1.f / DM) + EPS); GAS unsigned* po_ = (GAS unsigned*)(H + (size_t)(t0 + (I) + q_) * DM) + lane; \
            _Pragma("unroll") for (int j_ = 0; j_ < 4; ++j_) { const f32x4 y_ = (V[q_][j_] * ia_) * gs1[j_] + s0v[j_]; po_[64 * j_] = pg8::pk4_fp8(y_.x * pg8::F8_SA, y_.y * pg8::F8_SA, y_.z * pg8::F8_SA, y_.w * pg8::F8_SA); } } } while (0)
        N1_ISSUE(vA, 0);
#pragma unroll 1
        for (int i = 0; i < TPW; i += 4) { N1_ISSUE(vB, i + 2); N1_COMP(vA, i); if (i + 4 < TPW) N1_ISSUE(vA, i + 4); N1_COMP(vB, i + 2); }
#undef N1_ISSUE
#undef N1_COMP
        SEAM(pb);
    }
    if (IN(pb + 1)) REPP(pb + 1) { LAUNDER(F);
        pg8::Gemm g{(const bf16*)(F.ws + WS_H), (const bf16*)(F.ws + WS_WIN + (size_t)L * INW * 1024), NTOK, INW, DM / 2, 0};
        pg8::StaticOrder S; S.init(NTOK, INW, F.G, (int)blockIdx.x);
        pg8::EpiInProj E{(bf16*)(F.ws + WS_Q), (bf16*)(F.ws + WS_KN), (bf16*)(F.ws + WS_V), (bf16*)(F.ws + WS_UU), ARG(I_GQ) + L * 64, ARG(I_GK) + L * 64, (const float*)(F.ws + WS_ROPE)};
        pg8::gemm_phase<pg8::EpiInProj, pg8::StaticOrder, true, true, true>(F.lds + RING_OFF, g, S, E, F.tid);
        SEAM(pb + 1);
    }
    if (IN(pb + 2)) REPP(pb + 2) { LAUNDER(F);
        p_conv(F, ARG(I_WDW) + (size_t)L * 31 * CC, ARG(I_BDW) + L * CC, ARG(I_GCN) + L * CC, ARG(I_BCN) + L * CC);
        SEAM(pb + 2);
    }
    if (IN(pb + 3)) REPP(pb + 3) { LAUNDER(F);
        static_assert(attn_body::ATTN_LDS_BYTES <= RING_BYTES, "attention body LDS vs frame");
        const attn_body::AttnTensors AT{(const attn_body::bf16*)(F.ws + WS_Q), (const attn_body::bf16*)(F.ws + WS_KN), (const attn_body::bf16*)(F.ws + WS_V), (attn_body::bf16*)(F.ws + WS_MIX)};
        const attn_body::StaticOrder S((int)F.G, (int)blockIdx.x);
        float mfix; bool afixed;
        { const float gq_ = wave_max_s(__builtin_fabsf(((const GAS float*)(ARG(I_GQ) + L * 64))[F.lane])), gk_ = wave_max_s(__builtin_fabsf(((const GAS float*)(ARG(I_GK) + L * 64))[F.lane]));
          mfix = attn_body::C2 * 64.0f * gq_ * gk_ * 1.01f + 0.25f; afixed = mfix <= 48.0f; }
        constexpr int ATT_SPLIT = 2; const int grp = F.vcu >> 7;
        if (afixed) {
#pragma unroll 1
        for (int seg = 0; seg < 3; ++seg) {
            const int kind = grp == 0 ? (seg == 0 ? 1 : seg == 1 ? 2 : 0) : (seg == 0 ? 3 : seg == 1 ? 1 : 4);
            if (kind == 1) { __syncthreads(); p_convert(F, ARG(I_WIN), ARG(I_WOUT), ARG(I_W1), ARG(I_W2), 1, L, (I_CV_W1L + I_CV_W2L) / 2, (F.vcu & 127) * NWAVES + F.wave, 128 * NWAVES, grp * ((I_CV_W1L + I_CV_W2L) / 2)); __syncthreads(); }
            else if (kind >= 2) attn_body::attn_phase<attn_body::StaticOrder, true>((char*)lds_generic + RING_OFF, AT, S, F.tid, kind == 4 ? ATT_SPLIT : 0, kind == 3 ? ATT_SPLIT : (1 << 30), mfix);
        }
        } else {
#pragma unroll 1
        for (int seg = 0; seg < 3; ++seg) {
            const int kind = grp == 0 ? (seg == 0 ? 1 : seg == 1 ? 2 : 0) : (seg == 0 ? 3 : seg == 1 ? 1 : 4);
            if (kind == 1) { __syncthreads(); p_convert(F, ARG(I_WIN), ARG(I_WOUT), ARG(I_W1), ARG(I_W2), 1, L, (I_CV_W1L + I_CV_W2L) / 2, (F.vcu & 127) * NWAVES + F.wave, 128 * NWAVES, grp * ((I_CV_W1L + I_CV_W2L) / 2)); __syncthreads(); }
            else if (kind >= 2) attn_body::attn_phase<attn_body::StaticOrder, false>((char*)lds_generic + RING_OFF, AT, S, F.tid, kind == 4 ? ATT_SPLIT : 0, kind == 3 ? ATT_SPLIT : (1 << 30), 0.f);
        }
        }
        SEAM(pb + 3);
    }
    if (IN(pb + 4)) REPP(pb + 4) { LAUNDER(F);
        pg8::Gemm g{(const bf16*)(F.ws + WS_MIX), (const bf16*)(F.ws + WS_WOUT + (size_t)L * 1024 * 1024), NTOK, DM, DM / 2, 0};
        pg8::StaticOrder S; S.init(NTOK, DM, F.G, (int)blockIdx.x);
        bf16* X = (bf16*)(F.ws + WS_X);
        pg8::EpiResGate<L == 0> E{L == 0 ? (const void*)ARG(I_X) : (const void*)X, X, (const float*)(F.ws + WS_MOD) + (size_t)L * NB * 6144 + 2 * 1024};
        pg8::gemm_phase<pg8::EpiResGate<L == 0>, pg8::StaticOrder, true, true, true>(F.lds + RING_OFF, g, S, E, F.tid);
        SEAM(pb + 4);
    }
    if (IN(pb + 5)) REPP(pb + 5) { LAUNDER(F);
        p_norm2_router(F, ARG(I_GFFN) + L * DM, ARG(I_WR) + (size_t)L * DM * NE, ARG(I_BR) + L * NE, (const float*)(F.ws + WS_MOD) + (size_t)L * NB * 6144, F.ctl + CW_CNT + 64 * L + ((DBG_REP == pb + 5 && rep_ == 0) ? 4096 : 0));
        SEAM(pb + 5);
    }
    if (IN(pb + 6)) REPP(pb + 6) { LAUNDER(F); p_perm(F, F.ctl + CW_CNT + 64 * L); SEAM(pb + 6); }
    if (IN(pb + 7)) REPP(pb + 7) { LAUNDER(F);
        const int T = build_tile_table(F, F.ctl + CW_CNT + 64 * L);
        pg8::Gemm g{(const bf16*)(F.ws + WS_H), (const bf16*)(F.ws + WS_W1 + (size_t)L * NE * 2048 * 1024), T * 256, 2048, DM / 2, (size_t)2048 * 1024};
        const unsigned long long pp_ = (unsigned long long)(F.ws + WS_PERM);
        const int* permp = (const int*)(((unsigned long long)(unsigned)__builtin_amdgcn_readfirstlane((int)(pp_ >> 32)) << 32) | (unsigned)__builtin_amdgcn_readfirstlane((int)(unsigned)pp_));
        pg8::MoeOrder<true, true> S{(const LAS unsigned char*)(F.lds + LX_TILE), T, F.G, F.vcu, permp, (LAS int*)(F.lds + LX_STG)};
        pg8::EpiSwiglu E{(unsigned char*)(F.ws + WS_ACT), ARG(I_B1) + (size_t)L * NE * 2048};
        pg8::gemm_phase<pg8::EpiSwiglu, pg8::MoeOrder<true, true>, true, true, true>(F.lds + RING_OFF, g, S, E, F.tid);
        SEAM(pb + 7);
    }
#ifdef DBG_DUP8
    if (L == 0 && IN(pb + 7)) { LAUNDER(F);
        const int T = build_tile_table(F, F.ctl + CW_CNT + 64 * L);
        pg8::Gemm g{(const bf16*)(F.ws + WS_H), (const bf16*)(F.ws + WS_W1 + (size_t)L * NE * 2048 * 1024), T * 256, 2048, DM / 2, (size_t)2048 * 1024};
        const unsigned long long pp_ = (unsigned long long)(F.ws + WS_PERM);
        const int* permp = (const int*)(((unsigned long long)(unsigned)__builtin_amdgcn_readfirstlane((int)(pp_ >> 32)) << 32) | (unsigned)__builtin_amdgcn_readfirstlane((int)(unsigned)pp_));
        pg8::MoeOrder<true, true> S{(const LAS unsigned char*)(F.lds + LX_TILE), T, F.G, F.vcu, permp, (LAS int*)(F.lds + LX_STG)};
        pg8::EpiSwiglu E{(unsigned char*)(F.ws + WS_ACT), ARG(I_B1) + (size_t)L * NE * 2048};
        pg8::gemm_phase<pg8::EpiSwiglu, pg8::MoeOrder<true, true>, true, true, true>(F.lds + RING_OFF, g, S, E, F.tid);
        SEAM(pb + 7);
    }
#endif
    if (IN(pb + 8)) REPP(pb + 8) { LAUNDER(F);
        const int T = build_tile_table(F, F.ctl + CW_CNT + 64 * L);
        pg8::Gemm g{(const bf16*)(F.ws + WS_ACT), (const bf16*)(F.ws + WS_W2 + (size_t)L * NE * 1024 * 1024), T * 256, DM, DM / 2, (size_t)1024 * 1024};
        pg8::MoeOrder<false, false, true> S{(const LAS unsigned char*)(F.lds + LX_TILE), T, F.G, F.vcu, nullptr, nullptr};
        pg8::EpiY E{(unsigned char*)(F.ws + WS_Y), ARG(I_B2) + (size_t)L * NE * 1024, (const float*)(F.ws + WS_PGATE)};
        pg8::gemm_phase<pg8::EpiY, pg8::MoeOrder<false, false, true>, true, true, true>(F.lds + RING_OFF, g, S, E, F.tid);
        SEAM(pb + 8);
    }
#ifdef DBG_DUP9
    if (L == 0 && IN(pb + 8)) { LAUNDER(F);
        const int T = build_tile_table(F, F.ctl + CW_CNT + 64 * L);
        pg8::Gemm g{(const bf16*)(F.ws + WS_ACT), (const bf16*)(F.ws + WS_W2 + (size_t)L * NE * 1024 * 1024), T * 256, DM, DM / 2, (size_t)1024 * 1024};
        pg8::MoeOrder<false, false, true> S{(const LAS unsigned char*)(F.lds + LX_TILE), T, F.G, F.vcu, nullptr, nullptr};
        pg8::EpiY E{(unsigned char*)(F.ws + WS_Y), ARG(I_B2) + (size_t)L * NE * 1024, (const float*)(F.ws + WS_PGATE)};
        pg8::gemm_phase<pg8::EpiY, pg8::MoeOrder<false, false, true>, true, true, true>(F.lds + RING_OFF, g, S, E, F.tid);
        SEAM(pb + 8);
    }
#endif
    if (IN(pb + 9)) REPP(pb + 9) { LAUNDER(F);
        const float* mod_l = (const float*)(F.ws + WS_MOD) + (size_t)L * NB * 6144;
        if (L == DEPTH - 1) {
            bool poison = false;
            for (int r = 0; r < NPH; ++r) poison |= __hip_atomic_load((gu32*)(F.ctl + CW_BAR + r * XCD_BAR_WORDS + XB_TMO), RLX_AGENT) != 0u;
            p_combine<true>(F, mod_l, ARG(I_GFIN), nullptr, ARG_OUT, poison);
        } else {
            p_combine<false>(F, mod_l, ARG(I_GMIX) + (L + 1) * DM, (const float*)(F.ws + WS_MOD) + (size_t)(L + 1) * NB * 6144, nullptr, false);
        }
        SEAM(pb + 9);
    }
}

__global__ void __launch_bounds__(NWAVES * 64, 2) enc_fwd(Args args) {
    extern __shared__ __attribute__((aligned(16))) unsigned char lds[];
    Ctx F0;
    F0.lds = (LAS unsigned char*)lds; F0.ws = args.ws; F0.ctl = (gu32*)(args.ws + WS_CTL);
    F0.tid = 0; F0.lane = 0; F0.wave = __builtin_amdgcn_readfirstlane((int)threadIdx.x >> 6);
    F0.G = gridDim.x; { const int bx = blockIdx.x; F0.vcu = (F0.G % 8 == 0) ? (bx % 8) * (F0.G / 8) + bx / 8 : bx; }
    volatile LAS unsigned* MISC = (volatile LAS unsigned*)(F0.lds + LX_MISC);
    for (int u = threadIdx.x; u < 128; u += NWAVES * 64) ((LAS unsigned*)(F0.lds + LX_MISC))[u] = 0u;
    __syncthreads();
    unsigned* barw = (unsigned*)(F0.ctl + CW_BAR) + args.li * XCD_BAR_WORDS;
    const XcdBarrier bar = xcd_barrier_post(barw, MISC + 8, (unsigned)F0.wave);
    const int lo = args.ph_lo, hi = args.ph_hi;
    if (IN(0)) REPP(0) { LAUNDER(F); p0_prologue(F, ARG(I_C), ARG(I_WMOD), ARG(I_BMOD), ARG(I_WIN), ARG(I_WOUT), ARG(I_W1), ARG(I_W2)); SEAM(0); }
    layer_body<0>(F0, args, bar, lo, hi, lds);
    layer_body<1>(F0, args, bar, lo, hi, lds);
#ifdef DBG_STOP
    if (IN(21)) { LAUNDER(F); const int gw = F.vcu * NWAVES + F.wave, NGW = F.G * NWAVES, lane = F.lane; const float* X = (DBG_STOP == 0) ? ARG(I_X) : (const float*)(F.ws + WS_X); const float* g = ARG(I_GFIN);
        for (int tok = gw; tok < NTOK; tok += NGW) { const GAS f32x4* xr = (const GAS f32x4*)(X + (size_t)tok * DM) + lane; f32x4 v[4]; float ss = 0.f;
            for (int j = 0; j < 4; ++j) { v[j] = xr[64 * j]; ss += (v[j].x * v[j].x + v[j].y * v[j].y) + (v[j].z * v[j].z + v[j].w * v[j].w); }
            const float rinv = 1.0f / sqrtf(wave_sum(ss, lane) * (1.f / DM) + EPS);
            for (int j = 0; j < 4; ++j) ((GAS f32x4*)(ARG_OUT + (size_t)tok * DM))[64 * j + lane] = (v[j] * rinv) * ((const GAS f32x4*)g)[64 * j + lane]; } }
#endif
}
#undef IN
#undef SEAM
#undef LAUNDER

extern "C" void kernel_launch(void* const* d_in, const int* in_sizes, int n_in, void* d_out, int out_size, void* d_ws, size_t ws_size, hipStream_t stream) {
    static int grid = 0;
    if (grid == 0) {
        if (n_in != 21 || in_sizes[0] != NTOK * DM || out_size != NTOK * DM || ws_size < WS_END) { fprintf(stderr, "kernel_launch: shape/workspace mismatch (n_in %d, in0 %d, out %d, ws %zu, need %zu); nothing launched\n", n_in, n_in > 0 ? in_sizes[0] : -1, out_size, ws_size, (size_t)WS_END); grid = -1; return; }
        int dev = 0, cus = 0, per_cu = 0;
        if (hipGetDevice(&dev) != hipSuccess || hipDeviceGetAttribute(&cus, hipDeviceAttributeMultiprocessorCount, dev) != hipSuccess) { fprintf(stderr, "kernel_launch: device query failed\n"); grid = -1; return; }
        if (hipFuncSetAttribute((const void*)enc_fwd, hipFuncAttributeMaxDynamicSharedMemorySize, LDS_BYTES) != hipSuccess) { fprintf(stderr, "kernel_launch: hipFuncSetAttribute failed\n"); grid = -1; return; }
        if (hipOccupancyMaxActiveBlocksPerMultiprocessor(&per_cu, (const void*)enc_fwd, NWAVES * 64, LDS_BYTES) != hipSuccess || per_cu < 1) fprintf(stderr, "kernel_launch: note: occupancy query reports %d workgroups per CU\n", per_cu);
        (void)hipGetLastError();
        if (cus != 256) { fprintf(stderr, "kernel_launch: built for a 256-CU device, found %d; nothing launched\n", cus); grid = -1; return; }
        grid = cus;
    }
    if (grid < 0) return;
    if (hipMemsetAsync((char*)d_ws + WS_CTL, 0, CTL_ZERO_BYTES, stream) != hipSuccess) { fprintf(stderr, "kernel_launch: hipMemsetAsync failed\n"); return; }
    Args a{};
    for (int i = 0; i < 21; ++i) a.in[i] = (const float*)d_in[i];
    a.out = (float*)d_out; a.ws = (unsigned char*)d_ws;
#if MK_PER_PHASE
    for (int li = 0; li < NPH; ++li) { if (li == 11) continue;
#ifdef DBG_STOP
        if (li > DBG_STOP) continue;
#endif
        a.ph_lo = li; a.ph_hi = li + 1; a.li = li;
        hipLaunchKernelGGL(enc_fwd, dim3(grid), dim3(NWAVES * 64), LDS_BYTES, stream, a); }
#ifdef DBG_STOP
    a.ph_lo = 21; a.ph_hi = 22; a.li = 20; hipLaunchKernelGGL(enc_fwd, dim3(grid), dim3(NWAVES * 64), LDS_BYTES, stream, a);
#endif
#else
    a.ph_lo = 0; a.ph_hi = NPH; a.li = 0;
    hipLaunchKernelGGL(enc_fwd, dim3(grid), dim3(NWAVES * 64), LDS_BYTES, stream, a);
#endif
    const hipError_t le = hipPeekAtLastError();
    if (le != hipSuccess) fprintf(stderr, "kernel_launch: launch failed: %s\n", hipGetErrorName(le));
}
```

```cpp
#include <hip/hip_runtime.h>
#include <hip/hip_bf16.h>
#include <cstdio>
#include <cstdint>
#include <cmath>
#ifndef MK_PER_PHASE
#define MK_PER_PHASE 0
#endif
namespace pg8 {
#define PG8_LAS __attribute__((address_space(3)))
typedef unsigned short bf16_t;
typedef short bf16x8 __attribute__((ext_vector_type(8)));
typedef float f32x4 __attribute__((ext_vector_type(4)));
typedef unsigned u32x4 __attribute__((ext_vector_type(4)));
constexpr int BM = 256, BK = 64, HALF = 128, HTB = HALF * BK * 2  , STAGE_BYTES = 8 * HTB, NXCD = 8, WGM = 8;

__host__ __device__ __forceinline__ int lds_byte(int r, int c) { const int st = (r >> 4) * 2 + (c >> 5), rr = r & 15, cc = c & 31, ob = rr * 64 + cc * 2; return st * 1024 + (ob ^ (((ob >> 9) & 1) << 5)); }
__host__ __device__ __forceinline__ void stage_rc(int b, int& R, int& C) { const int st = b / 1024, sb = b % 1024, swz = sb ^ (((sb >> 9) & 1) << 5); R = (st >> 1) * 16 + swz / 64; C = (st & 1) * 32 + (swz % 64) / 2; }
__host__ __device__ __forceinline__ int perm32(int rho) { const int n = rho >> 4, i = rho & 15; return 8 * (i >> 2) + 4 * n + (i & 3); }


#define PG8_GAS __attribute__((address_space(1)))
typedef int v8i_t __attribute__((ext_vector_type(8)));
typedef int v4i_t __attribute__((ext_vector_type(4)));
#ifndef PG8_F8_SCALE
#define PG8_F8_SCALE 0
#endif
__device__ __forceinline__ void pg8_glds(const void* sbase, unsigned voff, unsigned ldsdst) { unsigned keep;
    asm volatile("s_mov_b32 %0, m0\n\ts_mov_b32 m0, %3\n\ts_nop 0\n\tglobal_load_lds_dwordx4 %1, %2\n\ts_mov_b32 m0, %0" : "=&s"(keep) : "v"(voff), "s"(sbase), "s"(ldsdst) : "memory"); }
template <class T> __device__ __forceinline__ T* pg8_uniform(T* p) { const unsigned long long v = (unsigned long long)p;
    return (T*)(((unsigned long long)(unsigned)__builtin_amdgcn_readfirstlane((int)(v >> 32)) << 32) | (unsigned)__builtin_amdgcn_readfirstlane((int)(unsigned)v)); }
__device__ __forceinline__ v8i_t pg8_cat(bf16x8 lo, bf16x8 hi) { const v4i_t a = __builtin_bit_cast(v4i_t, lo), b = __builtin_bit_cast(v4i_t, hi); return __builtin_shufflevector(a, b, 0, 1, 2, 3, 4, 5, 6, 7); }

struct Unit { int pm, pn, e; };
struct Gemm { const bf16_t* A; const bf16_t* Bt; int M, N, K; size_t estride; };

struct StaticOrder {
    static constexpr bool GATHER = false; const int* perm; PG8_LAS int* ptab;
    int nM, nN, nwg, G, c;
    __host__ __device__ void init(int M, int N, int G_, int c_) { nM = M / BM; nN = N / BM; nwg = nM * nN; G = G_; c = c_; }
    __host__ __device__ bool next(int i, Unit& u) const {
        const long L = (long)i * G + c; if (L >= nwg) return false;
        int wgid = (int)L; { const int q = nwg / NXCD, r = nwg % NXCD, xcd = wgid % NXCD, off = wgid / NXCD; wgid = (xcd < r ? xcd * (q + 1) : r * (q + 1) + (xcd - r) * q) + off; }
        const int nig = WGM * nN, gid = wgid / nig, fm = gid * WGM, gsz = (nM - fm) < WGM ? (nM - fm) : WGM;
        u.pm = fm + ((wgid % nig) % gsz); u.pn = (wgid % nig) / gsz; u.e = 0; return true;
    }
    __device__ __forceinline__ void a_ready(const Unit&) const {}
    __device__ __forceinline__ void done(const Unit&) const {}
};
struct RowOrder {
    static constexpr bool GATHER = false; const int* perm; PG8_LAS int* ptab;
    int nM, nN, G, vcu;
    __device__ __forceinline__ bool next(int i, Unit& u) const { const int lap = i / nN, pm = lap * G + vcu; if (pm >= nM) return false; u.pm = pm; u.pn = i - lap * nN; u.e = 0; return true; }
    __device__ __forceinline__ void a_ready(const Unit&) const {}
    __device__ __forceinline__ void done(const Unit&) const {}
};
template <int LOGN, bool GATHER_ = false> struct MoeRowOrder {
    static constexpr bool GATHER = GATHER_;
    const PG8_LAS unsigned char* tile_e; int T, G, vcu; const int* perm; PG8_LAS int* ptab;
    __device__ __forceinline__ bool next(int i, Unit& u) const {
        const int fl = T / G, nfull = fl << LOGN;
        int t, pn;
        if (i < nfull) { t = (i >> LOGN) * G + vcu; pn = i & ((1 << LOGN) - 1); }
        else { const int v = (i - nfull) * G + vcu; t = fl * G + (v >> LOGN); pn = v & ((1 << LOGN) - 1); if (t >= T) return false; }
        u.pm = t; u.pn = pn; u.e = __builtin_amdgcn_readfirstlane((int)tile_e[t]); return true;
    }
    __device__ __forceinline__ void a_ready(const Unit&) const {}
    __device__ __forceinline__ void done(const Unit&) const {}
};
template <bool NN8, bool GATHER_ = false, bool REV = false> struct MoeOrder {
    static constexpr bool GATHER = GATHER_;
    const PG8_LAS unsigned char* tile_e; int T, G, vcu; const int* perm; PG8_LAS int* ptab;
    __device__ __forceinline__ bool next(int i, Unit& u) const {
        const int v = i * G + vcu, grp = v >> 5, j = v & 31;
        const int t = NN8 ? (4 * grp + (j & 3)) : (8 * grp + (j & 7));
        if (t >= T) return false;
        u.pm = REV ? (T - 1 - t) : t; u.pn = NN8 ? (j >> 2) : (j >> 3); u.e = __builtin_amdgcn_readfirstlane((int)tile_e[u.pm]); return true;
    }
    __device__ __forceinline__ void a_ready(const Unit&) const {}
    __device__ __forceinline__ void done(const Unit&) const {}
};

__device__ __forceinline__ unsigned cvt_pk_bf16(float lo, float hi) { unsigned r; asm volatile("v_cvt_pk_bf16_f32 %0, %1, %2" : "=v"(r) : "v"(lo), "v"(hi)); return r; }

constexpr float F8_SA = 8.f, F8_SW = 1024.f, F8_SACT = 8.f;
constexpr float F8_SMIX = 16.f;
constexpr float F8_DQ_OUT = 1.0f / (F8_SMIX * F8_SW);
constexpr float F8_DQ_IN = 1.0f / (F8_SA * F8_SW);
struct EpiInProj {
    static constexpr bool PERM = true, AFTER_DRAIN = false, STAGED = false;
    bf16_t* Q; bf16_t* KN; bf16_t* V; bf16_t* U; const float* g_q; const float* g_k; const float* rope;
    __device__ __forceinline__ void operator()(const f32x4 (&acc)[2][2][4][2], const Unit& u, int wr, int wc, int fr, int fq) const {
        const int row0 = u.pm * BM + wr * 64 + fr;
        if (u.pn >= 3) {
            bf16_t* op = U + (size_t)row0 * 512 + (u.pn - 3) * HALF + wc * 32 + 8 * fq;
#pragma unroll
            for (int ai = 0; ai < 2; ++ai)
#pragma unroll
                for (int m = 0; m < 4; ++m) { float o[8];
#pragma unroll
                    for (int n = 0; n < 2; ++n)
#pragma unroll
                        for (int j = 0; j < 4; ++j) o[4 * n + j] = (acc[ai][0][m][n][j] * F8_DQ_IN) * __builtin_amdgcn_rcpf(1.0f + __builtin_amdgcn_exp2f((-1.4426950408889634f * F8_DQ_IN) * acc[ai][1][m][n][j]));
                    u32x4 w; w.x = cvt_pk_bf16(o[0], o[1]); w.y = cvt_pk_bf16(o[2], o[3]); w.z = cvt_pk_bf16(o[4], o[5]); w.w = cvt_pk_bf16(o[6], o[7]);
                    *(PG8_GAS u32x4*)(op + (size_t)(ai * HALF + m * 16) * 512) = w; }
            return;
        }
        if (u.pn == 2 && wc >= 2) {
            bf16_t* op = V + (size_t)row0 * 128 + (wc - 2) * 64 + 8 * fq;
#pragma unroll
            for (int ai = 0; ai < 2; ++ai)
#pragma unroll
                for (int m = 0; m < 4; ++m)
#pragma unroll
                    for (int bj = 0; bj < 2; ++bj) { const f32x4 v0 = acc[ai][bj][m][0] * F8_DQ_IN, v1 = acc[ai][bj][m][1] * F8_DQ_IN;
                        u32x4 w; w.x = cvt_pk_bf16(v0[0], v0[1]); w.y = cvt_pk_bf16(v0[2], v0[3]); w.z = cvt_pk_bf16(v1[0], v1[1]); w.w = cvt_pk_bf16(v1[2], v1[3]);
                        *(PG8_GAS u32x4*)(op + (size_t)(ai * HALF + m * 16) * 128 + bj * 32) = w; }
            return;
        }
        const bool isq = u.pn < 2; const int lane = fr + 16 * fq;
        const float* gp = (isq ? g_q : g_k) + 32 * (fq >> 1) + 8 * (fq & 1);
        f32x4 g1[2], g2[2];
#pragma unroll
        for (int n = 0; n < 2; ++n) { g1[n] = *(const PG8_GAS f32x4*)(gp + 4 * n); g2[n] = *(const PG8_GAS f32x4*)(gp + 16 + 4 * n); }
        const float qs = isq ? 0.125f * 1.4426950408889634f : 1.0f;
        bf16_t* op = isq ? (Q + (size_t)row0 * 512 + (4 * u.pn + wc) * 64 + 8 * fq) : (KN + (size_t)row0 * 128 + wc * 64 + 8 * fq);
        const int ostride = isq ? 512 : 128;
#pragma unroll
        for (int ai = 0; ai < 2; ++ai)
#pragma unroll
            for (int m = 0; m < 4; ++m) { const int rr = ai * HALF + m * 16;
                const f32x4 a0 = acc[ai][0][m][0] * F8_DQ_IN, a1 = acc[ai][0][m][1] * F8_DQ_IN, b0 = acc[ai][1][m][0] * F8_DQ_IN, b1 = acc[ai][1][m][1] * F8_DQ_IN;
                float ss = (a0[0] * a0[0] + a0[1] * a0[1]) + (a0[2] * a0[2] + a0[3] * a0[3]) + (a1[0] * a1[0] + a1[1] * a1[1]) + (a1[2] * a1[2] + a1[3] * a1[3])
                         + (b0[0] * b0[0] + b0[1] * b0[1]) + (b0[2] * b0[2] + b0[3] * b0[3]) + (b1[0] * b1[0] + b1[1] * b1[1]) + (b1[2] * b1[2] + b1[3] * b1[3]);
                ss += __builtin_bit_cast(float, __builtin_amdgcn_ds_bpermute((lane ^ 16) << 2, __builtin_bit_cast(int, ss)));
                ss += __builtin_bit_cast(float, __builtin_amdgcn_ds_bpermute((lane ^ 32) << 2, __builtin_bit_cast(int, ss)));
                const float rinv = qs / __builtin_sqrtf(ss * (1.0f / 64.0f) + 1e-6f);
                const float* rp = rope + (size_t)((row0 + rr) & 2047) * 64 + 8 * fq;
                const f32x4 c0 = *(const PG8_GAS f32x4*)(rp), c1 = *(const PG8_GAS f32x4*)(rp + 4), s0 = *(const PG8_GAS f32x4*)(rp + 32), s1 = *(const PG8_GAS f32x4*)(rp + 36);
                const f32x4 y10 = a0 * rinv * g1[0], y11 = a1 * rinv * g1[1], y20 = b0 * rinv * g2[0], y21 = b1 * rinv * g2[1];
                const f32x4 o10 = y10 * c0 - y20 * s0, o11 = y11 * c1 - y21 * s1, o20 = y20 * c0 + y10 * s0, o21 = y21 * c1 + y11 * s1;
                u32x4 w; w.x = cvt_pk_bf16(o10[0], o10[1]); w.y = cvt_pk_bf16(o10[2], o10[3]); w.z = cvt_pk_bf16(o11[0], o11[1]); w.w = cvt_pk_bf16(o11[2], o11[3]);
                *(PG8_GAS u32x4*)(op + (size_t)rr * ostride) = w;
                w.x = cvt_pk_bf16(o20[0], o20[1]); w.y = cvt_pk_bf16(o20[2], o20[3]); w.z = cvt_pk_bf16(o21[0], o21[1]); w.w = cvt_pk_bf16(o21[2], o21[3]);
                *(PG8_GAS u32x4*)(op + (size_t)rr * ostride + 32) = w; }
    }
};
__host__ __device__ __forceinline__ int inproj_row(int n) {
    if (n < 640) { const int head = n >> 6, d = n & 63, a = d >> 5, p = (d >> 4) & 1, f = d & 15; const int tile = head < 8 ? (head >> 2) : 2, wc = head & 3; return tile * 256 + 128 * p + 32 * wc + 16 * a + f; }
    if (n < 768) { const int c = n - 640, vh = c >> 6, d = c & 63; return 2 * 256 + 128 * (d >> 5) + 32 * (2 + vh) + (d & 31); }
    if (n < 1280) { const int c = n - 768; return (3 + (c >> 7)) * 256 + (c & 127); }
    { const int c = n - 1280; return (3 + (c >> 7)) * 256 + 128 + (c & 127); }
}
template <bool XIN_F32> struct EpiResGate {
    static constexpr bool PERM = true, AFTER_DRAIN = false, STAGED = false;
    const void* xin; bf16_t* xout; const float* gate;
    __device__ __forceinline__ void operator()(const f32x4 (&acc)[2][2][4][2], const Unit& u, int wr, int wc, int fr, int fq) const {
        const int row0 = u.pm * BM + wr * 64 + fr, col0 = u.pn * BM + wc * 32 + 8 * fq;
        const float* gp = gate + (size_t)((u.pm * BM) >> 11) * 6144 + col0;
        f32x4 gv[2][2];
#pragma unroll
        for (int bj = 0; bj < 2; ++bj)
#pragma unroll
            for (int n = 0; n < 2; ++n) gv[bj][n] = *(const PG8_GAS f32x4*)(gp + bj * HALF + 4 * n) * F8_DQ_OUT;
#pragma unroll
        for (int ai = 0; ai < 2; ++ai)
#pragma unroll
            for (int m = 0; m < 4; ++m) { const size_t ro = (size_t)(row0 + ai * HALF + m * 16) * 1024 + col0;
#pragma unroll
                for (int bj = 0; bj < 2; ++bj) { f32x4 x0, x1;
                    if constexpr (XIN_F32) { x0 = *(const PG8_GAS f32x4*)((const float*)xin + ro + bj * HALF); x1 = *(const PG8_GAS f32x4*)((const float*)xin + ro + bj * HALF + 4); }
                    else { const u32x4 xw = *(const PG8_GAS u32x4*)((const bf16_t*)xin + ro + bj * HALF);
                        x0 = (f32x4){__builtin_bit_cast(float, xw.x << 16), __builtin_bit_cast(float, xw.x & 0xffff0000u), __builtin_bit_cast(float, xw.y << 16), __builtin_bit_cast(float, xw.y & 0xffff0000u)};
                        x1 = (f32x4){__builtin_bit_cast(float, xw.z << 16), __builtin_bit_cast(float, xw.z & 0xffff0000u), __builtin_bit_cast(float, xw.w << 16), __builtin_bit_cast(float, xw.w & 0xffff0000u)}; }
                    const f32x4 v0 = x0 + gv[bj][0] * acc[ai][bj][m][0], v1 = x1 + gv[bj][1] * acc[ai][bj][m][1];
                    u32x4 w; w.x = cvt_pk_bf16(v0[0], v0[1]); w.y = cvt_pk_bf16(v0[2], v0[3]); w.z = cvt_pk_bf16(v1[0], v1[1]); w.w = cvt_pk_bf16(v1[2], v1[3]);
                    *(PG8_GAS u32x4*)(xout + ro + bj * HALF) = w; } }
    }
};
__device__ __forceinline__ unsigned pk4_fp8(float a, float b, float c, float d) {
    a = __builtin_amdgcn_fmed3f(a, -448.f, 448.f); b = __builtin_amdgcn_fmed3f(b, -448.f, 448.f); c = __builtin_amdgcn_fmed3f(c, -448.f, 448.f); d = __builtin_amdgcn_fmed3f(d, -448.f, 448.f);
    int w = 0; w = __builtin_amdgcn_cvt_pk_fp8_f32(a, b, w, false); w = __builtin_amdgcn_cvt_pk_fp8_f32(c, d, w, true); return (unsigned)w; }
struct EpiSwiglu {
    static constexpr bool PERM = true, AFTER_DRAIN = false, STAGED = true;
    __device__ __forceinline__ const float* stage_addr(const Unit& u, int tid) const { const int t8 = tid & 255; return b1 + (size_t)u.e * 2048 + (t8 < 128 ? u.pn * HALF + t8 : 1024 + u.pn * HALF + t8 - 128); }
    __device__ __forceinline__ float stage(const Unit& u, int tid) const { return tid < 256 ? ((const PG8_GAS float*)b1)[(size_t)u.e * 2048 + (tid < 128 ? u.pn * HALF + tid : 1024 + u.pn * HALF + tid - 128)] : 0.f; }
    unsigned char* O; const float* b1;
    typedef float f32x2 __attribute__((ext_vector_type(2)));
    __device__ __forceinline__ void operator()(const f32x4 (&acc)[2][2][4][2], const Unit& u, int wr, int wc, int fr, int fq, const PG8_LAS float* st) const {
        const int row0 = u.pm * BM + wr * 64 + fr; const int colh = u.pn * HALF + wc * 32 + 8 * fq;
        const PG8_LAS float* bp = st + wc * 32 + 8 * fq; constexpr float dq = 1.0f / (F8_SA * F8_SW);
        constexpr float NC = -1.702f * 1.4426950408889634f;
        f32x4 bg[2], bl[2];
#pragma unroll
        for (int n = 0; n < 2; ++n) { bg[n] = *(const PG8_LAS f32x4*)(bp + 4 * n); bl[n] = *(const PG8_LAS f32x4*)(bp + 128 + 4 * n) * F8_SACT + F8_SACT; }
        typedef unsigned u32x2 __attribute__((ext_vector_type(2)));
#pragma unroll
        for (int ai = 0; ai < 2; ++ai)
#pragma unroll
            for (int m = 0; m < 4; ++m) { f32x2 a[4];
#pragma unroll
                for (int n = 0; n < 2; ++n)
#pragma unroll
                    for (int h = 0; h < 2; ++h) { const f32x2 ag = (f32x2){acc[ai][0][m][n][2 * h], acc[ai][0][m][n][2 * h + 1]}, al = (f32x2){acc[ai][1][m][n][2 * h], acc[ai][1][m][n][2 * h + 1]};
                        const f32x2 bgv = (f32x2){bg[n][2 * h], bg[n][2 * h + 1]}, blv = (f32x2){bl[n][2 * h], bl[n][2 * h + 1]};
                        f32x2 g = ag * dq + bgv; g.x = __builtin_fminf(g.x, 7.0f); g.y = __builtin_fminf(g.y, 7.0f);
                        f32x2 l = al * (dq * F8_SACT) + blv; l.x = __builtin_amdgcn_fmed3f(l.x, -6.0f * F8_SACT, 8.0f * F8_SACT); l.y = __builtin_amdgcn_fmed3f(l.y, -6.0f * F8_SACT, 8.0f * F8_SACT);
                        f32x2 t = g * NC; t.x = __builtin_amdgcn_exp2f(t.x); t.y = __builtin_amdgcn_exp2f(t.y); t = t + 1.0f; t.x = __builtin_amdgcn_rcpf(t.x); t.y = __builtin_amdgcn_rcpf(t.y);
                        a[2 * n + h] = (g * t) * l; }
                u32x2 w; int w0 = 0, w1 = 0;
                w0 = __builtin_amdgcn_cvt_pk_fp8_f32(a[0].x, a[0].y, w0, false); w0 = __builtin_amdgcn_cvt_pk_fp8_f32(a[1].x, a[1].y, w0, true);
                w1 = __builtin_amdgcn_cvt_pk_fp8_f32(a[2].x, a[2].y, w1, false); w1 = __builtin_amdgcn_cvt_pk_fp8_f32(a[3].x, a[3].y, w1, true);
                w.x = (unsigned)w0; w.y = (unsigned)w1;
                *(PG8_GAS u32x2*)(O + (size_t)(row0 + ai * HALF + m * 16) * 1024 + colh) = w; }
    }
};
constexpr float F8_SY = 64.f;
struct EpiY {
    static constexpr bool PERM = true, AFTER_DRAIN = false, STAGED = true;
    unsigned char* O; const float* b2; const float* rowgate;
    __device__ __forceinline__ const float* stage_addr(const Unit& u, int tid) const { return tid < 256 ? rowgate + u.pm * BM + tid : b2 + (size_t)u.e * 1024 + u.pn * BM + tid - 256; }
    __device__ __forceinline__ float stage(const Unit& u, int tid) const { return tid < 256 ? ((const PG8_GAS float*)rowgate)[u.pm * BM + tid] : ((const PG8_GAS float*)b2)[(size_t)u.e * 1024 + u.pn * BM + tid - 256]; }
    __device__ __forceinline__ void operator()(const f32x4 (&acc)[2][2][4][2], const Unit& u, int wr, int wc, int fr, int fq, const PG8_LAS float* st) const {
        const int rl0 = wr * 64 + fr; const int col0 = u.pn * BM + wc * 32 + 8 * fq;
        const PG8_LAS float* bp = st + 256 + wc * 32 + 8 * fq; constexpr float dq = 1.0f / (F8_SACT * F8_SW);
        f32x4 bv[2][2];
#pragma unroll
        for (int bj = 0; bj < 2; ++bj)
#pragma unroll
            for (int n = 0; n < 2; ++n) bv[bj][n] = *(const PG8_LAS f32x4*)(bp + bj * HALF + 4 * n);
        typedef unsigned u32x2 __attribute__((ext_vector_type(2)));
#pragma unroll
        for (int ai = 0; ai < 2; ++ai)
#pragma unroll
            for (int m = 0; m < 4; ++m) { const int rl = rl0 + ai * HALF + m * 16; const float gt = st[rl] * F8_SY; unsigned char* rowp = O + (size_t)(u.pm * BM + rl) * 1024 + col0;
#pragma unroll
                for (int bj = 0; bj < 2; ++bj) { const f32x4 v0 = (acc[ai][bj][m][0] * dq + bv[bj][0]) * gt, v1 = (acc[ai][bj][m][1] * dq + bv[bj][1]) * gt;
                    u32x2 w; w.x = pk4_fp8(v0[0], v0[1], v0[2], v0[3]); w.y = pk4_fp8(v1[0], v1[1], v1[2], v1[3]);
                    *(PG8_GAS u32x2*)(rowp + bj * HALF) = w; } }
    }
};

template <class Epi, class Sched, bool ALIGN_EPI = false, bool SP2 = false, bool F8 = false>
__device__ __forceinline__ void gemm_phase(PG8_LAS unsigned char* lds, const Gemm g_in, const Sched& S, const Epi& E, const int tid_in) {
    Gemm g = g_in; g.A = pg8_uniform(g_in.A); g.Bt = pg8_uniform(g_in.Bt);
    int tid_ = tid_in; asm volatile("" : "+v"(tid_));
    const int tid = tid_, wid = __builtin_amdgcn_readfirstlane(tid >> 6), lane = tid & 63, wr = wid >> 2, wc = wid & 3, fr = lane & 15, fq = lane >> 4;
    const int K = g.K, nt = K / BK;
    unsigned voffA, voffB;
    { int R, C; stage_rc(tid * 16, R, C); const int Rb = Epi::PERM ? ((R & ~31) + perm32(R & 31)) : R; voffA = (unsigned)(R * K + C) * 2u; voffB = (unsigned)(Rb * K + C) * 2u; }
    constexpr bool GATHER = Sched::GATHER;
    unsigned tabR, tabC;
    { int R, C; stage_rc(tid * 16, R, C); tabR = (unsigned)R; tabC = (unsigned)C * 2u; }
    const unsigned rowb = (unsigned)K * 2u;
#define PG8_GA_RD(h, PAR) unsigned gr0_ = 0, gr1_ = 0; if constexpr (GATHER) { gr0_ = (unsigned)S.ptab[(PAR) * 256 + (h) * 128 + (int)tabR]; gr1_ = (unsigned)S.ptab[(PAR) * 256 + (h) * 128 + 64 + (int)tabR]; }
#define PG8_GA_IS(bufoff, kofs) do { unsigned vo0_ = gr0_ * rowb + tabC, vo1_ = gr1_ * rowb + tabC; asm volatile("" : "+v"(vo0_), "+v"(vo1_)); \
        __builtin_amdgcn_global_load_lds((const unsigned*)((const char*)g.A + (kofs) + vo0_), (PG8_LAS unsigned*)(lds + (bufoff) + ldsw), 16, 0, 0); \
        __builtin_amdgcn_global_load_lds((const unsigned*)((const char*)g.A + (kofs) + vo1_), (PG8_LAS unsigned*)(lds + (bufoff) + ldsw + 8192), 16, 0, 0); } while (0)
#define PG8_GA(bufoff, kofs, h, PAR) do { PG8_GA_RD(h, PAR); PG8_GA_IS(bufoff, kofs); } while (0)
#define PG8_STAGE_A2(bufoff, ptr, kofs) do { if constexpr (GATHER) { PG8_GA_IS(bufoff, kofs); } else { PG8_STAGE(bufoff, ptr, voffA); } } while (0)
#define PG8_STAGE_A(bufoff, ptr, kofs, h, PAR) do { if constexpr (GATHER) { PG8_GA(bufoff, kofs, h, PAR); } else { PG8_STAGE(bufoff, ptr, voffA); } } while (0)
    const size_t kstep = (size_t)(BK * 2);
    const size_t hstep = (size_t)HALF * K * 2;
    const size_t tstep = 2 * hstep;
    const unsigned ldsw = (unsigned)wid * 1024u;
    const int aoff = lds_byte(wr * 64 + fr, fq * 8), boff = lds_byte(wc * 32 + fr, fq * 8);
#define PG8_SA(b, h) (((b) * 2 + (h)) * HTB)
#define PG8_SB(b, h) ((4 + (b) * 2 + (h)) * HTB)
#define PG8_STAGE(bufoff, gbase, voff) do { _Pragma("unroll") for (int _i = 0; _i < 2; ++_i) { unsigned vo_ = (voff); asm volatile("" : "+v"(vo_));     \
        __builtin_amdgcn_global_load_lds((const unsigned*)((const char*)(gbase) + (size_t)_i * 64 * rowb + vo_), (PG8_LAS unsigned*)(lds + (bufoff) + ldsw + _i * 8192), 16, 0, 0); } } while (0)
#define PG8_LDA(dst, b, h) do { _Pragma("unroll") for (int m = 0; m < 4; ++m) _Pragma("unroll") for (int k = 0; k < 2; ++k) dst[m][k] = *(const PG8_LAS bf16x8*)(lds + PG8_SA(b, h) + aoff + m * 2048 + k * 1024); } while (0)
#define PG8_LDB(dst, b, h) do { _Pragma("unroll") for (int n = 0; n < 2; ++n) _Pragma("unroll") for (int k = 0; k < 2; ++k) dst[n][k] = *(const PG8_LAS bf16x8*)(lds + PG8_SB(b, h) + boff + n * 2048 + k * 1024); } while (0)
#define PG8_MMA(ai, bj, At, Bt) do { __builtin_amdgcn_s_setprio(1); if constexpr (F8) { _Pragma("unroll") for (int m = 0; m < 4; ++m) _Pragma("unroll") for (int n = 0; n < 2; ++n) \
        acc[ai][bj][m][n] = __builtin_amdgcn_mfma_scale_f32_16x16x128_f8f6f4(pg8_cat(Bt[n][0], Bt[n][1]), pg8_cat(At[m][0], At[m][1]), acc[ai][bj][m][n], 0, 0, 0, PG8_F8_SCALE, 0, PG8_F8_SCALE); } \
        else { _Pragma("unroll") for (int m = 0; m < 4; ++m) _Pragma("unroll") for (int n = 0; n < 2; ++n) _Pragma("unroll") for (int k = 0; k < 2; ++k) \
        acc[ai][bj][m][n] = __builtin_amdgcn_mfma_f32_16x16x32_bf16(Bt[n][k], At[m][k], acc[ai][bj][m][n], 0, 0, 0); } __builtin_amdgcn_s_setprio(0); } while (0)
#define PG8_WAIT_V(n) asm volatile("s_waitcnt vmcnt(" #n ")" ::: "memory")
#define PG8_WAIT_L(n) asm volatile("s_waitcnt lgkmcnt(" #n ")" ::: "memory")
#define PG8_BAR __builtin_amdgcn_s_barrier()
#define PG8_SCHED __builtin_amdgcn_sched_barrier(0)
    Unit cur, nxt; int ui = 0;
    if (!S.next(0, cur)) return;
    f32x4 acc[2][2][4][2];
#pragma unroll
    for (int a = 0; a < 2; ++a)
#pragma unroll
        for (int b = 0; b < 2; ++b)
#pragma unroll
            for (int m = 0; m < 4; ++m)
#pragma unroll
                for (int n = 0; n < 2; ++n) acc[a][b][m][n] = (f32x4){0.f, 0.f, 0.f, 0.f};
    bf16x8 At[4][2], B0[2][2], B1[2][2];
    const char* cA = (const char*)g.A + (size_t)cur.pm * tstep; const char* cB = (const char*)g.Bt + (size_t)cur.e * g.estride + (size_t)cur.pn * tstep;
    S.a_ready(cur);
    int par = 0;
    PG8_LAS float* const etab = (PG8_LAS float*)(lds + STAGE_BYTES + 4096 + 2048);
    if constexpr (Epi::STAGED) { etab[tid] = E.stage(cur, tid); if constexpr (!GATHER) { PG8_WAIT_L(0); PG8_BAR; } }
    if constexpr (GATHER) { if (tid < 256) { unsigned po_ = (unsigned)(cur.pm * 256 + tid) * 4u; asm volatile("" : "+v"(po_)); S.ptab[tid] = *(const __attribute__((address_space(1))) int*)((const char*)S.perm + po_); } PG8_WAIT_L(0); PG8_BAR; }
    if constexpr (SP2) {
        PG8_STAGE(PG8_SB(0, 0), cB, voffB); PG8_STAGE(PG8_SB(0, 1), cB + hstep, voffB); PG8_STAGE_A(PG8_SA(0, 0), cA, (size_t)0, 0, par); PG8_STAGE_A(PG8_SA(0, 1), cA + hstep, (size_t)0, 1, par);
        if (wr == 1) PG8_BAR;
        PG8_WAIT_V(2); PG8_BAR;
        PG8_STAGE(PG8_SB(1, 0), cB + kstep, voffB); PG8_STAGE_A(PG8_SA(1, 0), cA + kstep, kstep, 0, par); PG8_STAGE(PG8_SB(1, 1), cB + hstep + kstep, voffB);
        PG8_WAIT_V(6); PG8_BAR;
    } else {
        PG8_STAGE(PG8_SB(0, 0), cB, voffB); PG8_STAGE_A(PG8_SA(0, 0), cA, (size_t)0, 0, par); PG8_STAGE(PG8_SB(0, 1), cB + hstep, voffB); PG8_STAGE_A(PG8_SA(0, 1), cA + hstep, (size_t)0, 1, par);
        if (wr == 1) PG8_BAR;
        PG8_WAIT_V(4); PG8_BAR;
        PG8_STAGE(PG8_SB(1, 0), cB + kstep, voffB); PG8_STAGE_A(PG8_SA(1, 0), cA + kstep, kstep, 0, par); PG8_STAGE(PG8_SB(1, 1), cB + hstep + kstep, voffB);
        PG8_WAIT_V(6); PG8_BAR;
    }
    for (;;) {
        const bool has_next = S.next(ui + 1, nxt);
        const char* nA = has_next ? (const char*)g.A + (size_t)nxt.pm * tstep : cA; const char* nB = has_next ? (const char*)g.Bt + (size_t)nxt.e * g.estride + (size_t)nxt.pn * tstep : cB;
        int pv = 0; if constexpr (GATHER) { if (has_next) { unsigned po_ = (unsigned)(nxt.pm * 256 + (tid & 255)) * 4u; asm volatile("" : "+v"(po_)); const int* pa_ = (const int*)((const char*)S.perm + po_); asm volatile("global_load_dword %0, %1, off" : "+v"(pv) : "v"(pa_) : "memory"); } }
        const int npar = has_next ? (par ^ 1) : par;
        float ev = 0.f; if constexpr (Epi::STAGED) { if (has_next) { const float* ea_ = E.stage_addr(nxt, tid); asm volatile("global_load_dword %0, %1, off" : "+v"(ev) : "v"(ea_) : "memory"); } }
#pragma unroll 1
        for (int t = 0; t < nt; t += 2) {
            const bool last = (t == nt - 2);
            if constexpr (GATHER) { if (t == 2 && has_next) { int tl_ = tid; asm volatile("" : "+v"(tl_)); if (tl_ < 256) S.ptab[(par ^ 1) * 256 + tl_] = pv; } }
            if constexpr (Epi::STAGED) { if (t == 2 && has_next) { int tl_ = tid; asm volatile("" : "+v"(tl_)); etab[(par ^ 1) * 512 + tl_] = ev; } }
            const size_t k2 = last ? (size_t)0 : (size_t)(t + 2) * kstep; const int p2 = last ? npar : par;
            const char* a1 = cA + (size_t)(t + 1) * kstep;
            const char* a2 = last ? nA : cA + (size_t)(t + 2) * kstep; const char* b2 = last ? nB : cB + (size_t)(t + 2) * kstep;
            const char* a3 = a2 + kstep; const char* b3 = b2 + kstep;
            if (last && has_next) S.a_ready(nxt);
            if constexpr (SP2) {
            { PG8_GA_RD(1, par); PG8_LDB(B0, 0, 0); PG8_LDB(B1, 0, 1); PG8_SCHED; PG8_LDA(At, 0, 0); PG8_STAGE_A2(PG8_SA(1, 1), a1 + hstep, (size_t)(t + 1) * kstep); }
            PG8_WAIT_V(8); PG8_WAIT_L(0); PG8_BAR; PG8_MMA(0, 0, At, B0); PG8_MMA(0, 1, At, B1); PG8_BAR; PG8_SCHED;
            { PG8_GA_RD(0, p2); PG8_LDA(At, 0, 1); PG8_STAGE(PG8_SB(0, 0), b2, voffB); PG8_STAGE(PG8_SB(0, 1), b2 + hstep, voffB); PG8_STAGE_A2(PG8_SA(0, 0), a2, k2); }
            PG8_WAIT_V(8); PG8_WAIT_L(0); PG8_BAR; PG8_MMA(1, 0, At, B0); PG8_MMA(1, 1, At, B1); PG8_BAR; PG8_SCHED;
            { PG8_GA_RD(1, p2); PG8_LDB(B0, 1, 0); PG8_LDB(B1, 1, 1); PG8_SCHED; PG8_LDA(At, 1, 0); PG8_STAGE_A2(PG8_SA(0, 1), a2 + hstep, k2); }
            PG8_WAIT_V(8); PG8_WAIT_L(0); PG8_BAR; PG8_MMA(0, 0, At, B0); PG8_MMA(0, 1, At, B1); PG8_BAR; PG8_SCHED;
            { PG8_GA_RD(0, p2); PG8_LDA(At, 1, 1); PG8_STAGE(PG8_SB(1, 0), b3, voffB); PG8_STAGE(PG8_SB(1, 1), b3 + hstep, voffB); PG8_STAGE_A2(PG8_SA(1, 0), a3, k2 + kstep); }
            PG8_WAIT_V(8); PG8_WAIT_L(0); PG8_BAR; PG8_MMA(1, 0, At, B0); PG8_MMA(1, 1, At, B1); PG8_BAR; PG8_SCHED;
            } else {
            { PG8_GA_RD(1, par); PG8_LDB(B0, 0, 0); PG8_SCHED; PG8_LDA(At, 0, 0); PG8_STAGE_A2(PG8_SA(1, 1), a1 + hstep, (size_t)(t + 1) * kstep); }
            PG8_WAIT_L(8); PG8_BAR; PG8_WAIT_L(0); PG8_MMA(0, 0, At, B0); PG8_BAR; PG8_SCHED;
            PG8_LDB(B1, 0, 1); PG8_STAGE(PG8_SB(0, 0), b2, voffB);
            PG8_BAR; PG8_WAIT_L(0); PG8_MMA(0, 1, At, B1); PG8_BAR;
            { PG8_GA_RD(0, p2); PG8_LDA(At, 0, 1); PG8_STAGE_A2(PG8_SA(0, 0), a2, k2); }
            PG8_BAR; PG8_WAIT_L(0); PG8_MMA(1, 0, At, B0); PG8_BAR; PG8_SCHED;
            PG8_STAGE(PG8_SB(0, 1), b2 + hstep, voffB);
            PG8_WAIT_V(6); PG8_BAR; PG8_MMA(1, 1, At, B1); PG8_BAR;
            { PG8_GA_RD(1, p2); PG8_LDB(B0, 1, 0); PG8_SCHED; PG8_LDA(At, 1, 0); PG8_STAGE_A2(PG8_SA(0, 1), a2 + hstep, k2); }
            PG8_WAIT_L(8); PG8_BAR; PG8_WAIT_L(0); PG8_MMA(0, 0, At, B0); PG8_BAR; PG8_SCHED;
            PG8_LDB(B1, 1, 1); PG8_STAGE(PG8_SB(1, 0), b3, voffB);
            PG8_BAR; PG8_WAIT_L(0); PG8_MMA(0, 1, At, B1); PG8_BAR;
            { PG8_GA_RD(0, p2); PG8_LDA(At, 1, 1); PG8_STAGE_A2(PG8_SA(1, 0), a3, k2 + kstep); }
            PG8_BAR; PG8_WAIT_L(0); PG8_MMA(1, 0, At, B0); PG8_BAR; PG8_SCHED;
            PG8_STAGE(PG8_SB(1, 1), b3 + hstep, voffB);
            PG8_WAIT_V(6); PG8_BAR; PG8_MMA(1, 1, At, B1); PG8_BAR;
            }
        }
        if constexpr (ALIGN_EPI) { if (wr == 0) PG8_BAR; }
        if constexpr (!Epi::AFTER_DRAIN) { int tl_ = tid; asm volatile("" : "+v"(tl_)); const int ln_ = tl_ & 63;
            if constexpr (Epi::STAGED) E(acc, cur, wr, wc, ln_ & 15, ln_ >> 4, etab + par * 512); else E(acc, cur, wr, wc, ln_ & 15, ln_ >> 4);
#ifdef DBG_EPI2
            if constexpr (F8 && Sched::GATHER) { asm volatile("" : "+v"(tl_)); const int l2_ = tl_ & 63; E(acc, cur, wr, wc, l2_ & 15, l2_ >> 4, etab + par * 512); }
#endif
#ifdef DBG_EPI2Y
            if constexpr (F8 && !Sched::GATHER && !SP2) { asm volatile("" : "+v"(tl_)); const int l2_ = tl_ & 63; E(acc, cur, wr, wc, l2_ & 15, l2_ >> 4, etab + par * 512); }
#endif
            S.done(cur); }
        if (!has_next) break;
#pragma unroll
        for (int a = 0; a < 2; ++a)
#pragma unroll
            for (int b = 0; b < 2; ++b)
#pragma unroll
                for (int m = 0; m < 4; ++m)
#pragma unroll
                    for (int n = 0; n < 2; ++n) acc[a][b][m][n] = (f32x4){0.f, 0.f, 0.f, 0.f};
        cur = nxt; cA = nA; cB = nB; ++ui; par = npar;
        if constexpr (ALIGN_EPI) { if (wr == 1) PG8_BAR; }
    }
    PG8_WAIT_V(0);
    if constexpr (!ALIGN_EPI) { if (wr == 0) PG8_BAR; }
    PG8_BAR;
    if constexpr (Epi::AFTER_DRAIN) { E.fused(acc, cur, wr, wc, fr, fq, lds, wid, lane); S.done(cur); }
#undef PG8_SA
#undef PG8_SB
#undef PG8_STAGE
#undef PG8_GA
#undef PG8_GA_RD
#undef PG8_GA_IS
#undef PG8_STAGE_A2
#undef PG8_STAGE_A
#undef PG8_LDA
#undef PG8_LDB
#undef PG8_MMA
#undef PG8_WAIT_V
#undef PG8_WAIT_L
#undef PG8_BAR
#undef PG8_SCHED
}
}
namespace attn_body {
using bf16=__hip_bfloat16;
using bf16x8=__attribute__((ext_vector_type(8)))short;
using s16x4=__attribute__((ext_vector_type(4)))short;
using f32x16=__attribute__((ext_vector_type(16)))float;
using u32x4=__attribute__((ext_vector_type(4)))unsigned;
constexpr int BATCH=32,NHEAD=8,NGRP=4,SEQ=2048,D=64;
constexpr int PQ=512,PK=128,PV=128,PO=1024;
constexpr float ATTN_OSCALE=16.f;
constexpr int NW=8,QBLK=32,QB=QBLK*NW,KVBLK=64,NQB=SEQ/QB;
constexpr int ATTN_UNIT_ROWS=QB;
__device__ __forceinline__ int crow(int r,int hi){return (r&3)+8*(r>>2)+4*hi;}
#define SBAR() __builtin_amdgcn_sched_barrier(0)
__device__ __forceinline__ void cmask(f32x16&p0,f32x16&p1,int jb,int qrel,int hi){
  const float NEG=-INFINITY; int kb=64*jb+4*hi;
  #pragma unroll
  for(int r=0;r<16;++r){int kv=kb+(r&3)+8*(r>>2); if(kv>qrel)p0[r]=NEG; if(kv+32>qrel)p1[r]=NEG;}
}

constexpr int NSLOT=3, SLOTB=8192;
constexpr int LDS_K=0, LDS_V=NSLOT*SLOTB, LDS_WS=2*NSLOT*SLOTB, LDS_OST=LDS_WS+NW*64*4, LDS_BYTES=LDS_OST+NW*4096;
constexpr float C2=0.125f*1.4426950408889634f;
__device__ __forceinline__ void glds16(const void*gsrc,unsigned lds_dst){unsigned keep;
  asm volatile("s_mov_b32 %0, m0\n\ts_mov_b32 m0, %2\n\ts_nop 0\n\tglobal_load_lds_dwordx4 %1, off\n\ts_mov_b32 m0, %0":"=&s"(keep):"v"(gsrc),"s"(lds_dst):"memory");}
__device__ __forceinline__ float max3f(float a,float b,float c){float r;asm("v_max3_f32 %0, %1, %2, %3":"=v"(r):"v"(a),"v"(b),"v"(c));return r;}
__device__ __forceinline__ float max2f(float a,float b){float r;asm("v_max_f32_e32 %0, %1, %2":"=v"(r):"v"(a),"v"(b));return r;}
__device__ __forceinline__ float fadd_s(float a,float b){float r;asm("v_add_f32_e32 %0, %1, %2":"=v"(r):"v"(a),"v"(b));return r;}
__device__ __forceinline__ float fsub_s(float a,float b){float r;asm("v_sub_f32_e32 %0, %1, %2":"=v"(r):"v"(a),"v"(b));return r;}
typedef float f32x2_t __attribute__((ext_vector_type(2))); typedef __bf16 bf16x2_t __attribute__((ext_vector_type(2)));
__device__ __forceinline__ unsigned cvtpk_s(float lo,float hi){f32x2_t v={lo,hi};bf16x2_t b=__builtin_convertvector(v,bf16x2_t);return __builtin_bit_cast(unsigned,b);}
#define WAIT_BAR(N) asm volatile("s_waitcnt vmcnt(" #N ") lgkmcnt(0)\n\ts_barrier":::"memory")

__device__ __forceinline__ void qkt(f32x16&p0,f32x16&p1,const char*Kslot,const bf16x8*qr,const f32x16&negm,int r32,int hi){
  const char*kb=Kslot+hi*1024+r32*16;
  #pragma unroll
  for(int d0=0;d0<4;++d0){
    const bf16x8 b0=*reinterpret_cast<const bf16x8*>(kb+d0*2048);
    const bf16x8 b1=*reinterpret_cast<const bf16x8*>(kb+d0*2048+512);
    if(d0==0){p0=__builtin_amdgcn_mfma_f32_32x32x16_bf16(b0,qr[0],negm,0,0,0);p1=__builtin_amdgcn_mfma_f32_32x32x16_bf16(b1,qr[0],negm,0,0,0);}
    else{p0=__builtin_amdgcn_mfma_f32_32x32x16_bf16(b0,qr[d0],p0,0,0,0);p1=__builtin_amdgcn_mfma_f32_32x32x16_bf16(b1,qr[d0],p1,0,0,0);}}
}
typedef __attribute__((address_space(3))) const char* lds_cptr;
typedef short v4i16_t __attribute__((ext_vector_type(4)));
__device__ __forceinline__ void kload8(bf16x8*kf,lds_cptr kp){
  kf[0]=*(const __attribute__((address_space(3))) bf16x8*)(kp);      kf[1]=*(const __attribute__((address_space(3))) bf16x8*)(kp+512);
  kf[2]=*(const __attribute__((address_space(3))) bf16x8*)(kp+2048); kf[3]=*(const __attribute__((address_space(3))) bf16x8*)(kp+2560);
  kf[4]=*(const __attribute__((address_space(3))) bf16x8*)(kp+4096); kf[5]=*(const __attribute__((address_space(3))) bf16x8*)(kp+4608);
  kf[6]=*(const __attribute__((address_space(3))) bf16x8*)(kp+6144); kf[7]=*(const __attribute__((address_space(3))) bf16x8*)(kp+6656);
}
__device__ __forceinline__ void kload2(bf16x8*kf,lds_cptr kp,int j){ kf[2*j]=*(const __attribute__((address_space(3))) bf16x8*)(kp+j*2048); kf[2*j+1]=*(const __attribute__((address_space(3))) bf16x8*)(kp+j*2048+512); }
__device__ __forceinline__ s16x4 vtr(lds_cptr p){ return __builtin_bit_cast(s16x4,__builtin_amdgcn_ds_read_tr16_b64_v4i16((__attribute__((address_space(3))) v4i16_t*)p)); }
__device__ __forceinline__ float rowmax(const f32x16&p0,const f32x16&p1){
  float a=max3f(p0[0],p0[1],p1[0]),b=max3f(p0[2],p0[3],p1[1]);a=max3f(a,p1[2],p1[3]);
  #pragma unroll
  for(int r=4;r<16;r+=4){a=max3f(a,p0[r],p0[r+1]);b=max3f(b,p0[r+2],p0[r+3]);a=max3f(a,p1[r],p1[r+1]);b=max3f(b,p1[r+2],p1[r+3]);}
  const float m=max2f(a,b);
  auto rr=__builtin_amdgcn_permlane32_swap(__float_as_uint(m),__float_as_uint(m),false,false);
  return max2f(__uint_as_float(rr[0]),__uint_as_float(rr[1]));
}
__device__ __forceinline__ void pv(f32x16*o,int vb,bf16x8 pa0,bf16x8 pa1,bf16x8 pa2,bf16x8 pa3){
  #pragma unroll
  for(int d0=0;d0<2;++d0){s16x4 lo[4],hi[4];
    #pragma unroll
    for(int ks=0;ks<4;++ks){
      asm volatile("ds_read_b64_tr_b16 %0,%1 offset:%c2":"=&v"(lo[ks]):"v"(vb),"i"(d0*4096+ks*1024):"memory");
      asm volatile("ds_read_b64_tr_b16 %0,%1 offset:%c2":"=&v"(hi[ks]):"v"(vb),"i"(d0*4096+ks*1024+512):"memory");}
    asm volatile("s_waitcnt lgkmcnt(0)":::"memory");SBAR();
    #define PK(k) (bf16x8){lo[k][0],lo[k][1],lo[k][2],lo[k][3],hi[k][0],hi[k][1],hi[k][2],hi[k][3]}
    o[d0]=__builtin_amdgcn_mfma_f32_32x32x16_bf16(pa0,PK(0),o[d0],0,0,0);
    o[d0]=__builtin_amdgcn_mfma_f32_32x32x16_bf16(pa1,PK(1),o[d0],0,0,0);
    o[d0]=__builtin_amdgcn_mfma_f32_32x32x16_bf16(pa2,PK(2),o[d0],0,0,0);
    o[d0]=__builtin_amdgcn_mfma_f32_32x32x16_bf16(pa3,PK(3),o[d0],0,0,0);
    #undef PK
  }
}

#ifndef ATTN_STORE16
#define ATTN_STORE16(p,v) (*(u32x4*)(p)=(v))
#endif
template<int THRL,bool FIXED> __device__ __forceinline__ void attn_unit(int b,int h,int qb,const bf16*Q,const bf16*__restrict__ K,const bf16*__restrict__ V,bf16*O,char*shm,const int tid_in,const float mfix){
  int tid_=tid_in; asm volatile("":"+v"(tid_)); const int tid=tid_,lane=tid&63,r32=lane&31,hi=lane>>5; const int wid=__builtin_amdgcn_readfirstlane(tid>>6);
  const long rowbase=(long)b*SEQ; const int q0=qb*QB;
  const bf16*Qw=Q+(rowbase+q0+wid*QBLK)*PQ+h*D;
  const bf16*Kh=K+rowbase*PK+(h/NGRP)*D,*Vh=V+rowbase*PV+(h/NGRP)*D;
  const unsigned lds0=(unsigned)(uintptr_t)shm;
  float*wsf=(float*)(shm+LDS_WS)+wid*64;
  const bf16*ksrc=Kh+(long)lane*PK+wid*8;
  const bf16*vsrc=Vh+(long)(16*(wid&3)+(lane>>2))*PV+(wid>>2)*32+(lane&3)*8;
  const unsigned kdst=lds0+LDS_K+wid*1024, vdst=lds0+LDS_V+wid*1024;
  #define DMA_K(t,slot) glds16(ksrc+(long)(t)*KVBLK*PK,(unsigned)__builtin_amdgcn_readfirstlane(kdst+(slot)))
  #define DMA_V(t,slot) glds16(vsrc+(long)(t)*KVBLK*PV,(unsigned)__builtin_amdgcn_readfirstlane(vdst+(slot)))
  const int vb0=(int)(lds0+LDS_V)+((lane>>4)&1)*32+(lane&3)*8+(4*hi+((lane&15)>>2))*64;
  const char*Kbase=shm+LDS_K; bf16x8 kf[8];
  const lds_cptr shm3=(lds_cptr)shm; const lds_cptr kp0=shm3+LDS_K+hi*1024+r32*16; const lds_cptr vp0=shm3+LDS_V+((lane>>4)&1)*32+(lane&3)*8+(4*hi+((lane&15)>>2))*64;
  constexpr int NT=SEQ/KVBLK;
  DMA_K(0,0);DMA_V(0,0);DMA_K(1,SLOTB);
  bf16x8 qr[4];
  #pragma unroll
  for(int d0=0;d0<4;++d0)qr[d0]=*(const __attribute__((address_space(1))) bf16x8*)(&Qw[(long)r32*PQ+d0*16+hi*8]);
  float mhat=0.f,l_reg=0.f;f32x16 o[2];o[0]=f32x16{};o[1]=f32x16{};f32x16 negm=f32x16{}; if constexpr(FIXED){ _Pragma("unroll") for(int r=0;r<16;++r)negm[r]=-mfix; } asm volatile("":"+v"(negm));
  #define CMASK(P0,P1,t) do{}while(0)
  bool resc=false;
  #define START(P0,P1) do{ if constexpr(!FIXED){ const float rm=rowmax(P0,P1); resc=false; \
    { const float dl=rm; mhat=fadd_s(mhat,dl); \
      _Pragma("unroll") for(int r=0;r<16;++r){P0[r]=fsub_s(P0[r],dl);P1[r]=fsub_s(P1[r],dl);} \
      _Pragma("unroll") for(int r=0;r<16;++r)negm[r]=-mhat; asm volatile("":"+v"(negm)); } } \
    _Pragma("unroll") for(int r=0;r<16;++r)P0[r]=__builtin_amdgcn_exp2f(P0[r]); }while(0)
  #define RESC() do{ if(resc){ asm volatile("s_waitcnt lgkmcnt(0)":::"memory"); \
      _Pragma("unroll") for(int d_=0;d_<2;++d_) _Pragma("unroll") for(int r=0;r<16;++r)o[d_][r]*=wsf[crow(r,hi)]; } }while(0)
  f32x16 pA0,pA1,pB0,pB1;
  int sl_prev=0,sl_cur=0,sl_next=SLOTB;
  #define ROT() do{sl_prev=sl_cur;sl_cur=sl_next;sl_next=(sl_next==(NSLOT-1)*SLOTB)?0:sl_next+SLOTB;}while(0)
  DMA_K(2,2*SLOTB);
  WAIT_BAR(3);
  qkt(pA0,pA1,Kbase,qr,negm,r32,hi);asm volatile("s_nop 15\n\ts_nop 7":"+v"(pA0),"+v"(pA1));CMASK(pA0,pA1,0);
  START(pA0,pA1);
  _Pragma("unroll") for(int r=0;r<16;++r)pA1[r]=__builtin_amdgcn_exp2f(pA1[r]);
  WAIT_BAR(0);
  DMA_K(3,0);DMA_V(1,SLOTB);
  ROT();
  kload8(kf,kp0+sl_cur);
  WAIT_BAR(2);
  s16x4 vlo[8],vhi[8]; u32x4 pw0,pw1,pw2,pw3;
  #define PKW(P,B) cvtpk_s(P[B],P[B+1])
  #define PAF(k) __builtin_bit_cast(bf16x8,pw##k)
  #define VFR(i) (bf16x8){vlo[i][0],vlo[i][1],vlo[i][2],vlo[i][3],vhi[i][0],vhi[i][1],vhi[i][2],vhi[i][3]}
  #define PIN(x) asm volatile("":"+v"(x))
  #define MX3(a,b,c) __builtin_fmaxf(__builtin_fmaxf((a),(b)),(c))
  #define GAPA(MF,A0,A1,A2,A3,W0,W1,PW) do{ MF; sacc+=A0; sacc+=A1; sacc+=A2; sacc+=A3; PIN(sacc); W0; W1; PIN(PW); SBAR(); }while(0)
  #define EX(v) __builtin_amdgcn_exp2f(v)
  #define GAPB(MF,X,B) do{ MF; X[B]=EX(X[B]); X[B+1]=EX(X[B+1]); X[B+2]=EX(X[B+2]); X[B+3]=EX(X[B+3]); PIN(X); SBAR(); }while(0)
  #define VRD(i) do{ vlo[i]=vtr(vp_+(((i)>>2)*4096+((i)&3)*1024)); vhi[i]=vtr(vp_+(((i)>>2)*4096+((i)&3)*1024+512)); }while(0)
  #define KRD(G,j) do{ if(G){ kload2(kf,kp0+sl_next,j); SBAR(); } }while(0)
  #define STEP(C0,C1,P0,P1,t,GK,GV,GL) do{ SBAR(); \
    const lds_cptr vp_=vp0+sl_prev; \
    VRD(0); SBAR(); float sacc=(P0[0]+P0[1]); \
    GAPA(C0=__builtin_amdgcn_mfma_f32_32x32x16_bf16(kf[0],qr[0],negm,0,0,0), P0[2],P0[3],P0[4],P0[5],     pw0[0]=PKW(P0,0), pw0[1]=PKW(P0,2), pw0); \
    VRD(4); SBAR(); GAPA(C1=__builtin_amdgcn_mfma_f32_32x32x16_bf16(kf[1],qr[0],negm,0,0,0), P0[6],P0[7],P0[8],P0[9],     pw0[2]=PKW(P0,4), pw0[3]=PKW(P0,6), pw0); \
    VRD(1); SBAR(); GAPA(C0=__builtin_amdgcn_mfma_f32_32x32x16_bf16(kf[2],qr[1],C0,0,0,0),   P0[10],P0[11],P0[12],P0[13], pw1[0]=PKW(P0,8), pw1[1]=PKW(P0,10), pw1); \
    VRD(5); SBAR(); GAPA(C1=__builtin_amdgcn_mfma_f32_32x32x16_bf16(kf[3],qr[1],C1,0,0,0),   P0[14],P0[15],P1[0],P1[1],   pw1[2]=PKW(P0,12),pw1[3]=PKW(P0,14), pw1); \
    VRD(2); SBAR(); GAPA(C0=__builtin_amdgcn_mfma_f32_32x32x16_bf16(kf[4],qr[2],C0,0,0,0),   P1[2],P1[3],P1[4],P1[5],     pw2[0]=PKW(P1,0), pw2[1]=PKW(P1,2), pw2); \
    VRD(6); SBAR(); GAPA(C1=__builtin_amdgcn_mfma_f32_32x32x16_bf16(kf[5],qr[2],C1,0,0,0),   P1[6],P1[7],P1[8],P1[9],     pw2[2]=PKW(P1,4), pw2[3]=PKW(P1,6), pw2); \
    VRD(3); SBAR(); GAPA(C0=__builtin_amdgcn_mfma_f32_32x32x16_bf16(kf[6],qr[3],C0,0,0,0),   P1[10],P1[11],P1[12],P1[13], pw3[0]=PKW(P1,8), pw3[1]=PKW(P1,10), pw3); \
    VRD(7); SBAR(); GAPA(C1=__builtin_amdgcn_mfma_f32_32x32x16_bf16(kf[7],qr[3],C1,0,0,0),   P1[14],P1[15],0.f,0.f,       pw3[2]=PKW(P1,12),pw3[3]=PKW(P1,14), pw3); \
    l_reg+=sacc; \
    if(GK){DMA_K((t)+3,sl_cur);} if(GV){DMA_V((t)+1,sl_next);} \
    CMASK(C0,C1,t); \
    if constexpr(!FIXED){ float a=MX3(C0[0],C0[1],C1[0]),b=MX3(C0[2],C0[3],C1[1]); a=MX3(a,C1[2],C1[3]); \
      _Pragma("unroll") for(int r=4;r<16;r+=4){a=MX3(a,C0[r],C0[r+1]);b=MX3(b,C0[r+2],C0[r+3]);a=MX3(a,C1[r],C1[r+1]);b=MX3(b,C1[r+2],C1[r+3]);} \
      float rm=__builtin_fmaxf(a,b); { auto rr=__builtin_amdgcn_permlane32_swap(__float_as_uint(rm),__float_as_uint(rm),false,false); rm=__builtin_fmaxf(__uint_as_float(rr[0]),__uint_as_float(rr[1])); } \
      resc=false; \
      if(__builtin_expect(__any(rm>(float)THRL),0)){ const float dl=__builtin_fmaxf(rm,0.f); mhat+=dl; \
        _Pragma("unroll") for(int r=0;r<16;++r){C0[r]-=dl;C1[r]-=dl;} \
        _Pragma("unroll") for(int r=0;r<16;++r)negm[r]=-mhat; asm volatile("":"+v"(negm)); \
        const float f=__builtin_amdgcn_exp2f(-dl); l_reg*=f; if(hi==0)wsf[r32]=f; resc=true; } } \
    SBAR(); \
    GAPB(o[0]=__builtin_amdgcn_mfma_f32_32x32x16_bf16(PAF(0),VFR(0),o[0],0,0,0), C0,0); \
    GAPB(o[1]=__builtin_amdgcn_mfma_f32_32x32x16_bf16(PAF(0),VFR(4),o[1],0,0,0), C0,4); \
    KRD(GL,0); GAPB(o[0]=__builtin_amdgcn_mfma_f32_32x32x16_bf16(PAF(1),VFR(1),o[0],0,0,0), C0,8); \
    KRD(GL,1); GAPB(o[1]=__builtin_amdgcn_mfma_f32_32x32x16_bf16(PAF(1),VFR(5),o[1],0,0,0), C0,12); \
    KRD(GL,2); GAPB(o[0]=__builtin_amdgcn_mfma_f32_32x32x16_bf16(PAF(2),VFR(2),o[0],0,0,0), C1,0); \
    KRD(GL,3); GAPB(o[1]=__builtin_amdgcn_mfma_f32_32x32x16_bf16(PAF(2),VFR(6),o[1],0,0,0), C1,4); \
    GAPB(o[0]=__builtin_amdgcn_mfma_f32_32x32x16_bf16(PAF(3),VFR(3),o[0],0,0,0), C1,8); \
    GAPB(o[1]=__builtin_amdgcn_mfma_f32_32x32x16_bf16(PAF(3),VFR(7),o[1],0,0,0), C1,12); \
    }while(0)
  int t=1;
  if(wid>=4)__builtin_amdgcn_s_setprio(1);
  #undef CMASK
  #define CMASK(P0,P1,t) do{}while(0)
  for(;t+5<NT;t+=2){
    STEP(pB0,pB1,pA0,pA1,t,true,true,true);     WAIT_BAR(2); RESC(); ROT();
    STEP(pA0,pA1,pB0,pB1,t+1,true,true,true);   WAIT_BAR(2); RESC(); ROT();
  }
  #undef CMASK
  #define CMASK(P0,P1,t) do{}while(0)
  #define ENDW(tt) do{ if((tt)+3<NT){WAIT_BAR(2);} else if((tt)+2<NT){WAIT_BAR(1);} else {WAIT_BAR(0);} }while(0)
  for(;t+1<NT;t+=2){
    STEP(pB0,pB1,pA0,pA1,t,(t+3<NT),(t+1<NT),(t+1<NT));       ENDW(t);   RESC(); ROT();
    STEP(pA0,pA1,pB0,pB1,t+1,(t+4<NT),(t+2<NT),(t+2<NT));     ENDW(t+1); RESC(); ROT();
  }
  STEP(pB0,pB1,pA0,pA1,NT-1,false,false,false); RESC();
  { float sacc=pB0[0]+pB0[1]; _Pragma("unroll") for(int r=2;r<16;++r)sacc+=pB0[r]; _Pragma("unroll") for(int r=0;r<16;++r)sacc+=pB1[r]; l_reg+=sacc;
    pw0=(u32x4){PKW(pB0,0),PKW(pB0,2),PKW(pB0,4),PKW(pB0,6)};pw1=(u32x4){PKW(pB0,8),PKW(pB0,10),PKW(pB0,12),PKW(pB0,14)};pw2=(u32x4){PKW(pB1,0),PKW(pB1,2),PKW(pB1,4),PKW(pB1,6)};pw3=(u32x4){PKW(pB1,8),PKW(pB1,10),PKW(pB1,12),PKW(pB1,14)};
    SBAR(); pv(o,vb0+sl_cur,PAF(0),PAF(1),PAF(2),PAF(3)); }
  #undef PKW
  #undef PAF
  #undef VFR
  #undef PIN
  #undef MX3
  #undef GAPA
  #undef GAPB
  #undef EX
  #undef VRD
  #undef KRD
  #undef STEP
  #undef ENDW
  __builtin_amdgcn_s_setprio(0);
  {auto rr=__builtin_amdgcn_permlane32_swap(__float_as_uint(l_reg),__float_as_uint(l_reg),false,false);l_reg=__uint_as_float(rr[0])+__uint_as_float(rr[1]);}
  if(hi==0)wsf[32+r32]=l_reg;asm volatile("s_waitcnt lgkmcnt(0)":::"memory");
  float rli[16];
  #pragma unroll
  for(int r=0;r<16;++r)rli[r]=__builtin_amdgcn_rcpf(wsf[32+crow(r,hi)]);
  unsigned char*Ow=(unsigned char*)O+(rowbase+q0+wid*QBLK)*PO+h*D;
  { unsigned char*stg=(unsigned char*)(shm+LDS_OST)+wid*2048;
    #pragma unroll
    for(int r=0;r<16;++r){const int orow=crow(r,hi);
      #pragma unroll
      for(int d0=0;d0<2;++d0){ float ov=o[d0][r]*rli[r]*ATTN_OSCALE; ov=__builtin_amdgcn_fmed3f(ov,-448.f,448.f); stg[orow*64+d0*32+r32]=(unsigned char)__builtin_amdgcn_cvt_pk_fp8_f32(ov,ov,0,false);}}
    asm volatile("s_waitcnt lgkmcnt(0)":::"memory");
    #pragma unroll
    for(int i=0;i<2;++i){const int row=i*16+(lane>>2),ch=lane&3; const u32x4 v=*(const u32x4*)(stg+row*64+ch*16); ATTN_STORE16(Ow+(long)row*PO+ch*16,v);} }
  asm volatile("s_waitcnt lgkmcnt(0)\n\ts_barrier":::"memory");
  #undef DMA_K
  #undef DMA_V
  #undef CMASK
  #undef START
  #undef RESC
  #undef ROT
}
constexpr int ATTN_LDS_BYTES=LDS_BYTES;
struct AttnTensors { const bf16* Q; const bf16* K; const bf16* V; bf16* O; };
struct AttnUnit { int bh; int qb; };
struct StaticOrder {
  int vcu,G;
  __device__ __forceinline__ explicit StaticOrder(int grid,int block):vcu((grid%8==0)?(block%8)*(grid/8)+block/8:block),G(grid){}
  __device__ __forceinline__ bool next(int i,AttnUnit&u)const{ const int L=i*G+vcu; if(L>=BATCH*NHEAD*(SEQ/QB))return false; const int pair=L/32,j=L%32; const int b=pair/2,kvh=pair%2; u.bh=b*NHEAD+kvh*NGRP+(j>>3); u.qb=j&7; return true; }
  __device__ __forceinline__ void a_ready(const AttnUnit&)const{}
  __device__ __forceinline__ void done(const AttnUnit&)const{}
};
template<class Sched,bool FIXED,int THRL=8> __device__ __forceinline__ void attn_phase(char*lds,const AttnTensors&T,const Sched&S,const int tid_in,const int i0,const int i1,const float mfix){
  AttnUnit u;
  for(int i=i0;i<i1&&S.next(i,u);++i){ S.a_ready(u); attn_unit<THRL,FIXED>(u.bh/NHEAD,u.bh%NHEAD,u.qb,T.Q,T.K,T.V,T.O,lds,tid_in,mfix); S.done(u); }
}
#undef SBAR
#undef WAIT_BAR
}
#define XB_TMO      128
#define XB_XCNT(j)  (256  + 64 * (j))
#define XB_XSUB(j)  (1280 + 64 * (j))
#define XB_XGEN(j)  (2304 + 64 * (j))
#define XB_TOP      3328
#define XB_TOPGEN   3392
#define XCD_BAR_WORDS 3456
#define XB_SPIN_CAP (1u << 18)
constexpr int NWAVES = 8;
#ifndef MK_PER_PHASE
#define MK_PER_PHASE 0
#endif
constexpr int DM = 1024, NB = 32, SEQ = 2048, NTOK = NB * SEQ, DEPTH = 2;
constexpr int INW = 1792, COL_K = 512, COL_V = 640, COL_CA = 768, COL_CG = 1280, CC = 512;
constexpr int NE = 32, TOPK = 4, NK = NTOK * TOPK;
constexpr int PMAX = NK + NE * 256, TMAX = PMAX / 256;
constexpr float EPS = 1e-6f;
constexpr int NPH = 21;

constexpr size_t MiB = 1u << 20;
constexpr size_t WS_CTL = 0, CTL_ZERO_BYTES = 1 * MiB;
constexpr size_t WS_MOD = 1 * MiB;
constexpr size_t WS_ROPE = 3 * MiB;
constexpr size_t WS_WIN = 4 * MiB;
constexpr size_t WS_WOUT = 11 * MiB;
constexpr size_t WS_TOPK = 15 * MiB;
constexpr size_t WS_SLOT = 17 * MiB;
constexpr size_t WS_PGATE = 18 * MiB;
constexpr size_t WS_PERM = 20 * MiB;
constexpr size_t WS_IDENT = 22 * MiB;
constexpr size_t WS_W1 = 24 * MiB;
constexpr size_t WS_W2 = 152 * MiB;
constexpr size_t WS_X = 216 * MiB;
constexpr size_t WS_H = 472 * MiB;
constexpr size_t WS_U = 600 * MiB;
constexpr size_t WS_UU = WS_U;
constexpr size_t WS_Q = WS_U + 64 * MiB;
constexpr size_t WS_KN = WS_U + 128 * MiB;
constexpr size_t WS_V = WS_U + 144 * MiB;
constexpr size_t WS_MIX = WS_U + 160 * MiB;
constexpr size_t WS_Y = WS_U;
constexpr size_t WS_ACT = 1128 * MiB;
constexpr size_t WS_END = 1392 * MiB;
static_assert(WS_MIX + (size_t)NTOK * 1024 * 2 <= WS_ACT && WS_Y + (size_t)PMAX * 1024 * 2 <= WS_ACT && WS_ACT + (size_t)PMAX * 1024 <= WS_END && WS_PERM + (size_t)PMAX * 4 <= WS_W1, "d_ws map");
constexpr int CW_BAR = 4096;
constexpr int CW_CNT = 131072;
constexpr int RING_OFF = 0, RING_BYTES = 131072;
constexpr int LDSX_OFF = RING_BYTES;
constexpr int LX_MISC = LDSX_OFF, LX_TAB = LDSX_OFF + 512, LX_TILE = LDSX_OFF + 2048, LX_STG = LDSX_OFF + 4096;
constexpr int LDS_BYTES = 147456;

#define GAS __attribute__((address_space(1)))
#define LAS __attribute__((address_space(3)))
typedef unsigned short bf16;
typedef unsigned v4u __attribute__((ext_vector_type(4)));
typedef unsigned v2u __attribute__((ext_vector_type(2)));
typedef float f32x4 __attribute__((ext_vector_type(4)));
typedef GAS unsigned gu32;
#define RLX_AGENT __ATOMIC_RELAXED, __HIP_MEMORY_SCOPE_AGENT
#define LDS_WAIT() asm volatile("s_waitcnt lgkmcnt(0)" ::: "memory")
#define VM_WAIT() asm volatile("s_waitcnt vmcnt(0)" ::: "memory")
__device__ __forceinline__ unsigned f2bf(float f) { unsigned u = __builtin_bit_cast(unsigned, f); return (u + 0x7fffu + ((u >> 16) & 1u)) >> 16; }
__device__ __forceinline__ unsigned pk2(float lo, float hi) { return f2bf(lo) | (f2bf(hi) << 16); }
__device__ __forceinline__ float bflo(unsigned w) { return __builtin_bit_cast(float, w << 16); }
__device__ __forceinline__ float bfhi(unsigned w) { return __builtin_bit_cast(float, w & 0xffff0000u); }
__device__ __forceinline__ float shx(float v, int mask, int lane) { return __builtin_bit_cast(float, __builtin_amdgcn_ds_bpermute((lane ^ mask) << 2, __builtin_bit_cast(int, v))); }
__device__ __forceinline__ int shxi(int v, int mask, int lane) { return __builtin_amdgcn_ds_bpermute((lane ^ mask) << 2, v); }
#define DPPF(old, src, ctrl, rmask) __builtin_bit_cast(float, __builtin_amdgcn_update_dpp(__builtin_bit_cast(int, (float)(old)), __builtin_bit_cast(int, (float)(src)), (ctrl), (rmask), 0xF, false))
__device__ __forceinline__ float wave_sum_s(float v) {
    v += DPPF(0.f, v, 0xB1, 0xF); v += DPPF(0.f, v, 0x4E, 0xF); v += DPPF(0.f, v, 0x141, 0xF); v += DPPF(0.f, v, 0x140, 0xF);
    v += DPPF(0.f, v, 0x142, 0xA); v += DPPF(0.f, v, 0x143, 0xC);
    return __builtin_bit_cast(float, __builtin_amdgcn_readlane(__builtin_bit_cast(int, v), 63));
}
__device__ __forceinline__ float wave_max_s(float v) {
    v = __builtin_fmaxf(v, DPPF(v, v, 0xB1, 0xF)); v = __builtin_fmaxf(v, DPPF(v, v, 0x4E, 0xF)); v = __builtin_fmaxf(v, DPPF(v, v, 0x141, 0xF)); v = __builtin_fmaxf(v, DPPF(v, v, 0x140, 0xF));
    v = __builtin_fmaxf(v, DPPF(v, v, 0x142, 0xA)); v = __builtin_fmaxf(v, DPPF(v, v, 0x143, 0xC));
    return __builtin_bit_cast(float, __builtin_amdgcn_readlane(__builtin_bit_cast(int, v), 63));
}
__device__ __forceinline__ float wave_sum(float v, int lane) { (void)lane; return wave_sum_s(v); }
__device__ __forceinline__ unsigned xb_ld(unsigned* p)              { return __hip_atomic_load(p, __ATOMIC_RELAXED, __HIP_MEMORY_SCOPE_AGENT); }
__device__ __forceinline__ unsigned xb_add(unsigned* p, unsigned v) { return __hip_atomic_fetch_add(p, v, __ATOMIC_RELAXED, __HIP_MEMORY_SCOPE_AGENT); }
__device__ __forceinline__ unsigned xb_xcc_id() { return (unsigned)__builtin_amdgcn_s_getreg((3 << 11) | 20) & 0xFu; }
#define XB_SPIN(cond, bar) do { unsigned _sp = 0; while (cond) { __builtin_amdgcn_s_sleep(1); \
    if ((++_sp & 255u) == 0u) { if (xb_ld(&(bar)[XB_TMO])) break; if (_sp > XB_SPIN_CAP) { atomicAdd(&(bar)[XB_TMO], 1u); break; } } } } while (0)

struct XcdBarrier {
    unsigned* bar; unsigned x;
    unsigned wave;
    volatile LAS unsigned* st;
};

__device__ __forceinline__ bool xb_thread0(unsigned wave) { unsigned z_ = 0u; asm volatile("" : "+v"(z_)); return wave == 0u && __builtin_amdgcn_mbcnt_hi(~0u, __builtin_amdgcn_mbcnt_lo(~0u, z_)) == 0u; }
__device__ __forceinline__ XcdBarrier xcd_barrier_post(unsigned* bar, volatile LAS unsigned* st, unsigned wave) {
    XcdBarrier b; b.bar = bar; b.x = xb_xcc_id(); b.st = st; b.wave = wave;
    if (xb_thread0(wave)) (void)xb_add(&bar[XB_XCNT(b.x)], 1u);
    return b;
}
__device__ __forceinline__ void xcd_barrier_complete(unsigned* bar, unsigned x, unsigned& nloc, unsigned& nx) {
    const unsigned G = gridDim.x * gridDim.y * gridDim.z;
    unsigned sum, cnt, mine, sp = 0u;
    for (;;) {
        sum = 0u; cnt = 0u; mine = 0u;
#pragma unroll
        for (unsigned j = 0; j < 16; ++j) { const unsigned c = xb_ld(&bar[XB_XCNT(j)]); sum += c; cnt += (c > 0u) ? 1u : 0u; mine = (j == x) ? c : mine; }
        if (sum == G) break;
        __builtin_amdgcn_s_sleep(1);
        if ((++sp & 255u) == 0u) { if (xb_ld(&bar[XB_TMO])) break; if (sp > XB_SPIN_CAP) { atomicAdd(&bar[XB_TMO], 1u); break; } }
    }
    nloc = mine > 0u ? mine : 1u; nx = cnt > 0u ? cnt : 1u;
}

__device__ __forceinline__ void xcd_barrier(const XcdBarrier& b) {
    asm volatile("s_waitcnt vmcnt(0)" ::: "memory");
    __syncthreads();
    if (xb_thread0(b.wave)) {
        unsigned* bar = b.bar;
        __builtin_amdgcn_s_waitcnt(0);
        unsigned nloc = b.st[0], nx = b.st[1];
        if (nloc == 0u) { xcd_barrier_complete(bar, b.x, nloc, nx); b.st[0] = nloc; b.st[1] = nx; }
        const unsigned old = xb_add(&bar[XB_XSUB(b.x)], 1u);
        const unsigned gen = old / nloc;
        if (old + 1u == (gen + 1u) * nloc) {
            __builtin_amdgcn_fence(__ATOMIC_RELEASE, "agent");
            asm volatile("s_waitcnt vmcnt(0)" ::: "memory");
            const unsigned og = xb_add(&bar[XB_TOP], 1u);
            const unsigned tg = og / nx;
            if (og + 1u == (tg + 1u) * nx) xb_add(&bar[XB_TOPGEN], 1u);
            else XB_SPIN(xb_ld(&bar[XB_TOPGEN]) == tg, bar);
            __builtin_amdgcn_fence(__ATOMIC_ACQUIRE, "agent");
            xb_add(&bar[XB_XGEN(b.x)], 1u);
            asm volatile("s_waitcnt vmcnt(0)" ::: "memory");
        } else {
            XB_SPIN(xb_ld(&bar[XB_XGEN(b.x)]) == gen, bar);
            __builtin_amdgcn_fence(__ATOMIC_ACQUIRE, "agent");
            asm volatile("s_waitcnt vmcnt(0)" ::: "memory");
        }
    }
    __syncthreads();
}
struct Ctx { LAS unsigned char* lds; unsigned char* ws; gu32* ctl; int tid, lane, wave, vcu, G; };

template <bool INPROJ = false> __device__ __forceinline__ void transpose_item(const float* W, int K, int N, bf16* WT, int kb, int n0, int drow0, LAS float* scr, int lane) {
    const int k0 = 64 * kb;
    float ld_[32];
#pragma unroll
    for (int i = 0; i < 32; ++i) ld_[i] = W[(size_t)(k0 + 2 * i + (lane >> 5)) * N + n0 + (lane & 31)];
#pragma unroll
    for (int i = 0; i < 32; ++i) scr[(2 * i + (lane >> 5)) * 33 + (lane & 31)] = ld_[i];
    LDS_WAIT(); asm volatile("" ::: "memory");
    const int c = lane & 7;
#pragma unroll
    for (int j = 0; j < 4; ++j) { const int n = (lane >> 3) + 8 * j; const LAS float* s = scr + (8 * c) * 33 + n;
        v4u o; o.x = pk2(s[0 * 33], s[1 * 33]); o.y = pk2(s[2 * 33], s[3 * 33]); o.z = pk2(s[4 * 33], s[5 * 33]); o.w = pk2(s[6 * 33], s[7 * 33]);
        *(GAS v4u*)(WT + (size_t)(INPROJ ? pg8::inproj_row(n0 + n) : drow0 + n) * K + k0 + 8 * c) = o; }
    LDS_WAIT(); asm volatile("" ::: "memory");
}

template <bool INPROJ = false> __device__ __forceinline__ void transpose_item_f8(const float* W, int K, int N, unsigned char* WT, int kb, int n0, int drow0, LAS float* scr, int lane, float scale) {
    const int k0 = 64 * kb;
    float ld_[32];
#pragma unroll
    for (int i = 0; i < 32; ++i) ld_[i] = W[(size_t)(k0 + 2 * i + (lane >> 5)) * N + n0 + (lane & 31)];
#pragma unroll
    for (int i = 0; i < 32; ++i) scr[(2 * i + (lane >> 5)) * 33 + (lane & 31)] = ld_[i];
    LDS_WAIT(); asm volatile("" ::: "memory");
    const int c = lane & 7;
#pragma unroll
    for (int j = 0; j < 4; ++j) { const int n = (lane >> 3) + 8 * j; const LAS float* s = scr + (8 * c) * 33 + n;
        v2u o; o.x = pg8::pk4_fp8(s[0 * 33] * scale, s[1 * 33] * scale, s[2 * 33] * scale, s[3 * 33] * scale); o.y = pg8::pk4_fp8(s[4 * 33] * scale, s[5 * 33] * scale, s[6 * 33] * scale, s[7 * 33] * scale);
        *(GAS v2u*)(WT + (size_t)(INPROJ ? pg8::inproj_row(n0 + n) : drow0 + n) * K + k0 + 8 * c) = o; }
    LDS_WAIT(); asm volatile("" ::: "memory");
}

constexpr int I_CV_W1 = 64 * 1024, I_CV_W2 = 64 * 512, I_CV_IN = 2 * 896, I_CV_OUT = 2 * 512, I_CV_W1L = 32 * 1024, I_CV_W2L = 32 * 512;
__device__ __forceinline__ void p_convert(const Ctx& F, const float* w_in, const float* w_out, const float* w1, const float* w2, const int mode, const int l, const int count, const int widx_in, const int nw, const int first = 0) {
    LAS float* scr = (LAS float*)(F.lds + RING_OFF + F.wave * 16384);
    const int lane = F.lane; const int widx = __builtin_amdgcn_readfirstlane(widx_in);
    constexpr int I_W1 = I_CV_W1, I_W2 = I_CV_W2, I_IN = I_CV_IN;
    struct Item { const float* W; unsigned char* WT; int N, k0, n0, drow0; bool inproj; };
    auto decode = [&](int v) -> Item { Item r; int q = mode == 0 ? I_W1 + I_W2 + v : (v < I_CV_W1L ? l * I_CV_W1L + v : I_W1 + l * I_CV_W2L + (v - I_CV_W1L));
        if (q < I_W1) { const int m = q >> 10, qq = q & 1023, n0 = (qq & 63) * 32, half = n0 >> 10, nn = n0 & 1023;
            r.W = w1 + (size_t)m * 1024 * 2048; r.WT = (unsigned char*)(F.ws + WS_W1) + (size_t)m * 2048 * 1024; r.N = 2048; r.k0 = 64 * (qq >> 6); r.n0 = n0; r.drow0 = (nn >> 7) * 256 + half * 128 + (nn & 127); r.inproj = false; return r; }
        q -= I_W1;
        if (q < I_W2) { const int m = q >> 9, qq = q & 511, n0 = (qq & 31) * 32;
            r.W = w2 + (size_t)m * 1024 * 1024; r.WT = (unsigned char*)(F.ws + WS_W2) + (size_t)m * 1024 * 1024; r.N = 1024; r.k0 = 64 * (qq >> 5); r.n0 = n0; r.drow0 = n0; r.inproj = false; return r; }
        q -= I_W2;
        if (q < I_IN) { const int m = q / 896, qq = q % 896, n0 = (qq % 56) * 32;
            r.W = w_in + (size_t)m * 1024 * INW; r.WT = (unsigned char*)(F.ws + WS_WIN) + (size_t)m * INW * 1024; r.N = INW; r.k0 = 64 * (qq / 56); r.n0 = n0; r.drow0 = n0; r.inproj = true; return r; }
        q -= I_IN;
        { const int m = q >> 9, qq = q & 511, n0 = (qq & 31) * 32;
            r.W = w_out + (size_t)m * 1024 * 1024; r.WT = (unsigned char*)(F.ws + WS_WOUT) + (size_t)m * 1024 * 1024; r.N = 1024; r.k0 = 64 * (qq >> 5); r.n0 = n0; r.drow0 = n0; r.inproj = false; return r; } };
    float lda[32], ldb[32];
#define P0_LOAD(LD, I) do { int ll_ = lane; asm volatile("" : "+v"(ll_));     \
        const GAS float* wp_ = (const GAS float*)((I).W + (size_t)((I).k0 + (ll_ >> 5)) * (I).N + (I).n0 + (ll_ & 31)); _Pragma("unroll") for (int i = 0; i < 32; ++i) LD[i] = wp_[(size_t)(2 * i) * (I).N]; } while (0)
#define P0_PROC(LD, ME) do { _Pragma("unroll") for (int i = 0; i < 32; ++i) scr[(2 * i + (lane >> 5)) * 33 + (lane & 31)] = LD[i] * pg8::F8_SW; } while (0)
#define P0_STORE(ME) do { LDS_WAIT(); asm volatile("" ::: "memory"); const int c = lane & 7; \
        _Pragma("unroll") for (int j = 0; j < 4; ++j) { const int n = (lane >> 3) + 8 * j; const LAS float* s = scr + (8 * c) * 33 + n; \
            v2u o; o.x = pg8::pk4_fp8(s[0 * 33], s[1 * 33], s[2 * 33], s[3 * 33]); o.y = pg8::pk4_fp8(s[4 * 33], s[5 * 33], s[6 * 33], s[7 * 33]); \
            *(GAS v2u*)((ME).WT + (size_t)((ME).inproj ? pg8::inproj_row((ME).n0 + n) : (ME).drow0 + n) * 1024 + (ME).k0 + 8 * c) = o; } \
        LDS_WAIT(); asm volatile("" ::: "memory"); } while (0)
    const int vend = first + count;
    if (first + widx < vend) { const Item t_ = decode(first + widx); P0_LOAD(lda, t_); } if (first + widx + nw < vend) { const Item t_ = decode(first + widx + nw); P0_LOAD(ldb, t_); }
#pragma unroll 1
    for (int it = first + widx; it < vend; it += 2 * nw) {
        { P0_PROC(lda, 0); if (it + 2 * nw < vend) { const Item t_ = decode(it + 2 * nw); P0_LOAD(lda, t_); } const Item me = decode(it); P0_STORE(me); }
        if (it + nw < vend) { P0_PROC(ldb, 0); if (it + 3 * nw < vend) { const Item t_ = decode(it + 3 * nw); P0_LOAD(ldb, t_); } const Item me = decode(it + nw); P0_STORE(me); }
    }
#undef P0_PROC
#undef P0_STORE
#undef P0_LOAD
}
__device__ __forceinline__ void p0_prologue(const Ctx& F, const float* c_in, const float* w_mod, const float* b_mod, const float* w_in, const float* w_out, const float* w1, const float* w2) {
    if (F.vcu < 192) {
        const int l = F.vcu / 96, n0 = (F.vcu % 96) * 64;
        LAS float* cact = (LAS float*)(F.lds + RING_OFF);
        for (int i = F.tid; i < NB * DM; i += NWAVES * 64) { const float v = c_in[i]; cact[i] = v / (1.0f + expf(-v)); }
        __syncthreads();
        float acc[NB];
#pragma unroll
        for (int b = 0; b < NB; ++b) acc[b] = 0.f;
        const float* wp = w_mod + (size_t)l * DM * 6144 + n0 + F.lane;
        const int k0 = F.wave * 128;
        float wn[32];
#pragma unroll
        for (int q = 0; q < 32; ++q) wn[q] = wp[(size_t)(k0 + q) * 6144];
#pragma unroll 1
        for (int kk = 0; kk < 4; ++kk) { const int k = k0 + 32 * kk; float w[32];
#pragma unroll
            for (int q = 0; q < 32; ++q) w[q] = wn[q];
            if (kk < 3) {
#pragma unroll
                for (int q = 0; q < 32; ++q) wn[q] = wp[(size_t)(k + 32 + q) * 6144]; }
#pragma unroll
            for (int b = 0; b < NB; ++b) { float a_ = acc[b];
#pragma unroll
                for (int q = 0; q < 32; q += 8) { const f32x4 c0 = *(const LAS f32x4*)(cact + b * DM + k + q), c1 = *(const LAS f32x4*)(cact + b * DM + k + q + 4);
                    a_ += (c0.x * w[q] + c0.y * w[q + 1] + c0.z * w[q + 2] + c0.w * w[q + 3]) + (c1.x * w[q + 4] + c1.y * w[q + 5] + c1.z * w[q + 6] + c1.w * w[q + 7]); }
                acc[b] = a_; } }
        __syncthreads();
        LAS float* red = (LAS float*)(F.lds + RING_OFF);
#pragma unroll
        for (int b = 0; b < NB; ++b) red[(F.wave * NB + b) * 64 + F.lane] = acc[b];
        __syncthreads();
        float* MOD = (float*)(F.ws + WS_MOD);
        for (int o = F.tid; o < NB * 64; o += NWAVES * 64) { const int b = o >> 6, col = o & 63; float s = b_mod[l * 6144 + n0 + col];
#pragma unroll
            for (int w = 0; w < NWAVES; ++w) s += red[(w * NB + b) * 64 + col];
            MOD[(size_t)(l * NB + b) * 6144 + n0 + col] = s; }
        __syncthreads();
    }
    { float* ROPE = (float*)(F.ws + WS_ROPE);
      for (int idx = F.vcu * NWAVES * 64 + F.tid; idx < SEQ * 32; idx += F.G * NWAVES * 64) { const int pos = idx >> 5, f = idx & 31, fi = f & 15;
          const float freq = powf(10000.0f, -(float)fi / 16.0f); const float p = (float)((f >> 4) ? (pos & 63) : (pos >> 6)); const float ang = p * freq;
          float s, c; sincosf(ang, &s, &c); ROPE[pos * 64 + f] = c; ROPE[pos * 64 + 32 + f] = s; } }
    p_convert(F, w_in, w_out, w1, w2, 0, 0, I_CV_IN + I_CV_OUT, F.vcu * NWAVES + F.wave, F.G * NWAVES);
}

__device__ __forceinline__ void norm_mod_row(const float* xrow, const float* g, const float* sc, const float* sh, bf16* orow, int lane) {
    const GAS f32x4* xr = (const GAS f32x4*)xrow + lane;
    f32x4 v[4]; float s = 0.f;
#pragma unroll
    for (int j = 0; j < 4; ++j) { v[j] = xr[64 * j]; s += (v[j].x * v[j].x + v[j].y * v[j].y) + (v[j].z * v[j].z + v[j].w * v[j].w); }
    const float rinv = 1.0f / sqrtf(wave_sum(s, lane) * (1.f / DM) + EPS);
    GAS unsigned long long* o8 = (GAS unsigned long long*)orow + lane;
#pragma unroll
    for (int j = 0; j < 4; ++j) { const f32x4 gg = ((const GAS f32x4*)g)[64 * j + lane], s1 = ((const GAS f32x4*)sc)[64 * j + lane], s0 = ((const GAS f32x4*)sh)[64 * j + lane];
        const f32x4 y = (v[j] * rinv) * gg * (s1 + 1.0f) + s0;
        o8[64 * j] = (unsigned long long)pk2(y.x, y.y) | ((unsigned long long)pk2(y.z, y.w) << 32); }
}

__device__ __forceinline__ void norm_mod_row2(const float* xa, const float* xb, const float* g, const float* sca, const float* sha, const float* scb, const float* shb, unsigned char* oa, unsigned char* ob, int lane) {
    const GAS f32x4* ra = (const GAS f32x4*)xa + lane; const GAS f32x4* rb = (const GAS f32x4*)xb + lane;
    f32x4 va[4], vb[4]; float sa = 0.f, sb = 0.f;
#pragma unroll
    for (int j = 0; j < 4; ++j) { va[j] = ra[64 * j]; vb[j] = rb[64 * j]; }
#pragma unroll
    for (int j = 0; j < 4; ++j) { sa += (va[j].x * va[j].x + va[j].y * va[j].y) + (va[j].z * va[j].z + va[j].w * va[j].w); sb += (vb[j].x * vb[j].x + vb[j].y * vb[j].y) + (vb[j].z * vb[j].z + vb[j].w * vb[j].w); }
    sa = wave_sum_s(sa); sb = wave_sum_s(sb);
    const float ia = 1.0f / sqrtf(sa * (1.f / DM) + EPS), ib = 1.0f / sqrtf(sb * (1.f / DM) + EPS);
    GAS unsigned* pa = (GAS unsigned*)oa + lane; GAS unsigned* pb = (GAS unsigned*)ob + lane;
#pragma unroll
    for (int j = 0; j < 4; ++j) { const f32x4 gg = ((const GAS f32x4*)g)[64 * j + lane];
        const f32x4 ya = (va[j] * ia) * gg * (((const GAS f32x4*)sca)[64 * j + lane] + 1.0f) + ((const GAS f32x4*)sha)[64 * j + lane];
        const f32x4 yb = (vb[j] * ib) * gg * (((const GAS f32x4*)scb)[64 * j + lane] + 1.0f) + ((const GAS f32x4*)shb)[64 * j + lane];
        pa[64 * j] = pg8::pk4_fp8(ya.x * pg8::F8_SA, ya.y * pg8::F8_SA, ya.z * pg8::F8_SA, ya.w * pg8::F8_SA);
        pb[64 * j] = pg8::pk4_fp8(yb.x * pg8::F8_SA, yb.y * pg8::F8_SA, yb.z * pg8::F8_SA, yb.w * pg8::F8_SA); }
}

__device__ __forceinline__ void p_conv(const Ctx& F, const float* w_dw, const float* b_dw, const float* g_cn, const float* b_cn) {
    const bf16* U = (const bf16*)(F.ws + WS_UU);
    const int c = F.tid; float w[31];
#pragma unroll
    for (int j = 0; j < 31; ++j) w[j] = w_dw[j * CC + c];
    const float bias = b_dw[c];
    LAS float* tile = (LAS float*)(F.lds + RING_OFF);
    unsigned char* MIX = (unsigned char*)(F.ws + WS_MIX);
    const f32x4 g0 = ((const GAS f32x4*)g_cn)[F.lane * 2], g1 = ((const GAS f32x4*)g_cn)[F.lane * 2 + 1], b0 = ((const GAS f32x4*)b_cn)[F.lane * 2], b1 = ((const GAS f32x4*)b_cn)[F.lane * 2 + 1];
    unsigned raw[62];
#define CONV_LOAD(CH) do { const int b_ = (CH) >> 6, s0_ = ((CH) & 63) * 32; _Pragma("unroll") for (int i = 0; i < 62; ++i) { const int s = s0_ - 15 + i; unsigned u = 0u; \
        if (s >= 0 && s < SEQ) u = (unsigned)((const GAS bf16*)U)[(size_t)(b_ * SEQ + s) * CC + c]; raw[i] = u; } } while (0)
    if (F.vcu < NTOK / 32) CONV_LOAD(F.vcu);
    for (int chunk = F.vcu; chunk < NTOK / 32; chunk += F.G) {
        const int b = chunk >> 6, s0 = (chunk & 63) * 32;
        { float win[62];
#pragma unroll
          for (int i = 0; i < 62; ++i) win[i] = __builtin_bit_cast(float, raw[i] << 16);
#pragma unroll
          for (int r = 0; r < 32; ++r) { float a = bias;
#pragma unroll
              for (int j = 0; j < 31; ++j) a += win[r + j] * w[j];
              tile[r * CC + c] = a; } }
        if (chunk + F.G < NTOK / 32) CONV_LOAD(chunk + F.G);
        LDS_WAIT(); __builtin_amdgcn_s_barrier(); asm volatile("" ::: "memory");
        { f32x4 a0[4], a1[4]; float s1[4], s2[4];
#pragma unroll
          for (int rr = 0; rr < 4; ++rr) { const LAS f32x4* tp = (const LAS f32x4*)(tile + (F.wave * 4 + rr) * CC + F.lane * 8); a0[rr] = tp[0]; a1[rr] = tp[1];
              s1[rr] = (a0[rr].x + a0[rr].y) + (a0[rr].z + a0[rr].w) + (a1[rr].x + a1[rr].y) + (a1[rr].z + a1[rr].w); }
#pragma unroll
          for (int rr = 0; rr < 4; ++rr) s1[rr] = wave_sum_s(s1[rr]);
#pragma unroll
          for (int rr = 0; rr < 4; ++rr) { const float mu = s1[rr] * (1.f / CC); a0[rr] = a0[rr] - mu; a1[rr] = a1[rr] - mu;
              s2[rr] = (a0[rr].x * a0[rr].x + a0[rr].y * a0[rr].y) + (a0[rr].z * a0[rr].z + a0[rr].w * a0[rr].w) + (a1[rr].x * a1[rr].x + a1[rr].y * a1[rr].y) + (a1[rr].z * a1[rr].z + a1[rr].w * a1[rr].w); }
#pragma unroll
          for (int rr = 0; rr < 4; ++rr) s2[rr] = wave_sum_s(s2[rr]);
#pragma unroll
          for (int rr = 0; rr < 4; ++rr) { const float rstd = 1.0f / sqrtf(s2[rr] * (1.f / CC) + EPS);
              f32x4 y0 = a0[rr] * rstd * g0 + b0, y1 = a1[rr] * rstd * g1 + b1;
#pragma unroll
              for (int q = 0; q < 4; ++q) { y0[q] = y0[q] / (1.0f + __expf(-y0[q])); y1[q] = y1[q] / (1.0f + __expf(-y1[q])); }
              v2u o; o.x = pg8::pk4_fp8(y0.x * pg8::F8_SMIX, y0.y * pg8::F8_SMIX, y0.z * pg8::F8_SMIX, y0.w * pg8::F8_SMIX); o.y = pg8::pk4_fp8(y1.x * pg8::F8_SMIX, y1.y * pg8::F8_SMIX, y1.z * pg8::F8_SMIX, y1.w * pg8::F8_SMIX);
              *(GAS v2u*)(MIX + (size_t)(b * SEQ + s0 + F.wave * 4 + rr) * 1024 + 512 + F.lane * 8) = o; } }
        LDS_WAIT(); __builtin_amdgcn_s_barrier(); asm volatile("" ::: "memory");
    }
    __syncthreads();
#undef CONV_LOAD
}

typedef short rt_bf16x8 __attribute__((ext_vector_type(8)));
__device__ __forceinline__ unsigned short bf_hi(float f) { return (unsigned short)f2bf(f); }
__device__ __forceinline__ void p_norm2_router(const Ctx& F, const float* g_ffn, const float* w_router, const float* b_router, const float* mod_l, gu32* gcnt) {
    constexpr int APITCH = 2064;
    LAS unsigned char* Ahi = F.lds + RING_OFF; LAS unsigned char* Alo = Ahi + 16 * APITCH; LAS float* PART = (LAS float*)(Alo + 16 * APITCH);
    LAS int* cntL = (LAS int*)(F.lds + LX_TAB); LAS int* baseL = cntL + 32;
    LAS v2u* stg = (LAS v2u*)(F.lds + LX_STG);
    const int lane = F.lane, c16 = lane & 15, kg = lane >> 4, el = lane & 31, half = lane >> 5;
    rt_bf16x8 Bhi[4][2], Blo[4][2];
#pragma unroll
    for (int s = 0; s < 4; ++s)
#pragma unroll
        for (int nt = 0; nt < 2; ++nt) { const float* wp = w_router + (size_t)(128 * F.wave + 32 * s + 8 * kg) * NE + 16 * nt + c16;
#pragma unroll
            for (int q = 0; q < 8; ++q) { const float wv = wp[q * NE]; const unsigned short h = bf_hi(wv); const unsigned short l = bf_hi(wv - __builtin_bit_cast(float, (unsigned)h << 16)); Bhi[s][nt][q] = (short)h; Blo[s][nt][q] = (short)l; } }
    const float brl = b_router[el];
    if (F.tid < 32) cntL[F.tid] = 0;
    __syncthreads();
    const bf16* X = (const bf16*)(F.ws + WS_X); unsigned char* H = (unsigned char*)(F.ws + WS_H);
    const int rbase = F.vcu * (NTOK / F.G);
    const float* sc = mod_l + (size_t)(rbase >> 11) * 6144 + 4 * 1024; const float* sh = mod_l + (size_t)(rbase >> 11) * 6144 + 3 * 1024;
    const int rl0 = 2 * F.wave; constexpr int NTILE = 16;
    f32x4 gs1[4], s0v[4];
#pragma unroll
    for (int j = 0; j < 4; ++j) { gs1[j] = ((const GAS f32x4*)g_ffn)[64 * j + lane] * (((const GAS f32x4*)sc)[64 * j + lane] + 1.0f); s0v[j] = ((const GAS f32x4*)sh)[64 * j + lane]; }
    v2u nxa[4], nxb[4];
    { const GAS v2u* xa = (const GAS v2u*)(X + (size_t)(rbase + rl0) * DM) + lane; const GAS v2u* xb = xa + DM / 4;
#pragma unroll
      for (int j = 0; j < 4; ++j) { nxa[j] = xa[64 * j]; nxb[j] = xb[64 * j]; } }
    for (int t = 0; t < (NTOK / F.G) / NTILE; ++t) {
        const int tok0 = rbase + 16 * t + rl0;
        f32x4 hA[4], hB[4]; float sA = 0.f, sB = 0.f;
#pragma unroll
        for (int j = 0; j < 4; ++j) { const v2u wa = nxa[j], wb = nxb[j];
            hA[j] = (f32x4){bflo(wa.x), bfhi(wa.x), bflo(wa.y), bfhi(wa.y)}; hB[j] = (f32x4){bflo(wb.x), bfhi(wb.x), bflo(wb.y), bfhi(wb.y)}; }
        if (t + 1 < (NTOK / F.G) / NTILE) { const GAS v2u* xa = (const GAS v2u*)(X + (size_t)(tok0 + 16) * DM) + lane; const GAS v2u* xb = xa + DM / 4;
#pragma unroll
            for (int j = 0; j < 4; ++j) { nxa[j] = xa[64 * j]; nxb[j] = xb[64 * j]; } }
#pragma unroll
        for (int j = 0; j < 4; ++j) { sA += (hA[j].x * hA[j].x + hA[j].y * hA[j].y) + (hA[j].z * hA[j].z + hA[j].w * hA[j].w); sB += (hB[j].x * hB[j].x + hB[j].y * hB[j].y) + (hB[j].z * hB[j].z + hB[j].w * hB[j].w); }
        const float rA = 1.0f / sqrtf(wave_sum_s(sA) * (1.f / DM) + EPS), rB = 1.0f / sqrtf(wave_sum_s(sB) * (1.f / DM) + EPS);
        GAS unsigned* oa = (GAS unsigned*)(H + (size_t)tok0 * DM) + lane; GAS unsigned* ob = oa + DM / 4;
#pragma unroll
        for (int j = 0; j < 4; ++j) {
            hA[j] = (hA[j] * rA) * gs1[j] + s0v[j]; hB[j] = (hB[j] * rB) * gs1[j] + s0v[j];
            oa[64 * j] = pg8::pk4_fp8(hA[j].x * pg8::F8_SA, hA[j].y * pg8::F8_SA, hA[j].z * pg8::F8_SA, hA[j].w * pg8::F8_SA);
            ob[64 * j] = pg8::pk4_fp8(hB[j].x * pg8::F8_SA, hB[j].y * pg8::F8_SA, hB[j].z * pg8::F8_SA, hB[j].w * pg8::F8_SA);
            v2u ha, la, hb, lb;
#define SPLIT2(v0, v1, HO, LO) do { const unsigned short h0_ = bf_hi(v0), h1_ = bf_hi(v1); HO = (unsigned)h0_ | ((unsigned)h1_ << 16); \
            LO = (unsigned)bf_hi((v0) - __builtin_bit_cast(float, (unsigned)h0_ << 16)) | ((unsigned)bf_hi((v1) - __builtin_bit_cast(float, (unsigned)h1_ << 16)) << 16); } while (0)
            SPLIT2(hA[j].x, hA[j].y, ha.x, la.x); SPLIT2(hA[j].z, hA[j].w, ha.y, la.y); SPLIT2(hB[j].x, hB[j].y, hb.x, lb.x); SPLIT2(hB[j].z, hB[j].w, hb.y, lb.y);
#undef SPLIT2
            const int cb = (4 * lane + 256 * j) * 2;
            *(LAS v2u*)(Ahi + rl0 * APITCH + cb) = ha; *(LAS v2u*)(Alo + rl0 * APITCH + cb) = la; *(LAS v2u*)(Ahi + (rl0 + 1) * APITCH + cb) = hb; *(LAS v2u*)(Alo + (rl0 + 1) * APITCH + cb) = lb; }
        LDS_WAIT(); __builtin_amdgcn_s_barrier(); asm volatile("" ::: "memory");
        f32x4 acc[2] = {(f32x4){0.f, 0.f, 0.f, 0.f}, (f32x4){0.f, 0.f, 0.f, 0.f}};
#pragma unroll
        for (int s = 0; s < 4; ++s) { const int kb = (128 * F.wave + 32 * s + 8 * kg) * 2;
            const rt_bf16x8 ah = *(const LAS rt_bf16x8*)(Ahi + c16 * APITCH + kb), al = *(const LAS rt_bf16x8*)(Alo + c16 * APITCH + kb);
#pragma unroll
            for (int nt = 0; nt < 2; ++nt) { acc[nt] = __builtin_amdgcn_mfma_f32_16x16x32_bf16(Bhi[s][nt], ah, acc[nt], 0, 0, 0); acc[nt] = __builtin_amdgcn_mfma_f32_16x16x32_bf16(Blo[s][nt], ah, acc[nt], 0, 0, 0);
                acc[nt] = __builtin_amdgcn_mfma_f32_16x16x32_bf16(Bhi[s][nt], al, acc[nt], 0, 0, 0); } }
#pragma unroll
        for (int nt = 0; nt < 2; ++nt) *(LAS f32x4*)(PART + (F.wave * 16 + c16) * 32 + 16 * nt + 4 * kg) = acc[nt];
        LDS_WAIT(); __builtin_amdgcn_s_barrier(); asm volatile("" ::: "memory");
        float v = brl;
#pragma unroll
        for (int w = 0; w < NWAVES; ++w) v += PART[(w * 16 + rl0 + half) * 32 + el];
        float val[4]; int idx[4];
#pragma unroll
        for (int k = 0; k < 4; ++k) {
            float m = v; m = __builtin_fmaxf(m, DPPF(m, m, 0xB1, 0xF)); m = __builtin_fmaxf(m, DPPF(m, m, 0x4E, 0xF)); m = __builtin_fmaxf(m, DPPF(m, m, 0x141, 0xF)); m = __builtin_fmaxf(m, DPPF(m, m, 0x140, 0xF));
            m = __builtin_fmaxf(m, DPPF(m, m, 0x142, 0xA));
            const float mA = __builtin_bit_cast(float, __builtin_amdgcn_readlane(__builtin_bit_cast(int, m), 31)), mB = __builtin_bit_cast(float, __builtin_amdgcn_readlane(__builtin_bit_cast(int, m), 63));
            const float mm = half ? mB : mA;
            const unsigned long long bm = __builtin_amdgcn_ballot_w64(v == mm);
            const int sA_ = __builtin_ctz((unsigned)bm), sB_ = __builtin_ctz((unsigned)(bm >> 32));
            const int sel = half ? sB_ : sA_;
            val[k] = mm; idx[k] = sel; if (el == sel) v = -INFINITY; }
        float g[4]; float sm = 0.f;
#pragma unroll
        for (int k = 0; k < 4; ++k) { g[k] = expf(val[k] - val[0]); sm += g[k]; }
        if (el < 4) { const int k = el; const int e = k == 0 ? idx[0] : k == 1 ? idx[1] : k == 2 ? idx[2] : idx[3]; const float gt = (k == 0 ? g[0] : k == 1 ? g[1] : k == 2 ? g[2] : g[3]) / sm;
            const int pos = __hip_atomic_fetch_add(cntL + e, 1, __ATOMIC_RELAXED, __HIP_MEMORY_SCOPE_WORKGROUP);
            const int lr = 16 * t + rl0 + half;
            v2u ent; ent.x = (unsigned)e | ((unsigned)pos << 8); ent.y = __builtin_bit_cast(unsigned, gt); stg[lr * 4 + k] = ent; }
    }
    __syncthreads();
    if (F.tid < 32) baseL[F.tid] = (int)__hip_atomic_fetch_add(gcnt + F.tid, (unsigned)cntL[F.tid], RLX_AGENT);
    __syncthreads();
    v2u* TOPKB = (v2u*)(F.ws + WS_TOPK);
    for (int i = F.tid; i < (NTOK / F.G) * 4; i += NWAVES * 64) { v2u ent = stg[i]; const int tok = rbase + (i >> 2);
        const unsigned e = ent.x & 255u, pos = (ent.x >> 8) + (unsigned)baseL[e]; ent.x = e | (pos << 8); TOPKB[(size_t)tok * 4 + (i & 3)] = ent; }
    __syncthreads();
}

__device__ __forceinline__ void p_perm(const Ctx& F, gu32* gcnt) {
    LAS int* pst = (LAS int*)(F.lds + LX_TAB + 256); LAS int* pcn = pst + 32;
    if (F.tid < NE) pcn[F.tid] = (int)__hip_atomic_load(gcnt + F.tid, RLX_AGENT);
    __syncthreads();
    if (F.tid == 0) { int acc = 0; for (int e = 0; e < NE; ++e) { pst[e] = acc; acc += (pcn[e] + 255) & ~255; } }
    __syncthreads();
    const v2u* TOPKB = (const v2u*)(F.ws + WS_TOPK); int* SLOT = (int*)(F.ws + WS_SLOT); float* PGATE = (float*)(F.ws + WS_PGATE); int* PERM = (int*)(F.ws + WS_PERM);
    const int gt = (F.vcu * NWAVES + F.wave) * 64 + F.lane, NGT = F.G * NWAVES * 64;
    for (int i = gt; i < NTOK * 4; i += NGT) { const v2u ent = ((const GAS v2u*)TOPKB)[i]; const unsigned ex = ent.x, gbits = ent.y; const int dest = pst[ex & 255u] + (int)(ex >> 8);
        ((GAS int*)SLOT)[i] = dest; ((GAS float*)PGATE)[dest] = __builtin_bit_cast(float, gbits); ((GAS int*)PERM)[dest] = i >> 2; }
    if (F.vcu < NE) { const int e = F.vcu, c = pcn[e], pe = (c + 255) & ~255; for (int r = c + F.tid; r < pe; r += NWAVES * 64) { PERM[pst[e] + r] = 0; PGATE[pst[e] + r] = 0.f; } }
}

__device__ __forceinline__ int build_tile_table(const Ctx& F, gu32* gcnt) {
    LAS int* tst = (LAS int*)(F.lds + LX_TAB + 512); LAS unsigned char* te = (LAS unsigned char*)(F.lds + LX_TILE);
    LAS int* tcn = tst + 40;
    if (F.tid < NE) tcn[F.tid] = (int)__hip_atomic_load(gcnt + F.tid, RLX_AGENT);
    __syncthreads();
    if (F.tid == 0) { int acc = 0; for (int e = 0; e < NE; ++e) { tst[e] = acc; acc += (tcn[e] + 255) >> 8; } tst[NE] = acc; }
    __syncthreads();
    if (F.tid < NE) { const int t0 = tst[F.tid], t1 = tst[F.tid + 1]; for (int t = t0; t < t1; ++t) te[t] = (unsigned char)F.tid; }
    __syncthreads();
    return __builtin_amdgcn_readfirstlane(tst[NE]);
}

template <bool LAST> __device__ __forceinline__ void cb_token(const v2u (&yv)[2][4], const v4u (&xw)[2], const f32x4 (&gy)[4], const f32x4 (&gn)[4], const f32x4 (&s0v)[4], bf16* X, unsigned char* H, float* out, int tok, int lane, bool poison) {
    f32x4 x[4]; float ss = 0.f;
#pragma unroll
    for (int j = 0; j < 2; ++j) {
        const v2u y0 = yv[j][0], y1 = yv[j][1], y2 = yv[j][2], y3 = yv[j][3]; const v4u xx = xw[j];
        const f32x4 xa = (f32x4){bflo(xx.x), bfhi(xx.x), bflo(xx.y), bfhi(xx.y)}, xb = (f32x4){bflo(xx.z), bfhi(xx.z), bflo(xx.w), bfhi(xx.w)};
        f32x4 sa, sb;
#define F8X(w, k) __builtin_amdgcn_cvt_f32_fp8((int)(w), (k))
        sa.x = ((F8X(y0.x, 0) + F8X(y1.x, 0)) + F8X(y2.x, 0)) + F8X(y3.x, 0); sa.y = ((F8X(y0.x, 1) + F8X(y1.x, 1)) + F8X(y2.x, 1)) + F8X(y3.x, 1);
        sa.z = ((F8X(y0.x, 2) + F8X(y1.x, 2)) + F8X(y2.x, 2)) + F8X(y3.x, 2); sa.w = ((F8X(y0.x, 3) + F8X(y1.x, 3)) + F8X(y2.x, 3)) + F8X(y3.x, 3);
        sb.x = ((F8X(y0.y, 0) + F8X(y1.y, 0)) + F8X(y2.y, 0)) + F8X(y3.y, 0); sb.y = ((F8X(y0.y, 1) + F8X(y1.y, 1)) + F8X(y2.y, 1)) + F8X(y3.y, 1);
        sb.z = ((F8X(y0.y, 2) + F8X(y1.y, 2)) + F8X(y2.y, 2)) + F8X(y3.y, 2); sb.w = ((F8X(y0.y, 3) + F8X(y1.y, 3)) + F8X(y2.y, 3)) + F8X(y3.y, 3);
#undef F8X
        x[2 * j] = xa + gy[2 * j] * sa; x[2 * j + 1] = xb + gy[2 * j + 1] * sb;
        ss += (x[2 * j].x * x[2 * j].x + x[2 * j].y * x[2 * j].y) + (x[2 * j].z * x[2 * j].z + x[2 * j].w * x[2 * j].w) + (x[2 * j + 1].x * x[2 * j + 1].x + x[2 * j + 1].y * x[2 * j + 1].y) + (x[2 * j + 1].z * x[2 * j + 1].z + x[2 * j + 1].w * x[2 * j + 1].w); }
    const float rinv = 1.0f / sqrtf(wave_sum(ss, lane) * (1.f / DM) + EPS);
#pragma unroll
    for (int j = 0; j < 2; ++j) { const int col = 512 * j + 8 * lane;
        if (LAST) { f32x4 o0 = (x[2 * j] * rinv) * gn[2 * j], o1 = (x[2 * j + 1] * rinv) * gn[2 * j + 1];
            if (poison) { const float qn = __builtin_nanf(""); o0 = (f32x4){qn, qn, qn, qn}; o1 = o0; }
            *(GAS f32x4*)(out + (size_t)tok * DM + col) = o0; *(GAS f32x4*)(out + (size_t)tok * DM + col + 4) = o1; }
        else { { v4u xo; xo.x = pk2(x[2 * j].x, x[2 * j].y); xo.y = pk2(x[2 * j].z, x[2 * j].w); xo.z = pk2(x[2 * j + 1].x, x[2 * j + 1].y); xo.w = pk2(x[2 * j + 1].z, x[2 * j + 1].w); *(GAS v4u*)(X + (size_t)tok * DM + col) = xo; }
            const f32x4 ya = (x[2 * j] * rinv) * gn[2 * j] + s0v[2 * j], yb = (x[2 * j + 1] * rinv) * gn[2 * j + 1] + s0v[2 * j + 1];
            v2u o; o.x = pg8::pk4_fp8(ya.x * pg8::F8_SA, ya.y * pg8::F8_SA, ya.z * pg8::F8_SA, ya.w * pg8::F8_SA); o.y = pg8::pk4_fp8(yb.x * pg8::F8_SA, yb.y * pg8::F8_SA, yb.z * pg8::F8_SA, yb.w * pg8::F8_SA);
            *(GAS v2u*)(H + (size_t)tok * DM + col) = o; } }
}
template <bool LAST> __device__ __forceinline__ void p_combine(const Ctx& F, const float* mod_l, const float* g_next, const float* mod_next, float* out, bool poison) {
    bf16* X = (bf16*)(F.ws + WS_X); const unsigned char* Y = (const unsigned char*)(F.ws + WS_Y);   const int* SLOT = (const int*)(F.ws + WS_SLOT); unsigned char* H = (unsigned char*)(F.ws + WS_H);
    constexpr int TPW = NTOK / (256 * NWAVES);
    const int lane = F.lane; const int t0 = (F.vcu * NWAVES + F.wave) * TPW; const int b = t0 >> 11;
    f32x4 gy[4], gn[4], s0v[4];
#pragma unroll
    for (int j = 0; j < 2; ++j) { const int col = 512 * j + 8 * lane; const float* gt2 = mod_l + (size_t)b * 6144 + 5 * 1024;
        gy[2 * j] = *(const GAS f32x4*)(gt2 + col) * (1.0f / pg8::F8_SY); gy[2 * j + 1] = *(const GAS f32x4*)(gt2 + col + 4) * (1.0f / pg8::F8_SY);
        gn[2 * j] = *(const GAS f32x4*)(g_next + col); gn[2 * j + 1] = *(const GAS f32x4*)(g_next + col + 4);
        if (!LAST) { const float* sh = mod_next + (size_t)b * 6144; const float* sc = sh + 1024;
            gn[2 * j] = gn[2 * j] * (*(const GAS f32x4*)(sc + col) + 1.0f); gn[2 * j + 1] = gn[2 * j + 1] * (*(const GAS f32x4*)(sc + col + 4) + 1.0f);
            s0v[2 * j] = *(const GAS f32x4*)(sh + col); s0v[2 * j + 1] = *(const GAS f32x4*)(sh + col + 4); }
        else { s0v[2 * j] = (f32x4){0.f, 0.f, 0.f, 0.f}; s0v[2 * j + 1] = s0v[2 * j]; } }
    const v4u my = *(const GAS v4u*)(SLOT + (size_t)(t0 + (lane & (TPW - 1))) * 4);
    const int m0 = (int)my.x, m1 = (int)my.y, m2 = (int)my.z, m3 = (int)my.w;
    v2u yA[2][2][4], yB[2][2][4]; v4u xA[2][2], xB[2][2];
#define CB_ISSUE(YV, XW, I) do { _Pragma("unroll") for (int q_ = 0; q_ < 2; ++q_) { const int ti_ = (I) + q_; \
        const unsigned char* r0_ = Y + (size_t)(unsigned)__builtin_amdgcn_readlane(m0, ti_) * DM; const unsigned char* r1_ = Y + (size_t)(unsigned)__builtin_amdgcn_readlane(m1, ti_) * DM; \
        const unsigned char* r2_ = Y + (size_t)(unsigned)__builtin_amdgcn_readlane(m2, ti_) * DM; const unsigned char* r3_ = Y + (size_t)(unsigned)__builtin_amdgcn_readlane(m3, ti_) * DM; \
        _Pragma("unroll") for (int j_ = 0; j_ < 2; ++j_) { const int col_ = 512 * j_ + 8 * lane; \
            YV[q_][j_][0] = *(const GAS v2u*)(r0_ + col_); YV[q_][j_][1] = *(const GAS v2u*)(r1_ + col_); YV[q_][j_][2] = *(const GAS v2u*)(r2_ + col_); YV[q_][j_][3] = *(const GAS v2u*)(r3_ + col_); \
            XW[q_][j_] = *(const GAS v4u*)(X + (size_t)(t0 + ti_) * DM + col_); } } } while (0)
#define CB_COMP(YV, XW, I) do { cb_token<LAST>(YV[0], XW[0], gy, gn, s0v, X, H, out, t0 + (I), lane, poison); cb_token<LAST>(YV[1], XW[1], gy, gn, s0v, X, H, out, t0 + (I) + 1, lane, poison); } while (0)
    CB_ISSUE(yA, xA, 0);
#pragma unroll 1
    for (int i = 0; i < TPW; i += 4) {
        CB_ISSUE(yB, xB, i + 2);
        CB_COMP(yA, xA, i);
        if (i + 4 < TPW) CB_ISSUE(yA, xA, i + 4);
        CB_COMP(yB, xB, i + 2);
    }
#undef CB_ISSUE
#undef CB_COMP
}
struct Args { const float* in[21]; float* out; unsigned char* ws; int ph_lo, ph_hi, li, pad; };
enum { I_X = 0, I_C, I_WMOD, I_BMOD, I_GMIX, I_WIN, I_GQ, I_GK, I_WDW, I_BDW, I_GCN, I_BCN, I_WOUT, I_GFFN, I_WR, I_BR, I_W1, I_B1, I_W2, I_B2, I_GFIN };

#define IN(k) (lo <= (k) && (k) < hi)
#define KAS __attribute__((address_space(4)))
#define ARG(k) (*(const float* const KAS*)(kap + 8 * (k)))
#define ARG_OUT (*(float* const KAS*)(kap + 8 * 21))
#define LAUNDER(P) const KAS char* kap = (const KAS char*)__builtin_amdgcn_kernarg_segment_ptr(); asm volatile("" : "+s"(kap)); Ctx P = F0; { unsigned z_ = 0u; asm volatile("" : "+v"(z_)); P.lane = (int)__builtin_amdgcn_mbcnt_hi(~0u, __builtin_amdgcn_mbcnt_lo(~0u, z_)); }     P.tid = P.wave * 64 + P.lane; asm volatile("" : "+v"(P.tid), "+v"(P.lane), "+s"(P.ws), "+s"(P.ctl))
#ifndef DBG_REP
#define DBG_REP -1
#endif
#define REPP(k) for (int rep_ = 0; rep_ < ((DBG_REP == (k)) ? 2 : 1); ++rep_)
#ifdef DBG_BAR2
#define SEAM(k) do { if (IN(k) && IN((k) + 1)) { xcd_barrier(bar); xcd_barrier(bar); } } while (0)
#else
#define SEAM(k) do { if (IN(k) && IN((k) + 1)) xcd_barrier(bar); } while (0)
#endif

template <int L> __device__ __forceinline__ void layer_body(const Ctx& F0, const Args& args, const XcdBarrier& bar, const int lo, const int hi, unsigned char* lds_generic) {
    constexpr int pb = 1 + 10 * L;
    if (L == 0 && IN(pb)) REPP(pb) { LAUNDER(F);
        constexpr int TPW = NTOK / (256 * NWAVES); const int lane = F.lane; const int t0 = (F.vcu * NWAVES + F.wave) * TPW;
        const float* x = ARG(I_X); const float* g = ARG(I_GMIX); const float* ma = (const float*)(F.ws + WS_MOD) + (size_t)L * NB * 6144 + (size_t)(t0 >> 11) * 6144; unsigned char* H = (unsigned char*)(F.ws + WS_H);
        f32x4 gs1[4], s0v[4];
#pragma unroll
        for (int j = 0; j < 4; ++j) { gs1[j] = ((const GAS f32x4*)g)[64 * j + lane] * (((const GAS f32x4*)(ma + 1024))[64 * j + lane] + 1.0f); s0v[j] = ((const GAS f32x4*)ma)[64 * j + lane]; }
        f32x4 vA[2][4], vB[2][4];
#define N1_ISSUE(V, I) do { _Pragma("unroll") for (int q_ = 0; q_ < 2; ++q_) _Pragma("unroll") for (int j_ = 0; j_ < 4; ++j_) V[q_][j_] = ((const GAS f32x4*)(x + (size_t)(t0 + (I) + q_) * DM))[64 * j_ + lane]; } while (0)
#define N1_COMP(V, I) do { _Pragma("unroll") for (int q_ = 0; q_ < 2; ++q_) { float ss_ = 0.f; \
            _Pragma("unroll") for (int j_ = 0; j_ < 4; ++j_) ss_ += (V[q_][j_].x * V[q_][j_].x + V[q_][j_].y * V[q_][j_].y) + (V[q_][j_].z * V[q_][j_].z + V[q_][j_].w * V[q_][j_].w); \
            const float ia_ = 1.0f / sqrtf(wave_sum_s(ss_) * (1.f / DM) + EPS); GAS unsigned* po_ = (GAS unsigned*)(H + (size_t)(t0 + (I) + q_) * DM) + lane; \
            _Pragma("unroll") for (int j_ = 0; j_ < 4; ++j_) { const f32x4 y_ = (V[q_][j_] * ia_) * gs1[j_] + s0v[j_]; po_[64 * j_] = pg8::pk4_fp8(y_.x * pg8::F8_SA, y_.y * pg8::F8_SA, y_.z * pg8::F8_SA, y_.w * pg8::F8_SA); } } } while (0)
        N1_ISSUE(vA, 0);
#pragma unroll 1
        for (int i = 0; i < TPW; i += 4) { N1_ISSUE(vB, i + 2); N1_COMP(vA, i); if (i + 4 < TPW) N1_ISSUE(vA, i + 4); N1_COMP(vB, i + 2); }
#undef N1_ISSUE
#undef N1_COMP
        SEAM(pb);
    }
    if (IN(pb + 1)) REPP(pb + 1) { LAUNDER(F);
        pg8::Gemm g{(const bf16*)(F.ws + WS_H), (const bf16*)(F.ws + WS_WIN + (size_t)L * INW * 1024), NTOK, INW, DM / 2, 0};
        pg8::StaticOrder S; S.init(NTOK, INW, F.G, (int)blockIdx.x);
        pg8::EpiInProj E{(bf16*)(F.ws + WS_Q), (bf16*)(F.ws + WS_KN), (bf16*)(F.ws + WS_V), (bf16*)(F.ws + WS_UU), ARG(I_GQ) + L * 64, ARG(I_GK) + L * 64, (const float*)(F.ws + WS_ROPE)};
        pg8::gemm_phase<pg8::EpiInProj, pg8::StaticOrder, true, true, true>(F.lds + RING_OFF, g, S, E, F.tid);
        SEAM(pb + 1);
    }
    if (IN(pb + 2)) REPP(pb + 2) { LAUNDER(F);
        p_conv(F, ARG(I_WDW) + (size_t)L * 31 * CC, ARG(I_BDW) + L * CC, ARG(I_GCN) + L * CC, ARG(I_BCN) + L * CC);
        SEAM(pb + 2);
    }
    if (IN(pb + 3)) REPP(pb + 3) { LAUNDER(F);
        static_assert(attn_body::ATTN_LDS_BYTES <= RING_BYTES, "attention body LDS vs frame");
        const attn_body::AttnTensors AT{(const attn_body::bf16*)(F.ws + WS_Q), (const attn_body::bf16*)(F.ws + WS_KN), (const attn_body::bf16*)(F.ws + WS_V), (attn_body::bf16*)(F.ws + WS_MIX)};
        const attn_body::StaticOrder S((int)F.G, (int)blockIdx.x);
        float mfix; bool afixed;
        { const float gq_ = wave_max_s(__builtin_fabsf(((const GAS float*)(ARG(I_GQ) + L * 64))[F.lane])), gk_ = wave_max_s(__builtin_fabsf(((const GAS float*)(ARG(I_GK) + L * 64))[F.lane]));
          mfix = attn_body::C2 * 64.0f * gq_ * gk_ * 1.01f + 0.25f; afixed = mfix <= 48.0f; }
        constexpr int ATT_SPLIT = 2; const int grp = F.vcu >> 7;
        if (afixed) {
#pragma unroll 1
        for (int seg = 0; seg < 3; ++seg) {
            const int kind = grp == 0 ? (seg == 0 ? 1 : seg == 1 ? 2 : 0) : (seg == 0 ? 3 : seg == 1 ? 1 : 4);
            if (kind == 1) { __syncthreads(); p_convert(F, ARG(I_WIN), ARG(I_WOUT), ARG(I_W1), ARG(I_W2), 1, L, (I_CV_W1L + I_CV_W2L) / 2, (F.vcu & 127) * NWAVES + F.wave, 128 * NWAVES, grp * ((I_CV_W1L + I_CV_W2L) / 2)); __syncthreads(); }
            else if (kind >= 2) attn_body::attn_phase<attn_body::StaticOrder, true>((char*)lds_generic + RING_OFF, AT, S, F.tid, kind == 4 ? ATT_SPLIT : 0, kind == 3 ? ATT_SPLIT : (1 << 30), mfix);
        }
        } else {
#pragma unroll 1
        for (int seg = 0; seg < 3; ++seg) {
            const int kind = grp == 0 ? (seg == 0 ? 1 : seg == 1 ? 2 : 0) : (seg == 0 ? 3 : seg == 1 ? 1 : 4);
            if (kind == 1) { __syncthreads(); p_convert(F, ARG(I_WIN), ARG(I_WOUT), ARG(I_W1), ARG(I_W2), 1, L, (I_CV_W1L + I_CV_W2L) / 2, (F.vcu & 127) * NWAVES + F.wave, 128 * NWAVES, grp * ((I_CV_W1L + I_CV_W2L) / 2)); __syncthreads(); }
            else if (kind >= 2) attn_body::attn_phase<attn_body::StaticOrder, false>((char*)lds_generic + RING_OFF, AT, S, F.tid, kind == 4 ? ATT_SPLIT : 0, kind == 3 ? ATT_SPLIT : (1 << 30), 0.f);
        }
        }
        SEAM(pb + 3);
    }
    if (IN(pb + 4)) REPP(pb + 4) { LAUNDER(F);
        pg8::Gemm g{(const bf16*)(F.ws + WS_MIX), (const bf16*)(F.ws + WS_WOUT + (size_t)L * 1024 * 1024), NTOK, DM, DM / 2, 0};
        pg8::StaticOrder S; S.init(NTOK, DM, F.G, (int)blockIdx.x);
        bf16* X = (bf16*)(F.ws + WS_X);
        pg8::EpiResGate<L == 0> E{L == 0 ? (const void*)ARG(I_X) : (const void*)X, X, (const float*)(F.ws + WS_MOD) + (size_t)L * NB * 6144 + 2 * 1024};
        pg8::gemm_phase<pg8::EpiResGate<L == 0>, pg8::StaticOrder, true, true, true>(F.lds + RING_OFF, g, S, E, F.tid);
        SEAM(pb + 4);
    }
    if (IN(pb + 5)) REPP(pb + 5) { LAUNDER(F);
        p_norm2_router(F, ARG(I_GFFN) + L * DM, ARG(I_WR) + (size_t)L * DM * NE, ARG(I_BR) + L * NE, (const float*)(F.ws + WS_MOD) + (size_t)L * NB * 6144, F.ctl + CW_CNT + 64 * L + ((DBG_REP == pb + 5 && rep_ == 0) ? 4096 : 0));
        SEAM(pb + 5);
    }
    if (IN(pb + 6)) REPP(pb + 6) { LAUNDER(F); p_perm(F, F.ctl + CW_CNT + 64 * L); SEAM(pb + 6); }
    if (IN(pb + 7)) REPP(pb + 7) { LAUNDER(F);
        const int T = build_tile_table(F, F.ctl + CW_CNT + 64 * L);
        pg8::Gemm g{(const bf16*)(F.ws + WS_H), (const bf16*)(F.ws + WS_W1 + (size_t)L * NE * 2048 * 1024), T * 256, 2048, DM / 2, (size_t)2048 * 1024};
        const unsigned long long pp_ = (unsigned long long)(F.ws + WS_PERM);
        const int* permp = (const int*)(((unsigned long long)(unsigned)__builtin_amdgcn_readfirstlane((int)(pp_ >> 32)) << 32) | (unsigned)__builtin_amdgcn_readfirstlane((int)(unsigned)pp_));
        pg8::MoeOrder<true, true> S{(const LAS unsigned char*)(F.lds + LX_TILE), T, F.G, F.vcu, permp, (LAS int*)(F.lds + LX_STG)};
        pg8::EpiSwiglu E{(unsigned char*)(F.ws + WS_ACT), ARG(I_B1) + (size_t)L * NE * 2048};
        pg8::gemm_phase<pg8::EpiSwiglu, pg8::MoeOrder<true, true>, true, true, true>(F.lds + RING_OFF, g, S, E, F.tid);
        SEAM(pb + 7);
    }
#ifdef DBG_DUP8
    if (L == 0 && IN(pb + 7)) { LAUNDER(F);
        const int T = build_tile_table(F, F.ctl + CW_CNT + 64 * L);
        pg8::Gemm g{(const bf16*)(F.ws + WS_H), (const bf16*)(F.ws + WS_W1 + (size_t)L * NE * 2048 * 1024), T * 256, 2048, DM / 2, (size_t)2048 * 1024};
        const unsigned long long pp_ = (unsigned long long)(F.ws + WS_PERM);
        const int* permp = (const int*)(((unsigned long long)(unsigned)__builtin_amdgcn_readfirstlane((int)(pp_ >> 32)) << 32) | (unsigned)__builtin_amdgcn_readfirstlane((int)(unsigned)pp_));
        pg8::MoeOrder<true, true> S{(const LAS unsigned char*)(F.lds + LX_TILE), T, F.G, F.vcu, permp, (LAS int*)(F.lds + LX_STG)};
        pg8::EpiSwiglu E{(unsigned char*)(F.ws + WS_ACT), ARG(I_B1) + (size_t)L * NE * 2048};
        pg8::gemm_phase<pg8::EpiSwiglu, pg8::MoeOrder<true, true>, true, true, true>(F.lds + RING_OFF, g, S, E, F.tid);
        SEAM(pb + 7);
    }
#endif
    if (IN(pb + 8)) REPP(pb + 8) { LAUNDER(F);
        const int T = build_tile_table(F, F.ctl + CW_CNT + 64 * L);
        pg8::Gemm g{(const bf16*)(F.ws + WS_ACT), (const bf16*)(F.ws + WS_W2 + (size_t)L * NE * 1024 * 1024), T * 256, DM, DM / 2, (size_t)1024 * 1024};
        pg8::MoeOrder<false, false, true> S{(const LAS unsigned char*)(F.lds + LX_TILE), T, F.G, F.vcu, nullptr, nullptr};
        pg8::EpiY E{(unsigned char*)(F.ws + WS_Y), ARG(I_B2) + (size_t)L * NE * 1024, (const float*)(F.ws + WS_PGATE)};
        pg8::gemm_phase<pg8::EpiY, pg8::MoeOrder<false, false, true>, true, true, true>(F.lds + RING_OFF, g, S, E, F.tid);
        SEAM(pb + 8);
    }
#ifdef DBG_DUP9
    if (L == 0 && IN(pb + 8)) { LAUNDER(F);
        const int T = build_tile_table(F, F.ctl + CW_CNT + 64 * L);
        pg8::Gemm g{(const bf16*)(F.ws + WS_ACT), (const bf16*)(F.ws + WS_W2 + (size_t)L * NE * 1024 * 1024), T * 256, DM, DM / 2, (size_t)1024 * 1024};
        pg8::MoeOrder<false, false, true> S{(const LAS unsigned char*)(F.lds + LX_TILE), T, F.G, F.vcu, nullptr, nullptr};
        pg8::EpiY E{(unsigned char*)(F.ws + WS_Y), ARG(I_B2) + (size_t)L * NE * 1024, (const float*)(F.ws + WS_PGATE)};
        pg8::gemm_phase<pg8::EpiY, pg8::MoeOrder<false, false, true>, true, true, true>(F.lds + RING_OFF, g, S, E, F.tid);
        SEAM(pb + 8);
    }
#endif
    if (IN(pb + 9)) REPP(pb + 9) { LAUNDER(F);
        const float* mod_l = (const float*)(F.ws + WS_MOD) + (size_t)L * NB * 6144;
        if (L == DEPTH - 1) {
            bool poison = false;
            for (int r = 0; r < NPH; ++r) poison |= __hip_atomic_load((gu32*)(F.ctl + CW_BAR + r * XCD_BAR_WORDS + XB_TMO), RLX_AGENT) != 0u;
            p_combine<true>(F, mod_l, ARG(I_GFIN), nullptr, ARG_OUT, poison);
        } else {
            p_combine<false>(F, mod_l, ARG(I_GMIX) + (L + 1) * DM, (const float*)(F.ws + WS_MOD) + (size_t)(L + 1) * NB * 6144, nullptr, false);
        }
        SEAM(pb + 9);
    }
}

__global__ void __launch_bounds__(NWAVES * 64, 2) enc_fwd(Args args) {
    extern __shared__ __attribute__((aligned(16))) unsigned char lds[];
    Ctx F0;
    F0.lds = (LAS unsigned char*)lds; F0.ws = args.ws; F0.ctl = (gu32*)(args.ws + WS_CTL);
    F0.tid = 0; F0.lane = 0; F0.wave = __builtin_amdgcn_readfirstlane((int)threadIdx.x >> 6);
    F0.G = gridDim.x; { const int bx = blockIdx.x; F0.vcu = (F0.G % 8 == 0) ? (bx % 8) * (F0.G / 8) + bx / 8 : bx; }
    volatile LAS unsigned* MISC = (volatile LAS unsigned*)(F0.lds + LX_MISC);
    for (int u = threadIdx.x; u < 128; u += NWAVES * 64) ((LAS unsigned*)(F0.lds + LX_MISC))[u] = 0u;
    __syncthreads();
    unsigned* barw = (unsigned*)(F0.ctl + CW_BAR) + args.li * XCD_BAR_WORDS;
    const XcdBarrier bar = xcd_barrier_post(barw, MISC + 8, (unsigned)F0.wave);
    const int lo = args.ph_lo, hi = args.ph_hi;
    if (IN(0)) REPP(0) { LAUNDER(F); p0_prologue(F, ARG(I_C), ARG(I_WMOD), ARG(I_BMOD), ARG(I_WIN), ARG(I_WOUT), ARG(I_W1), ARG(I_W2)); SEAM(0); }
    layer_body<0>(F0, args, bar, lo, hi, lds);
    layer_body<1>(F0, args, bar, lo, hi, lds);
#ifdef DBG_STOP
    if (IN(21)) { LAUNDER(F); const int gw = F.vcu * NWAVES + F.wave, NGW = F.G * NWAVES, lane = F.lane; const float* X = (DBG_STOP == 0) ? ARG(I_X) : (const float*)(F.ws + WS_X); const float* g = ARG(I_GFIN);
        for (int tok = gw; tok < NTOK; tok += NGW) { const GAS f32x4* xr = (const GAS f32x4*)(X + (size_t)tok * DM) + lane; f32x4 v[4]; float ss = 0.f;
            for (int j = 0; j < 4; ++j) { v[j] = xr[64 * j]; ss += (v[j].x * v[j].x + v[j].y * v[j].y) + (v[j].z * v[j].z + v[j].w * v[j].w); }
            const float rinv = 1.0f / sqrtf(wave_sum(ss, lane) * (1.f / DM) + EPS);
            for (int j = 0; j < 4; ++j) ((GAS f32x4*)(ARG_OUT + (size_t)tok * DM))[64 * j + lane] = (v[j] * rinv) * ((const GAS f32x4*)g)[64 * j + lane]; } }
#endif
}
#undef IN
#undef SEAM
#undef LAUNDER

extern "C" void kernel_launch(void* const* d_in, const int* in_sizes, int n_in, void* d_out, int out_size, void* d_ws, size_t ws_size, hipStream_t stream) {
    static int grid = 0;
    if (grid == 0) {
        if (n_in != 21 || in_sizes[0] != NTOK * DM || out_size != NTOK * DM || ws_size < WS_END) { fprintf(stderr, "kernel_launch: shape/workspace mismatch (n_in %d, in0 %d, out %d, ws %zu, need %zu); nothing launched\n", n_in, n_in > 0 ? in_sizes[0] : -1, out_size, ws_size, (size_t)WS_END); grid = -1; return; }
        int dev = 0, cus = 0, per_cu = 0;
        if (hipGetDevice(&dev) != hipSuccess || hipDeviceGetAttribute(&cus, hipDeviceAttributeMultiprocessorCount, dev) != hipSuccess) { fprintf(stderr, "kernel_launch: device query failed\n"); grid = -1; return; }
        if (hipFuncSetAttribute((const void*)enc_fwd, hipFuncAttributeMaxDynamicSharedMemorySize, LDS_BYTES) != hipSuccess) { fprintf(stderr, "kernel_launch: hipFuncSetAttribute failed\n"); grid = -1; return; }
        if (hipOccupancyMaxActiveBlocksPerMultiprocessor(&per_cu, (const void*)enc_fwd, NWAVES * 64, LDS_BYTES) != hipSuccess || per_cu < 1) fprintf(stderr, "kernel_launch: note: occupancy query reports %d workgroups per CU\n", per_cu);
        (void)hipGetLastError();
        if (cus != 256) { fprintf(stderr, "kernel_launch: built for a 256-CU device, found %d; nothing launched\n", cus); grid = -1; return; }
        grid = cus;
    }
    if (grid < 0) return;
    if (hipMemsetAsync((char*)d_ws + WS_CTL, 0, CTL_ZERO_BYTES, stream) != hipSuccess) { fprintf(stderr, "kernel_launch: hipMemsetAsync failed\n"); return; }
    Args a{};
    for (int i = 0; i < 21; ++i) a.in[i] = (const float*)d_in[i];
    a.out = (float*)d_out; a.ws = (unsigned char*)d_ws;
#if MK_PER_PHASE
    for (int li = 0; li < NPH; ++li) { if (li == 11) continue;
#ifdef DBG_STOP
        if (li > DBG_STOP) continue;
#endif
        a.ph_lo = li; a.ph_hi = li + 1; a.li = li;
        hipLaunchKernelGGL(enc_fwd, dim3(grid), dim3(NWAVES * 64), LDS_BYTES, stream, a); }
#ifdef DBG_STOP
    a.ph_lo = 21; a.ph_hi = 22; a.li = 20; hipLaunchKernelGGL(enc_fwd, dim3(grid), dim3(NWAVES * 64), LDS_BYTES, stream, a);
#endif
#else
    a.ph_lo = 0; a.ph_hi = NPH; a.li = 0;
    hipLaunchKernelGGL(enc_fwd, dim3(grid), dim3(NWAVES * 64), LDS_BYTES, stream, a);
#endif
    const hipError_t le = hipPeekAtLastError();
    if (le != hipSuccess) fprintf(stderr, "kernel_launch: launch failed: %s\n", hipGetErrorName(le));
}
```
